# Optimizing an MI355X kernel written in HIP

```python
import jax, jax.numpy as jnp
from jax import lax
import numpy as np

D_MODEL = 2048
BATCH = 1
SEQ = 8192
DEPTH = 1

CHUNK = 64
HEAD_DIM = 128
N_HEADS_SB = 8
N_HEADS_FOX = 8
D_SB = N_HEADS_SB * HEAD_DIM
D_FOX = N_HEADS_FOX * HEAD_DIM
N_IN = 3 * D_SB + 3 * D_FOX + N_HEADS_FOX + 2 * D_MODEL
Q_BLOCK = 128
N_EXPERTS = 32
TOP_K = 4
D_FF = D_MODEL
SWIGLU_LIMIT = 7.0
SWIGLU_ALPHA = 1.702
EXPERT_BLOCK = 128
RMS_EPS = 1e-5
FORGET_BIAS_INIT = 3.0

kernel_name = "hybrid_stickbreak_fox_moe_block"


def rmsnorm(x, g):
    xf = x.astype(jnp.float32)
    xf = xf * lax.rsqrt(jnp.mean(xf * xf, axis=-1, keepdims=True) + RMS_EPS)
    return (xf * g.astype(jnp.float32)).astype(x.dtype)


def to_heads(t, n_heads):
    b, s, _ = t.shape
    return t.reshape(b, s, n_heads, HEAD_DIM).transpose(0, 2, 1, 3)


def merge_block_heads(o):
    nb, b, h, qb, dh = o.shape
    return o.transpose(1, 0, 3, 2, 4).reshape(b, nb * qb, h * dh)


def stick_breaking_attention(q, k, v):
    _, _, s_len, dh = q.shape
    n_blocks = s_len // Q_BLOCK
    scale = dh ** -0.5
    kpos = jnp.arange(s_len)

    def block(i):
        q0 = i * Q_BLOCK
        qb = lax.dynamic_slice_in_dim(q, q0, Q_BLOCK, axis=2)
        z = jnp.einsum('bhqd,bhkd->bhqk', qb, k, preferred_element_type=jnp.float32) * scale
        qpos = q0 + jnp.arange(Q_BLOCK)
        strict = kpos[None, :] < qpos[:, None]
        log_keep = jnp.where(strict, jax.nn.log_sigmoid(-z), 0.0)
        log_between = lax.cumsum(log_keep, axis=3, reverse=True) - log_keep
        a = jnp.where(strict, jnp.exp(jax.nn.log_sigmoid(z) + log_between), 0.0)
        return jnp.einsum('bhqk,bhkd->bhqd', a.astype(v.dtype), v)

    return merge_block_heads(lax.map(block, jnp.arange(n_blocks)))


def forgetting_attention(q, k, v, log_f):
    _, _, s_len, dh = q.shape
    n_blocks = s_len // Q_BLOCK
    scale = dh ** -0.5
    kpos = jnp.arange(s_len)
    cum_f = jnp.cumsum(log_f, axis=-1)

    def block(i):
        q0 = i * Q_BLOCK
        qb = lax.dynamic_slice_in_dim(q, q0, Q_BLOCK, axis=2)
        fq = lax.dynamic_slice_in_dim(cum_f, q0, Q_BLOCK, axis=2)
        z = jnp.einsum('bhqd,bhkd->bhqk', qb, k, preferred_element_type=jnp.float32) * scale
        logits = z + fq[..., :, None] - cum_f[..., None, :]
        qpos = q0 + jnp.arange(Q_BLOCK)
        causal = kpos[None, :] <= qpos[:, None]
        p = jax.nn.softmax(jnp.where(causal, logits, -jnp.inf), axis=-1)
        return jnp.einsum('bhqk,bhkd->bhqd', p.astype(v.dtype), v)

    return merge_block_heads(lax.map(block, jnp.arange(n_blocks)))


def hybrid_mixer(h, w_in, b_forget, b_gate, w_proj_sb, w_proj_fox, w_out):
    p = h @ w_in
    cuts = np.cumsum([D_SB, D_SB, D_SB, D_FOX, D_FOX, D_FOX, N_HEADS_FOX]).tolist()
    q_sb, k_sb, v_sb, q_fx, k_fx, v_fx, f_fx, gate_logits = jnp.split(p, cuts, axis=-1)
    o_sb = stick_breaking_attention(to_heads(q_sb, N_HEADS_SB), to_heads(k_sb, N_HEADS_SB),
                                    to_heads(v_sb, N_HEADS_SB))
    log_f = jax.nn.log_sigmoid((f_fx + b_forget).astype(jnp.float32)).transpose(0, 2, 1)
    o_fx = forgetting_attention(to_heads(q_fx, N_HEADS_FOX), to_heads(k_fx, N_HEADS_FOX),
                                to_heads(v_fx, N_HEADS_FOX), log_f)
    g_sb, g_fx = jnp.split(jax.nn.sigmoid(gate_logits + b_gate), 2, axis=-1)
    mixed = g_sb * (o_sb @ w_proj_sb) + g_fx * (o_fx @ w_proj_fox)
    return mixed @ w_out


def moe_ffn(h, w_router, b_router, w_mlp1, b_mlp1, w_mlp2, b_mlp2):
    b, s, d = h.shape
    n_tok = b * s
    hf = h.reshape(n_tok, d)
    logits = hf.astype(jnp.float32) @ w_router.astype(jnp.float32) + b_router.astype(jnp.float32)
    top_v, top_i = lax.top_k(logits, TOP_K)
    top_w = jax.nn.softmax(top_v, axis=-1)
    n_assign = n_tok * TOP_K
    flat_e = top_i.reshape(-1)
    flat_tok = jnp.repeat(jnp.arange(n_tok), TOP_K)
    flat_w = top_w.reshape(-1)
    order = jnp.argsort(flat_e)
    se, stok, sw = flat_e[order], flat_tok[order], flat_w[order]
    counts = jnp.bincount(flat_e, length=N_EXPERTS)
    padded = (counts + EXPERT_BLOCK - 1) // EXPERT_BLOCK * EXPERT_BLOCK
    pad_end = jnp.cumsum(padded)
    pad_start = pad_end - padded
    raw_start = jnp.cumsum(counts) - counts
    dest = pad_start[se] + (jnp.arange(n_assign) - raw_start[se])
    n_slots = -(-n_assign // EXPERT_BLOCK) * EXPERT_BLOCK + N_EXPERTS * EXPERT_BLOCK
    n_blocks = n_slots // EXPERT_BLOCK
    slot_tok = jnp.full((n_slots,), n_tok, dtype=jnp.int32).at[dest].set(stok.astype(jnp.int32))
    slot_w = jnp.zeros((n_slots,), jnp.float32).at[dest].set(sw)
    block_e = jnp.minimum(jnp.searchsorted(pad_end, jnp.arange(n_blocks) * EXPERT_BLOCK, side='right'),
                          N_EXPERTS - 1)
    h_pad = jnp.concatenate([hf, jnp.zeros((1, d), hf.dtype)], axis=0)

    def expert_block(args):
        tok, e = args
        xb = h_pad[tok]
        gu = xb @ w_mlp1[e] + b_mlp1[e]
        gate = jnp.minimum(gu[:, 0::2], SWIGLU_LIMIT)
        lin = jnp.clip(gu[:, 1::2], -SWIGLU_LIMIT, SWIGLU_LIMIT)
        act = gate * jax.nn.sigmoid(SWIGLU_ALPHA * gate) * (lin + 1.0)
        return act @ w_mlp2[e] + b_mlp2[e]

    ys = lax.map(expert_block, (slot_tok.reshape(n_blocks, EXPERT_BLOCK), block_e))
    ys = ys.reshape(n_slots, d) * slot_w[:, None].astype(ys.dtype)
    out = jnp.zeros((n_tok + 1, d), ys.dtype).at[slot_tok].add(ys)[:n_tok]
    return out.reshape(b, s, d).astype(h.dtype)


def setup_inputs(seed: int = 0) -> dict:
    key = jax.random.key(seed)
    ks = jax.random.split(key, 16)
    f32 = jnp.float32
    nrm = lambda k, shape, scale: jax.random.normal(k, shape, f32) * scale
    return {
        "x": nrm(ks[0], (BATCH, SEQ, D_MODEL), 1.0),
        "g_mix": 1.0 + nrm(ks[1], (DEPTH, D_MODEL), 0.02),
        "w_in": nrm(ks[2], (DEPTH, D_MODEL, N_IN), D_MODEL ** -0.5),
        "b_forget": FORGET_BIAS_INIT + nrm(ks[3], (DEPTH, N_HEADS_FOX), 0.5),
        "b_gate": nrm(ks[4], (DEPTH, 2 * D_MODEL), 0.02),
        "w_proj_sb": nrm(ks[5], (DEPTH, D_SB, D_MODEL), D_SB ** -0.5),
        "w_proj_fox": nrm(ks[6], (DEPTH, D_FOX, D_MODEL), D_FOX ** -0.5),
        "w_out": nrm(ks[7], (DEPTH, D_MODEL, D_MODEL), D_MODEL ** -0.5),
        "g_ffn": 1.0 + nrm(ks[8], (DEPTH, D_MODEL), 0.02),
        "w_router": nrm(ks[9], (DEPTH, D_MODEL, N_EXPERTS), D_MODEL ** -0.5),
        "b_router": nrm(ks[10], (DEPTH, N_EXPERTS), 0.01),
        "w_mlp1": nrm(ks[11], (DEPTH, N_EXPERTS, D_MODEL, 2 * D_FF), D_MODEL ** -0.5),
        "b_mlp1": nrm(ks[12], (DEPTH, N_EXPERTS, 2 * D_FF), 0.02),
        "w_mlp2": nrm(ks[13], (DEPTH, N_EXPERTS, D_FF, D_MODEL), D_FF ** -0.5),
        "b_mlp2": nrm(ks[14], (DEPTH, N_EXPERTS, D_MODEL), 0.02),
        "g_final": 1.0 + nrm(ks[15], (D_MODEL,), 0.02),
    }


def reference(x, g_mix, w_in, b_forget, b_gate, w_proj_sb, w_proj_fox, w_out, g_ffn,
              w_router, b_router, w_mlp1, b_mlp1, w_mlp2, b_mlp2, g_final):
    for layer in range(DEPTH):
        h = rmsnorm(x, g_mix[layer])
        x = x + hybrid_mixer(h, w_in[layer], b_forget[layer], b_gate[layer],
                             w_proj_sb[layer], w_proj_fox[layer], w_out[layer])
        h = rmsnorm(x, g_ffn[layer])
        x = x + moe_ffn(h, w_router[layer], b_router[layer], w_mlp1[layer], b_mlp1[layer],
                        w_mlp2[layer], b_mlp2[layer])
    return rmsnorm(x, g_final)
```

```cpp
#include <hip/hip_runtime.h>
#include <hip/hip_bf16.h>
#include <cstdio>
#include <cstdint>

#ifndef DBG_P4_FROM_HN
#define DBG_P4_FROM_HN 0
#endif
#ifndef DBG_P4_MULTI
#define DBG_P4_MULTI 0
#endif
#ifndef DBG_P1_TO_MIXED
#define DBG_P1_TO_MIXED 0
#endif
#ifndef DBG_P3_SINGLE
#define DBG_P3_SINGLE 0
#endif
#ifndef DBG_NO_GATE_LOAD
#define DBG_NO_GATE_LOAD 0
#endif
#ifndef DBG_GATES_FROM_COPY
#define DBG_GATES_FROM_COPY 0
#endif
#ifndef DBG_SKIP_ATT
#define DBG_SKIP_ATT 0
#endif
#ifndef DBG_MIX_MODE
#define DBG_MIX_MODE 0
#endif
#ifndef DBG_NO_MOE
#define DBG_NO_MOE 0
#endif
#if DBG_NO_MOE
#define PH_MASK (DBG_P4_FROM_HN ? 0x111 : DBG_GATES_FROM_COPY ? 0x11b : DBG_P1_TO_MIXED ? 0x113 : DBG_SKIP_ATT ? 0x11b : 0x11f)
#endif
#ifndef MK_N_LAUNCHES
#define MK_N_LAUNCHES 1
#endif

namespace pg8 {
#define PG8_LAS __attribute__((address_space(3)))
typedef unsigned short bf16_t;
typedef short bf16x8 __attribute__((ext_vector_type(8)));
typedef float f32x4 __attribute__((ext_vector_type(4)));
typedef unsigned u32x4 __attribute__((ext_vector_type(4)));
typedef unsigned u32x2 __attribute__((ext_vector_type(2)));
constexpr int BM = 256, BK = 64, HALF = 128, HTB = HALF * BK * 2  , STAGE_BYTES = 8 * HTB, NXCD = 8, WGM = 8;

__host__ __device__ __forceinline__ int lds_byte(int r, int c) { const int st = (r >> 4) * 2 + (c >> 5), rr = r & 15, cc = c & 31, ob = rr * 64 + cc * 2; return st * 1024 + (ob ^ (((ob >> 9) & 1) << 5)); }
__host__ __device__ __forceinline__ void stage_rc(int b, int& R, int& C) { const int st = b / 1024, sb = b % 1024, swz = sb ^ (((sb >> 9) & 1) << 5); R = (st >> 1) * 16 + swz / 64; C = (st & 1) * 32 + (swz % 64) / 2; }
__host__ __device__ __forceinline__ int perm32(int rho) { const int n = rho >> 4, i = rho & 15; return 8 * (i >> 2) + 4 * n + (i & 3); }

struct Unit { const char* a; const char* b; int pm, pn, aux; };

typedef float f32x2_c __attribute__((ext_vector_type(2))); typedef __bf16 bf16x2_c __attribute__((ext_vector_type(2)));
__device__ __forceinline__ unsigned cvt_pk_bf16(float lo, float hi) { const f32x2_c v = {lo, hi}; const bf16x2_c b = __builtin_convertvector(v, bf16x2_c); return __builtin_bit_cast(unsigned, b); }
__device__ __forceinline__ float bf_lo(unsigned u) { return __uint_as_float(u << 16); }
__device__ __forceinline__ float bf_hi(unsigned u) { return __uint_as_float(u & 0xffff0000u); }
__device__ __forceinline__ float sigmoidf_fast(float x) { return __builtin_amdgcn_rcpf(1.0f + __builtin_amdgcn_exp2f(-1.4426950408889634f * x)); }

struct TileOrder {
    const char* A; const char* Bt; size_t tstepA, tstepB; int nM, nN, nwg, G, c;
    __device__ __forceinline__ void init(const void* A_, const void* Bt_, int M, int N, int K, int G_, int c_) { A = (const char*)A_; Bt = (const char*)Bt_; tstepA = (size_t)BM * K * 2; tstepB = tstepA; nM = M / BM; nN = N / BM; nwg = nM * nN; G = G_; c = c_; }
    __device__ __forceinline__ bool map(int L, int& pm, int& pn) const {
        if (L >= nwg) return false;
        int wgid = L; { const int q = nwg / NXCD, r = nwg % NXCD, xcd = wgid % NXCD, off = wgid / NXCD; wgid = (xcd < r ? xcd * (q + 1) : r * (q + 1) + (xcd - r) * q) + off; }
        const int nig = WGM * nN, gid = wgid / nig, fm = gid * WGM, gsz = (nM - fm) < WGM ? (nM - fm) : WGM;
        pm = fm + ((wgid % nig) % gsz); pn = (wgid % nig) / gsz; return true;
    }
    __device__ __forceinline__ bool next(int i, Unit& u) const {
        int pm, pn; if (!map(i * G + c, pm, pn)) return false;
        u.pm = pm; u.pn = pn; u.aux = 0; u.a = A + (size_t)pm * tstepA; u.b = Bt + (size_t)pn * tstepB; return true;
    }
    __device__ __forceinline__ void a_ready(const Unit&) const {}
    __device__ __forceinline__ void done(const Unit&) const {}
};
struct MixOrder {
    TileOrder t; const char* A1; const char* B1;
    __device__ __forceinline__ bool next(int i, Unit& u) const {
        int pm, pn; if (!t.map((i >> 1) * t.G + t.c, pm, pn)) return false;
        u.pm = pm; u.pn = pn; u.aux = i & 1;
        u.a = ((i & 1) ? A1 : t.A) + (size_t)pm * t.tstepA; u.b = ((i & 1) ? B1 : t.Bt) + (size_t)pn * t.tstepB; return true;
    }
    __device__ __forceinline__ void a_ready(const Unit&) const {}
    __device__ __forceinline__ void done(const Unit&) const {}
};
struct MoeOrder {
    const char* A; const char* Bt; const PG8_LAS int* pref;
    size_t a_estride, b_estride, tstep; int NT, cap_tiles, G, c;
    __device__ __forceinline__ bool next(int i, Unit& u) const {
        const int L = i * G + c; const int total = pref[32] * NT; if (L >= total) return false;
        int e = 0;
#pragma unroll 1
        for (int j = 1; j < 32; ++j) if (pref[j] * NT <= L) e = j;
        const int me = pref[e + 1] - pref[e], q = L - pref[e] * NT, nt = q / me, mt = q - nt * me;
        u.aux = e; u.pm = e * cap_tiles + mt; u.pn = nt;
        u.a = A + (size_t)e * a_estride + (size_t)mt * tstep; u.b = Bt + (size_t)e * b_estride + (size_t)nt * tstep; return true;
    }
    __device__ __forceinline__ void a_ready(const Unit&) const {}
    __device__ __forceinline__ void done(const Unit&) const {}
};

struct EpiP1 {
    static constexpr bool PERM = true, AFTER_DRAIN = false;
    bf16_t* qkv; size_t buf_stride; bf16_t* gates; const float* b_gate; bf16_t* dbg;
    __device__ __forceinline__ void operator()(const f32x4 (&acc)[2][2][4][2], const Unit& u, int wr, int wc, int fr, int fq) const {
        const int row0 = u.pm * BM + wr * 64 + fr;
        if (u.pn < 24) {
            bf16_t* base = qkv + (size_t)(u.pn >> 2) * buf_stride; const int col0 = (u.pn & 3) * BM + wc * 32 + 8 * fq;
#pragma unroll
            for (int ai = 0; ai < 2; ++ai)
#pragma unroll
                for (int m = 0; m < 4; ++m) { bf16_t* rowp = base + (size_t)(row0 + ai * HALF + m * 16) * 1024 + col0;
#pragma unroll
                    for (int bj = 0; bj < 2; ++bj) { const f32x4 v0 = acc[ai][bj][m][0], v1 = acc[ai][bj][m][1];
                        u32x4 w; w.x = cvt_pk_bf16(v0[0], v0[1]); w.y = cvt_pk_bf16(v0[2], v0[3]); w.z = cvt_pk_bf16(v1[0], v1[1]); w.w = cvt_pk_bf16(v1[2], v1[3]);
                        *(u32x4*)(rowp + bj * HALF) = w;
                        if (DBG_P1_TO_MIXED == 1 && u.pn < 8) *(u32x4*)(dbg + (size_t)(row0 + ai * HALF + m * 16) * 2048 + u.pn * BM + wc * 32 + 8 * fq + bj * HALF) = w;
                        if (DBG_P1_TO_MIXED == 3 && u.pn >= 16) *(u32x4*)(dbg + (size_t)(row0 + ai * HALF + m * 16) * 2048 + (u.pn - 16) * BM + wc * 32 + 8 * fq + bj * HALF) = w; } }
        } else {
            const int gc0 = (u.pn - 24) * BM + wc * 32 + 8 * fq;
            f32x4 bv[2][2];
#pragma unroll
            for (int bj = 0; bj < 2; ++bj)
#pragma unroll
                for (int n = 0; n < 2; ++n) bv[bj][n] = *(const f32x4*)(b_gate + gc0 + bj * HALF + 4 * n);
#pragma unroll
            for (int ai = 0; ai < 2; ++ai)
#pragma unroll
                for (int m = 0; m < 4; ++m) { bf16_t* rowp = gates + (size_t)(row0 + ai * HALF + m * 16) * 4096 + gc0;
#pragma unroll
                    for (int bj = 0; bj < 2; ++bj) { f32x4 v0 = acc[ai][bj][m][0] + bv[bj][0], v1 = acc[ai][bj][m][1] + bv[bj][1];
#pragma unroll
                        for (int q = 0; q < 4; ++q) { v0[q] = sigmoidf_fast(v0[q]); v1[q] = sigmoidf_fast(v1[q]); }
                        u32x4 w; w.x = cvt_pk_bf16(v0[0], v0[1]); w.y = cvt_pk_bf16(v0[2], v0[3]); w.z = cvt_pk_bf16(v1[0], v1[1]); w.w = cvt_pk_bf16(v1[2], v1[3]);
                        *(u32x4*)(rowp + bj * HALF) = w;
                        if (DBG_P1_TO_MIXED == 2 && u.pn >= 32) *(u32x4*)(dbg + (size_t)(row0 + ai * HALF + m * 16) * 2048 + (u.pn - 32) * BM + wc * 32 + 8 * fq + bj * HALF) = w; } }
        }
    }
};
struct EpiMix {
    static constexpr bool PERM = true, AFTER_DRAIN = false;
    const bf16_t* gates; float* part; bf16_t* mixed;
    __device__ __forceinline__ void operator()(const f32x4 (&acc)[2][2][4][2], const Unit& u, int wr, int wc, int fr, int fq) const {
        const int row0 = u.pm * BM + wr * 64 + fr, col0 = u.pn * BM + wc * 32 + 8 * fq; const int goff = (u.aux || DBG_P3_SINGLE) ? 2048 : 0;
#pragma unroll
        for (int ai = 0; ai < 2; ++ai)
#pragma unroll
            for (int m = 0; m < 4; ++m) { const size_t row = (size_t)(row0 + ai * HALF + m * 16);
#pragma unroll
                for (int bj = 0; bj < 2; ++bj) { const int c = col0 + bj * HALF;
                    const u32x4 g = DBG_NO_GATE_LOAD ? (u32x4){0x3f803f80u, 0x3f803f80u, 0x3f803f80u, 0x3f803f80u} : DBG_GATES_FROM_COPY ? *(const u32x4*)((const bf16_t*)part + row * 2048 + c) : *(const u32x4*)(gates + row * 4096 + goff + c);
                    const f32x4 a0 = acc[ai][bj][m][0], a1 = acc[ai][bj][m][1];
                    f32x4 r0 = {bf_lo(g.x) * a0[0], bf_hi(g.x) * a0[1], bf_lo(g.y) * a0[2], bf_hi(g.y) * a0[3]};
                    f32x4 r1 = {bf_lo(g.z) * a1[0], bf_hi(g.z) * a1[1], bf_lo(g.w) * a1[2], bf_hi(g.w) * a1[3]};
                    float* pp = part + row * 2048 + c;
                    if (DBG_P3_SINGLE) { u32x4 w; w.x = cvt_pk_bf16(r0[0], r0[1]); w.y = cvt_pk_bf16(r0[2], r0[3]); w.z = cvt_pk_bf16(r1[0], r1[1]); w.w = cvt_pk_bf16(r1[2], r1[3]); *(u32x4*)(mixed + row * 2048 + c) = w; }
                    else if (u.aux == 0) { if (DBG_MIX_MODE == 2) { r0 = (f32x4){0.f, 0.f, 0.f, 0.f}; r1 = r0; } *(f32x4*)pp = r0; *(f32x4*)(pp + 4) = r1; }
                    else { if (DBG_MIX_MODE == 1) { r0 = (f32x4){0.f, 0.f, 0.f, 0.f}; r1 = r0; } r0 += *(const f32x4*)pp; r1 += *(const f32x4*)(pp + 4);
                        u32x4 w; w.x = cvt_pk_bf16(r0[0], r0[1]); w.y = cvt_pk_bf16(r0[2], r0[3]); w.z = cvt_pk_bf16(r1[0], r1[1]); w.w = cvt_pk_bf16(r1[2], r1[3]);
                        *(u32x4*)(mixed + row * 2048 + c) = w; } } }
    }
};
struct EpiResid {
    static constexpr bool PERM = false, AFTER_DRAIN = false;
    const float* x; float* x1;
    __device__ __forceinline__ void operator()(const f32x4 (&acc)[2][2][4][2], const Unit& u, int wr, int wc, int fr, int fq) const {
        const int row0 = u.pm * BM + wr * 64 + fr, col0 = u.pn * BM + wc * 32 + 4 * fq;
#pragma unroll
        for (int ai = 0; ai < 2; ++ai)
#pragma unroll
            for (int m = 0; m < 4; ++m) { const size_t off = (size_t)(row0 + ai * HALF + m * 16) * 2048 + col0;
#pragma unroll
                for (int bj = 0; bj < 2; ++bj)
#pragma unroll
                    for (int n = 0; n < 2; ++n) *(f32x4*)(x1 + off + bj * HALF + n * 16) = *(const f32x4*)(x + off + bj * HALF + n * 16) + acc[ai][bj][m][n]; }
    }
};
__device__ __forceinline__ float swiglu1(float g, float l) {
    g = fminf(g, 7.0f); l = fminf(fmaxf(l, -7.0f), 7.0f);
    return g * sigmoidf_fast(1.702f * g) * (l + 1.0f);
}
struct EpiSwiglu {
    static constexpr bool PERM = true, AFTER_DRAIN = false;
    const float* b1; bf16_t* H;
    __device__ __forceinline__ void operator()(const f32x4 (&acc)[2][2][4][2], const Unit& u, int wr, int wc, int fr, int fq) const {
        const int row0 = u.pm * BM + wr * 64 + fr, c0 = u.pn * BM + wc * 32 + 8 * fq; const float* be = b1 + (size_t)u.aux * 4096 + c0;
        f32x4 bv[2][2];
#pragma unroll
        for (int bj = 0; bj < 2; ++bj)
#pragma unroll
            for (int n = 0; n < 2; ++n) bv[bj][n] = *(const f32x4*)(be + bj * HALF + 4 * n);
#pragma unroll
        for (int ai = 0; ai < 2; ++ai)
#pragma unroll
            for (int m = 0; m < 4; ++m) { bf16_t* rowp = H + (size_t)(row0 + ai * HALF + m * 16) * 2048 + (c0 >> 1);
#pragma unroll
                for (int bj = 0; bj < 2; ++bj) { const f32x4 v0 = acc[ai][bj][m][0] + bv[bj][0], v1 = acc[ai][bj][m][1] + bv[bj][1];
                    u32x2 w; w.x = cvt_pk_bf16(swiglu1(v0[0], v0[1]), swiglu1(v0[2], v0[3])); w.y = cvt_pk_bf16(swiglu1(v1[0], v1[1]), swiglu1(v1[2], v1[3]));
                    *(u32x2*)(rowp + bj * (HALF / 2)) = w; } }
    }
};
struct EpiMoeOut {
    static constexpr bool PERM = true, AFTER_DRAIN = false;
    static constexpr int T4 = 8192 * 4;
    const float* b2; const int* slot_tok; const float* slot_w; const PG8_LAS int* cnt; bf16_t* Y; int cap;
    __device__ __forceinline__ void operator()(const f32x4 (&acc)[2][2][4][2], const Unit& u, int wr, int wc, int fr, int fq) const {
        const int e = u.aux, row0 = u.pm * BM + wr * 64 + fr, c0 = u.pn * BM + wc * 32 + 8 * fq; const float* be = b2 + (size_t)e * 2048 + c0;
        const int lim = e * cap + cnt[e];
        f32x4 bv[2][2];
#pragma unroll
        for (int bj = 0; bj < 2; ++bj)
#pragma unroll
            for (int n = 0; n < 2; ++n) bv[bj][n] = *(const f32x4*)(be + bj * HALF + 4 * n);
#pragma unroll
        for (int ai = 0; ai < 2; ++ai)
#pragma unroll
            for (int m = 0; m < 4; ++m) { const int row = row0 + ai * HALF + m * 16;
                const int tk0 = slot_tok[row]; const float w8 = slot_w[row];
                const int tk = row < lim ? (tk0 & (T4 - 1)) : T4;
                bf16_t* rowp = Y + (size_t)(unsigned)tk * 2048 + c0;
#pragma unroll
                for (int bj = 0; bj < 2; ++bj) { const f32x4 v0 = (acc[ai][bj][m][0] + bv[bj][0]) * w8, v1 = (acc[ai][bj][m][1] + bv[bj][1]) * w8;
                    u32x4 w; w.x = cvt_pk_bf16(v0[0], v0[1]); w.y = cvt_pk_bf16(v0[2], v0[3]); w.z = cvt_pk_bf16(v1[0], v1[1]); w.w = cvt_pk_bf16(v1[2], v1[3]);
                    *(u32x4*)(rowp + bj * HALF) = w; } }
    }
};

template <class Epi, class Sched, bool ALIGN_EPI = false, bool SP2 = false>
__device__ __forceinline__ void gemm_phase(PG8_LAS unsigned char* lds, const int K, const Sched& S, const Epi& E) {
    int tid = threadIdx.x; asm volatile("" : "+v"(tid));
    const int wid = __builtin_amdgcn_readfirstlane(tid >> 6), lane = tid & 63, wr = wid >> 2, wc = wid & 3, fr = lane & 15, fq = lane >> 4;
    const int nt = K / BK;
    unsigned voffA[2], voffB[2];
#pragma unroll
    for (int i = 0; i < 2; ++i) { int R, C; stage_rc(tid * 16 + i * 8192, R, C); const int Rb = Epi::PERM ? ((R & ~31) + perm32(R & 31)) : R;
        voffA[i] = (unsigned)(R * K + C) * 2u; voffB[i] = (unsigned)(Rb * K + C) * 2u; }
    const size_t kstep = (size_t)(BK * 2);
    const size_t hstep = (size_t)HALF * K * 2;
    const unsigned ldsw = (unsigned)wid * 1024u;
    const int aoff = lds_byte(wr * 64 + fr, fq * 8), boff = lds_byte(wc * 32 + fr, fq * 8);
#define PG8_SA(b, h) (((b) * 2 + (h)) * HTB)
#define PG8_SB(b, h) ((4 + (b) * 2 + (h)) * HTB)
#define PG8_STAGE(bufoff, gbase, voff) do { _Pragma("unroll") for (int _i = 0; _i < 2; ++_i) \
        __builtin_amdgcn_global_load_lds((const unsigned*)((const char*)(gbase) + (voff)[_i]), (PG8_LAS unsigned*)(lds + (bufoff) + ldsw + _i * 8192), 16, 0, 0); } while (0)
#define PG8_LDA(dst, b, h) do { _Pragma("unroll") for (int m = 0; m < 4; ++m) _Pragma("unroll") for (int k = 0; k < 2; ++k) dst[m][k] = *(const PG8_LAS bf16x8*)(lds + PG8_SA(b, h) + aoff + m * 2048 + k * 1024); } while (0)
#define PG8_LDB(dst, b, h) do { _Pragma("unroll") for (int n = 0; n < 2; ++n) _Pragma("unroll") for (int k = 0; k < 2; ++k) dst[n][k] = *(const PG8_LAS bf16x8*)(lds + PG8_SB(b, h) + boff + n * 2048 + k * 1024); } while (0)
#define PG8_MMA(ai, bj, At, Bt) do { __builtin_amdgcn_s_setprio(1); _Pragma("unroll") for (int m = 0; m < 4; ++m) _Pragma("unroll") for (int n = 0; n < 2; ++n) _Pragma("unroll") for (int k = 0; k < 2; ++k) \
        acc[ai][bj][m][n] = __builtin_amdgcn_mfma_f32_16x16x32_bf16(Bt[n][k], At[m][k], acc[ai][bj][m][n], 0, 0, 0); __builtin_amdgcn_s_setprio(0); } while (0)
#define PG8_WAIT_V(n) asm volatile("s_waitcnt vmcnt(" #n ")" ::: "memory")
#define PG8_WAIT_L(n) asm volatile("s_waitcnt lgkmcnt(" #n ")" ::: "memory")
#define PG8_BAR __builtin_amdgcn_s_barrier()
#define PG8_SCHED __builtin_amdgcn_sched_barrier(0)
    Unit cur, nxt; int ui = 0;
    if (!S.next(0, cur)) return;
    f32x4 acc[2][2][4][2];
#pragma unroll
    for (int a = 0; a < 2; ++a)
#pragma unroll
        for (int b = 0; b < 2; ++b)
#pragma unroll
            for (int m = 0; m < 4; ++m)
#pragma unroll
                for (int n = 0; n < 2; ++n) acc[a][b][m][n] = (f32x4){0.f, 0.f, 0.f, 0.f};
    bf16x8 At[4][2], B0[2][2], B1[2][2];
    const char* cA = cur.a; const char* cB = cur.b;
    S.a_ready(cur);
    if constexpr (SP2) {
        PG8_STAGE(PG8_SB(0, 0), cB, voffB); PG8_STAGE(PG8_SB(0, 1), cB + hstep, voffB); PG8_STAGE(PG8_SA(0, 0), cA, voffA); PG8_STAGE(PG8_SA(0, 1), cA + hstep, voffA);
        if (wr == 1) PG8_BAR;
        PG8_WAIT_V(2); PG8_BAR;
        PG8_STAGE(PG8_SB(1, 0), cB + kstep, voffB); PG8_STAGE(PG8_SA(1, 0), cA + kstep, voffA); PG8_STAGE(PG8_SB(1, 1), cB + hstep + kstep, voffB);
        PG8_WAIT_V(6); PG8_BAR;
    } else {
        PG8_STAGE(PG8_SB(0, 0), cB, voffB); PG8_STAGE(PG8_SA(0, 0), cA, voffA); PG8_STAGE(PG8_SB(0, 1), cB + hstep, voffB); PG8_STAGE(PG8_SA(0, 1), cA + hstep, voffA);
        if (wr == 1) PG8_BAR;
        PG8_WAIT_V(4); PG8_BAR;
        PG8_STAGE(PG8_SB(1, 0), cB + kstep, voffB); PG8_STAGE(PG8_SA(1, 0), cA + kstep, voffA); PG8_STAGE(PG8_SB(1, 1), cB + hstep + kstep, voffB);
        PG8_WAIT_V(6); PG8_BAR;
    }
    for (;;) {
        const bool has_next = S.next(ui + 1, nxt);
        const char* nA = has_next ? nxt.a : cA; const char* nB = has_next ? nxt.b : cB;
        for (int t = 0; t < nt; t += 2) {
            const bool last = (t == nt - 2);
            const char* a1 = cA + (size_t)(t + 1) * kstep;
            const char* a2 = last ? nA : cA + (size_t)(t + 2) * kstep; const char* b2 = last ? nB : cB + (size_t)(t + 2) * kstep;
            const char* a3 = a2 + kstep; const char* b3 = b2 + kstep;
            if (last && has_next) S.a_ready(nxt);
            if constexpr (SP2) {
            PG8_LDB(B0, 0, 0); PG8_LDB(B1, 0, 1); PG8_SCHED; PG8_LDA(At, 0, 0); PG8_STAGE(PG8_SA(1, 1), a1 + hstep, voffA);
            PG8_WAIT_V(8); PG8_WAIT_L(0); PG8_BAR; PG8_MMA(0, 0, At, B0); PG8_MMA(0, 1, At, B1); PG8_BAR; PG8_SCHED;
            PG8_LDA(At, 0, 1); PG8_STAGE(PG8_SB(0, 0), b2, voffB); PG8_STAGE(PG8_SB(0, 1), b2 + hstep, voffB); PG8_STAGE(PG8_SA(0, 0), a2, voffA);
            PG8_WAIT_V(8); PG8_WAIT_L(0); PG8_BAR; PG8_MMA(1, 0, At, B0); PG8_MMA(1, 1, At, B1); PG8_BAR; PG8_SCHED;
            PG8_LDB(B0, 1, 0); PG8_LDB(B1, 1, 1); PG8_SCHED; PG8_LDA(At, 1, 0); PG8_STAGE(PG8_SA(0, 1), a2 + hstep, voffA);
            PG8_WAIT_V(8); PG8_WAIT_L(0); PG8_BAR; PG8_MMA(0, 0, At, B0); PG8_MMA(0, 1, At, B1); PG8_BAR; PG8_SCHED;
            PG8_LDA(At, 1, 1); PG8_STAGE(PG8_SB(1, 0), b3, voffB); PG8_STAGE(PG8_SB(1, 1), b3 + hstep, voffB); PG8_STAGE(PG8_SA(1, 0), a3, voffA);
            PG8_WAIT_V(8); PG8_WAIT_L(0); PG8_BAR; PG8_MMA(1, 0, At, B0); PG8_MMA(1, 1, At, B1); PG8_BAR; PG8_SCHED;
            } else {
            PG8_LDB(B0, 0, 0); PG8_SCHED; PG8_LDA(At, 0, 0); PG8_STAGE(PG8_SA(1, 1), a1 + hstep, voffA);
            PG8_WAIT_L(8); PG8_BAR; PG8_WAIT_L(0); PG8_MMA(0, 0, At, B0); PG8_BAR; PG8_SCHED;
            PG8_LDB(B1, 0, 1); PG8_STAGE(PG8_SB(0, 0), b2, voffB);
            PG8_BAR; PG8_WAIT_L(0); PG8_MMA(0, 1, At, B1); PG8_BAR;
            PG8_LDA(At, 0, 1); PG8_STAGE(PG8_SA(0, 0), a2, voffA);
            PG8_BAR; PG8_WAIT_L(0); PG8_MMA(1, 0, At, B0); PG8_BAR; PG8_SCHED;
            PG8_STAGE(PG8_SB(0, 1), b2 + hstep, voffB);
            PG8_WAIT_V(6); PG8_BAR; PG8_MMA(1, 1, At, B1); PG8_BAR;
            PG8_LDB(B0, 1, 0); PG8_SCHED; PG8_LDA(At, 1, 0); PG8_STAGE(PG8_SA(0, 1), a2 + hstep, voffA);
            PG8_WAIT_L(8); PG8_BAR; PG8_WAIT_L(0); PG8_MMA(0, 0, At, B0); PG8_BAR; PG8_SCHED;
            PG8_LDB(B1, 1, 1); PG8_STAGE(PG8_SB(1, 0), b3, voffB);
            PG8_BAR; PG8_WAIT_L(0); PG8_MMA(0, 1, At, B1); PG8_BAR;
            PG8_LDA(At, 1, 1); PG8_STAGE(PG8_SA(1, 0), a3, voffA);
            PG8_BAR; PG8_WAIT_L(0); PG8_MMA(1, 0, At, B0); PG8_BAR; PG8_SCHED;
            PG8_STAGE(PG8_SB(1, 1), b3 + hstep, voffB);
            PG8_WAIT_V(6); PG8_BAR; PG8_MMA(1, 1, At, B1); PG8_BAR;
            }
        }
        if constexpr (ALIGN_EPI) { if (wr == 0) PG8_BAR; }
        if constexpr (!Epi::AFTER_DRAIN) { E(acc, cur, wr, wc, fr, fq); S.done(cur); }
        if (!has_next) break;
#pragma unroll
        for (int a = 0; a < 2; ++a)
#pragma unroll
            for (int b = 0; b < 2; ++b)
#pragma unroll
                for (int m = 0; m < 4; ++m)
#pragma unroll
                    for (int n = 0; n < 2; ++n) acc[a][b][m][n] = (f32x4){0.f, 0.f, 0.f, 0.f};
        cur = nxt; cA = nA; cB = nB; ++ui;
        if constexpr (ALIGN_EPI) { if (wr == 1) PG8_BAR; }
    }
    PG8_WAIT_V(0);
    if constexpr (!ALIGN_EPI) { if (wr == 0) PG8_BAR; }
    PG8_BAR;
    if constexpr (Epi::AFTER_DRAIN) { E.fused(acc, cur, wr, wc, fr, fq, lds, wid, lane); S.done(cur); }
#undef PG8_SA
#undef PG8_SB
#undef PG8_STAGE
#undef PG8_LDA
#undef PG8_LDB
#undef PG8_MMA
#undef PG8_WAIT_V
#undef PG8_WAIT_L
#undef PG8_BAR
#undef PG8_SCHED
}
}

namespace att {
#define ALAS __attribute__((address_space(3)))
typedef short bf16x8 __attribute__((ext_vector_type(8)));
typedef short s16x4 __attribute__((ext_vector_type(4)));
typedef float f32x16 __attribute__((ext_vector_type(16)));
typedef float f32x4 __attribute__((ext_vector_type(4)));
typedef unsigned u32x4 __attribute__((ext_vector_type(4)));
typedef unsigned short bf16_t;
typedef ALAS char* ALAS_char_ptr;
constexpr int D = 128, PITCH = 1024, NW = 8, QBLK = 32, KVBLK = 64, QB = NW * QBLK, SEQ = 8192;
constexpr int SHM = KVBLK * D * 2;
constexpr int OFF_V = 0, OFF_K = 2 * SHM, OFF_WS = 4 * SHM, OFF_G = OFF_WS + NW * 64 * 4, OFF_FLAG = OFF_G + SEQ * 4, LDS_BYTES = OFF_FLAG + 128;
constexpr float SCALE = 0.08838834764831845f, LOG2E = 1.4426950408889634f, C2 = SCALE * LOG2E;
constexpr float THR2 = 10.0f;
constexpr float SB_EXIT = 152.0f;

#define KSWZ(row, colB) ((row) * 256 + ((colB) ^ (((row) & 7) << 4)))
#define ASBAR() __builtin_amdgcn_sched_barrier(0)
__device__ __forceinline__ int v_st(int k, int c) { const int kk = (k & ~0xC) | ((k & 4) << 1) | ((k & 8) >> 1); return ((kk >> 3) * 4 + (c >> 5)) * 512 + ((kk & 7) * 32 + (c & 31)) * 2; }
__device__ __forceinline__ int v_rd_base(int lane) { return ((lane & 3) << 3) | (((lane >> 2) & 3) << 6) | (((lane >> 4) & 1) << 5) | (((lane >> 5) & 1) << 8); }
constexpr int v_rd_off(int d0, int ks, int half) { return d0 * 512 + ks * 4096 + half * 2048; }
__device__ __forceinline__ int crow(int r, int hi) { return (r & 3) + 8 * (r >> 2) + 4 * hi; }
__device__ __forceinline__ unsigned cvtpk(float lo, float hi) { return pg8::cvt_pk_bf16(lo, hi); }

struct Stage { bf16x8 k0, k1, v0, v1; };
__device__ __forceinline__ void sload(Stage& S, const bf16_t* Kh, const bf16_t* Vh, int kbase, unsigned loff) {
    const char* Kt = (const char*)Kh + (size_t)kbase * PITCH * 2; const char* Vt = (const char*)Vh + (size_t)kbase * PITCH * 2;
    S.v0 = *(const bf16x8*)(Vt + loff); S.v1 = *(const bf16x8*)(Vt + (loff + 32u * PITCH * 2u));
    S.k0 = *(const bf16x8*)(Kt + loff); S.k1 = *(const bf16x8*)(Kt + (loff + 32u * PITCH * 2u));
}
__device__ __forceinline__ void swrite(const Stage& S, ALAS char* lds, int buf, int kws, int vst0, int vst1) {
    *(ALAS bf16x8*)(lds + OFF_K + buf * SHM + kws) = S.k0; *(ALAS bf16x8*)(lds + OFF_K + buf * SHM + kws + 32 * 256) = S.k1;
    *(ALAS bf16x8*)(lds + OFF_V + buf * SHM + vst0) = S.v0; *(ALAS bf16x8*)(lds + OFF_V + buf * SHM + vst1) = S.v1;
}
__device__ __forceinline__ void qkt(f32x16& p0, f32x16& p1, const ALAS char* Kb, int r32, int hi, const bf16x8* qr) {
    p0 = f32x16{}; p1 = f32x16{};
    const ALAS char* kb[4];
#pragma unroll
    for (int dd = 0; dd < 4; ++dd) kb[dd] = Kb + KSWZ(r32, (dd * 16 + hi * 8) * 2);
#pragma unroll
    for (int d0 = 0; d0 < 8; ++d0) { const ALAS char* a = kb[d0 & 3] + (d0 >> 2) * 128;
        const bf16x8 b0 = *(const ALAS bf16x8*)a;
        const bf16x8 b1 = *(const ALAS bf16x8*)(a + 32 * 256);
        p0 = __builtin_amdgcn_mfma_f32_32x32x16_bf16(b0, qr[d0], p0, 0, 0, 0);
        p1 = __builtin_amdgcn_mfma_f32_32x32x16_bf16(b1, qr[d0], p1, 0, 0, 0); }
}
__device__ __forceinline__ void pv_tile(f32x16* o, int vb, bf16x8 pa0, bf16x8 pa1, bf16x8 pa2, bf16x8 pa3) {
#define TRRD(dst, off) asm volatile("ds_read_b64_tr_b16 %0, %1 offset:%2" : "=&v"(dst) : "v"(vb), "i"(off) : "memory")
#define PV_D0(d0) do { s16x4 l0, l1, l2, l3, h0, h1, h2, h3; constexpr int b_ = v_rd_off(d0, 0, 0); \
        TRRD(l0, b_); TRRD(h0, b_ + 2048); TRRD(l1, b_ + 4096); TRRD(h1, b_ + 6144); TRRD(l2, b_ + 8192); TRRD(h2, b_ + 10240); TRRD(l3, b_ + 12288); TRRD(h3, b_ + 14336); \
        asm volatile("s_waitcnt lgkmcnt(0)" ::: "memory"); ASBAR(); \
        o[d0] = __builtin_amdgcn_mfma_f32_32x32x16_bf16(pa0, (bf16x8){l0[0], l0[1], l0[2], l0[3], h0[0], h0[1], h0[2], h0[3]}, o[d0], 0, 0, 0);   \
        o[d0] = __builtin_amdgcn_mfma_f32_32x32x16_bf16(pa1, (bf16x8){l1[0], l1[1], l1[2], l1[3], h1[0], h1[1], h1[2], h1[3]}, o[d0], 0, 0, 0);   \
        o[d0] = __builtin_amdgcn_mfma_f32_32x32x16_bf16(pa2, (bf16x8){l2[0], l2[1], l2[2], l2[3], h2[0], h2[1], h2[2], h2[3]}, o[d0], 0, 0, 0);   \
        o[d0] = __builtin_amdgcn_mfma_f32_32x32x16_bf16(pa3, (bf16x8){l3[0], l3[1], l3[2], l3[3], h3[0], h3[1], h3[2], h3[3]}, o[d0], 0, 0, 0); } while (0)
    PV_D0(0); PV_D0(1); PV_D0(2); PV_D0(3);
#undef PV_D0
#undef TRRD
}
__device__ __forceinline__ void pack_p(const f32x16& p0, const f32x16& p1, bf16x8& pa0, bf16x8& pa1, bf16x8& pa2, bf16x8& pa3) {
#define PK4(P, B_, OUT) do { unsigned a0 = cvtpk(P[B_+0], P[B_+1]), a1 = cvtpk(P[B_+2], P[B_+3]);                          \
        unsigned b0 = cvtpk(P[B_+4], P[B_+5]), b1 = cvtpk(P[B_+6], P[B_+7]);                                             \
        auto r0 = __builtin_amdgcn_permlane32_swap(a0, b0, false, false); auto r1 = __builtin_amdgcn_permlane32_swap(a1, b1, false, false); \
        u32x4 w = {r0[0], r1[0], r0[1], r1[1]}; OUT = *reinterpret_cast<bf16x8*>(&w); } while (0)
    PK4(p0, 0, pa0); PK4(p0, 8, pa1); PK4(p1, 0, pa2); PK4(p1, 8, pa3);
#undef PK4
}
__device__ __forceinline__ void store_o(const f32x16* o, const float* rs, bf16_t* Ow  , int r32, int hi) {
    const unsigned lo = (unsigned)((4 * hi * PITCH + r32) * 2);
#pragma unroll
    for (int r = 0; r < 16; ++r) { const int orow0 = (r & 3) + 8 * (r >> 2);
#pragma unroll
        for (int d0 = 0; d0 < 4; ++d0) { const float v = o[d0][r] * rs[r]; const float vn = __shfl_xor(v, 1);
            if ((r32 & 1) == 0) *(unsigned*)((char*)Ow + (lo + (unsigned)((orow0 * PITCH + d0 * 32) * 2))) = cvtpk(v, vn); } }
}

__device__ __forceinline__ void fox_unit(const bf16_t* Qh, const bf16_t* Kh, const bf16_t* Vh, bf16_t* Oh, const float* Gh, int qb, ALAS char* lds) {
    int tid = threadIdx.x; asm volatile("" : "+v"(tid));
    const int wid = __builtin_amdgcn_readfirstlane(tid >> 6), lane = tid & 63, r32 = lane & 31, hi = lane >> 5;
    const int P0 = qb * QB, NT = 4 * (qb + 1);
    const int sr = tid >> 4, sc = (tid & 15) * 8, vst0 = v_st(sr, sc), vst1 = v_st(32 + sr, sc), kws = KSWZ(sr, sc * 2); const unsigned loff = (unsigned)((sr * PITCH + sc) * 2);
    const int vb0 = (int)(unsigned)(size_t)(lds + OFF_V) + v_rd_base(lane);
    ALAS float* wsf = (ALAS float*)(lds + OFF_WS) + wid * 64; ALAS float* li_l = wsf; ALAS float* al_l = wsf + 32;
    ALAS float* Gl = (ALAS float*)(lds + OFF_G);
    for (int i = tid; i < (P0 + QB) / 4; i += NW * 64) ((ALAS f32x4*)Gl)[i] = *(const f32x4*)((const char*)Gh + (unsigned)(i * 16));
    bf16x8 qr[8];
#pragma unroll
    for (int d0 = 0; d0 < 8; ++d0) qr[d0] = *(const bf16x8*)((const char*)Qh + (size_t)P0 * PITCH * 2 + (unsigned)(((wid * QBLK + r32) * PITCH + hi * 8) * 2 + d0 * 32));
    Stage S; sload(S, Kh, Vh, (NT - 1) * KVBLK, loff);
    asm volatile("s_waitcnt vmcnt(0)" ::: "memory"); swrite(S, lds, 0, kws, vst0, vst1);
    __syncthreads();
    const float Gref = Gl[P0 + QB - 1];
    float m_reg = -1e30f, l_reg = 0.f; f32x16 o[4] = {};
    const int qlo = P0 + wid * QBLK, qm = qlo + r32 - 4 * hi;
    for (int t = 0; t < NT; ++t) {
        const int buf = t & 1, kb = (NT - 1 - t) * KVBLK;
        if (t + 1 < NT) sload(S, Kh, Vh, kb - KVBLK, loff);
        ASBAR();
        if (kb <= qlo + QBLK - 1) {
            f32x16 p0, p1;
            qkt(p0, p1, lds + OFF_K + buf * SHM, r32, hi, qr);
#pragma unroll
            for (int g = 0; g < 4; ++g) { const f32x4 b0 = *(const ALAS f32x4*)(Gl + kb + 8 * g + 4 * hi), b1 = *(const ALAS f32x4*)(Gl + kb + 32 + 8 * g + 4 * hi);
#pragma unroll
                for (int i = 0; i < 4; ++i) { p0[4 * g + i] = fmaf(p0[4 * g + i], C2, Gref - b0[i]); p1[4 * g + i] = fmaf(p1[4 * g + i], C2, Gref - b1[i]); } }
            if (kb + KVBLK - 1 > qlo) {
                const int dq = qm - kb; const float NEG = -__builtin_inff();
#pragma unroll
                for (int r = 0; r < 16; ++r) { const int c = (r & 3) + 8 * (r >> 2); if (dq - c < 0) p0[r] = NEG; if (dq - c - 32 < 0) p1[r] = NEG; }
            }
            float pmax = p0[0];
#pragma unroll
            for (int r = 1; r < 16; ++r) pmax = fmaxf(pmax, p0[r]);
#pragma unroll
            for (int r = 0; r < 16; ++r) pmax = fmaxf(pmax, p1[r]);
            { auto rr = __builtin_amdgcn_permlane32_swap(__float_as_uint(pmax), __float_as_uint(pmax), false, false); pmax = fmaxf(__uint_as_float(rr[0]), __uint_as_float(rr[1])); }
            float mn, alpha;
            if (__all(pmax - m_reg <= THR2)) { mn = m_reg; alpha = 1.f; }
            else { mn = fmaxf(m_reg, pmax); alpha = __builtin_amdgcn_exp2f(m_reg - mn); m_reg = mn; }
            float ps = 0.f;
#pragma unroll
            for (int r = 0; r < 16; ++r) { p0[r] = __builtin_amdgcn_exp2f(p0[r] - mn); ps += p0[r]; }
#pragma unroll
            for (int r = 0; r < 16; ++r) { p1[r] = __builtin_amdgcn_exp2f(p1[r] - mn); ps += p1[r]; }
            { auto rr = __builtin_amdgcn_permlane32_swap(__float_as_uint(ps), __float_as_uint(ps), false, false); ps = __uint_as_float(rr[0]) + __uint_as_float(rr[1]); }
            l_reg = l_reg * alpha + ps;
            bf16x8 pa0, pa1, pa2, pa3; pack_p(p0, p1, pa0, pa1, pa2, pa3);
            if (__any(alpha < 1.f)) { if (hi == 0) al_l[r32] = alpha; asm volatile("s_waitcnt lgkmcnt(0)" ::: "memory");
#pragma unroll
                for (int d_ = 0; d_ < 4; ++d_)
#pragma unroll
                    for (int r = 0; r < 16; ++r) o[d_][r] *= al_l[crow(r, hi)]; }
            ASBAR();
            pv_tile(o, vb0 + buf * SHM, pa0, pa1, pa2, pa3);
        }
        if (t + 1 < NT) { asm volatile("s_waitcnt vmcnt(0)" ::: "memory"); swrite(S, lds, buf ^ 1, kws, vst0, vst1); }
        __syncthreads();
    }
    if (hi == 0) li_l[r32] = l_reg; asm volatile("s_waitcnt lgkmcnt(0)" ::: "memory");
    float rli[16];
#pragma unroll
    for (int r = 0; r < 16; ++r) rli[r] = __builtin_amdgcn_rcpf(li_l[crow(r, hi)]);
    store_o(o, rli, Oh + (size_t)(P0 + wid * QBLK) * PITCH, r32, hi);
    __syncthreads();
}

__device__ __forceinline__ float softplus2(float u) { return fmaxf(u, 0.f) + __builtin_amdgcn_logf(1.0f + __builtin_amdgcn_exp2f(-fabsf(u))); }
__device__ __forceinline__ void sb_unit(const bf16_t* Qh, const bf16_t* Kh, const bf16_t* Vh, bf16_t* Oh, int qb, ALAS char* lds) {
    int tid = threadIdx.x; asm volatile("" : "+v"(tid));
    const int wid = __builtin_amdgcn_readfirstlane(tid >> 6), lane = tid & 63, r32 = lane & 31, hi = lane >> 5;
    const int P0 = qb * QB, NT = 4 * (qb + 1);
    const int sr = tid >> 4, sc = (tid & 15) * 8, vst0 = v_st(sr, sc), vst1 = v_st(32 + sr, sc), kws = KSWZ(sr, sc * 2); const unsigned loff = (unsigned)((sr * PITCH + sc) * 2);
    const int vb0 = (int)(unsigned)(size_t)(lds + OFF_V) + v_rd_base(lane);
    ALAS int* flg = (ALAS int*)(lds + OFF_FLAG);
    bf16x8 qr[8];
#pragma unroll
    for (int d0 = 0; d0 < 8; ++d0) qr[d0] = *(const bf16x8*)((const char*)Qh + (size_t)P0 * PITCH * 2 + (unsigned)(((wid * QBLK + r32) * PITCH + hi * 8) * 2 + d0 * 32));
    Stage S; sload(S, Kh, Vh, (NT - 1) * KVBLK, loff);
    asm volatile("s_waitcnt vmcnt(0)" ::: "memory"); swrite(S, lds, 0, kws, vst0, vst1);
    __syncthreads();
    float carry = 0.f; f32x16 o[4] = {};
    const int qlo = P0 + wid * QBLK, qm = qlo + r32 - 4 * hi;
    for (int t = 0; t < NT; ++t) {
        const int buf = t & 1, kb = (NT - 1 - t) * KVBLK;
        if (t + 1 < NT) sload(S, Kh, Vh, kb - KVBLK, loff);
        ASBAR();
        if (kb < qlo + QBLK - 1) {
            f32x16 p0, p1, s0, s1;
            qkt(p0, p1, lds + OFF_K + buf * SHM, r32, hi, qr);
            const int dq = qm - kb - 1;
#pragma unroll
            for (int r = 0; r < 16; ++r) { const int c = (r & 3) + 8 * (r >> 2);
                p0[r] *= C2; p1[r] *= C2;
                s0[r] = (dq - c < 0) ? 0.f : softplus2(p0[r]); s1[r] = (dq - c - 32 < 0) ? 0.f : softplus2(p1[r]); }
#pragma unroll
            for (int g = 0; g < 4; ++g) { s0[4 * g + 2] += s0[4 * g + 3]; s0[4 * g + 1] += s0[4 * g + 2]; s0[4 * g] += s0[4 * g + 1];
                                          s1[4 * g + 2] += s1[4 * g + 3]; s1[4 * g + 1] += s1[4 * g + 2]; s1[4 * g] += s1[4 * g + 1]; }
            float e0[4], e1[4], running = carry;
#pragma unroll
            for (int g = 3; g >= 0; --g) { auto rb = __builtin_amdgcn_permlane32_swap(__float_as_uint(s1[4 * g]), __float_as_uint(s1[4 * g]), false, false);
                const float eh = running; running += __uint_as_float(rb[1]); const float el = running; running += __uint_as_float(rb[0]); e1[g] = hi ? eh : el; }
#pragma unroll
            for (int g = 3; g >= 0; --g) { auto ra = __builtin_amdgcn_permlane32_swap(__float_as_uint(s0[4 * g]), __float_as_uint(s0[4 * g]), false, false);
                const float eh = running; running += __uint_as_float(ra[1]); const float el = running; running += __uint_as_float(ra[0]); e0[g] = hi ? eh : el; }
            carry = running;
#pragma unroll
            for (int g = 0; g < 4; ++g) {
#pragma unroll
                for (int i = 0; i < 4; ++i) { const int r = 4 * g + i, c = (r & 3) + 8 * (r >> 2);
                    p0[r] = (dq - c < 0) ? 0.f : __builtin_amdgcn_exp2f(p0[r] - (e0[g] + s0[r]));
                    p1[r] = (dq - c - 32 < 0) ? 0.f : __builtin_amdgcn_exp2f(p1[r] - (e1[g] + s1[r])); } }
            bf16x8 pa0, pa1, pa2, pa3; pack_p(p0, p1, pa0, pa1, pa2, pa3);
            ASBAR();
            pv_tile(o, vb0 + buf * SHM, pa0, pa1, pa2, pa3);
        }
        const bool done_w = __all(carry > SB_EXIT);
        if (lane == 0) flg[buf * 8 + wid] = done_w ? 1 : 0;
        if (t + 1 < NT) { asm volatile("s_waitcnt vmcnt(0)" ::: "memory"); swrite(S, lds, buf ^ 1, kws, vst0, vst1); }
        __syncthreads();
        int all_done = 1;
#pragma unroll
        for (int w = 0; w < NW; ++w) all_done &= flg[buf * 8 + w];
        if (all_done) break;
    }
    float one[16];
#pragma unroll
    for (int r = 0; r < 16; ++r) one[r] = 1.f;
    store_o(o, one, Oh + (size_t)(P0 + wid * QBLK) * PITCH, r32, hi);
    __syncthreads();
}
#undef KSWZ
#undef ASBAR
}

constexpr int NWAVES = 8;
constexpr int N_LAUNCHES = MK_N_LAUNCHES;
constexpr int PER_PHASE = 9;

constexpr int T = 8192, DM = 2048, NH = 8, HD = 128, DH = NH * HD  ;
constexpr int NIN = 3 * DH + 3 * DH + NH + 2 * DM;
constexpr int NIN_G = 6 * DH + 2 * DM;
constexpr int NE = 32, TOPK = 4, DFF = DM, CAP = T;
constexpr float RMS_EPS = 1e-5f;

constexpr size_t MiB = 1u << 20;
constexpr size_t WS_CTL = 0, CTL_ZERO_BYTES = 1 * MiB;
constexpr size_t WS_WIN = 1 * MiB;
constexpr size_t WS_WPA = 41 * MiB, WS_WPB = 45 * MiB;
constexpr size_t WS_WOUT = 49 * MiB;
constexpr size_t WS_W1 = 57 * MiB;
constexpr size_t WS_W2 = 569 * MiB;
constexpr size_t WS_HN = 825 * MiB;
constexpr size_t WS_QKV = 857 * MiB, QKV_STRIDE = 16 * MiB;
constexpr size_t WS_GATES = 1050 * MiB;
constexpr size_t WS_LOGF = 1017 * MiB, WS_G = WS_LOGF + 512 * 1024;
constexpr size_t WS_OSB = 1018 * MiB, WS_OFX = 1034 * MiB;
constexpr size_t WS_PART = 953 * MiB;
constexpr size_t WS_MIXED = 1114 * MiB;
constexpr size_t WS_X1 = 1146 * MiB;
constexpr size_t WS_STOK = 1210 * MiB, WS_SW = 1211 * MiB;
constexpr size_t WS_Y = 1212 * MiB;
constexpr size_t WS_AS = 1341 * MiB;
constexpr size_t WS_H = 2365 * MiB;
constexpr size_t WS_END = 3389 * MiB;
constexpr int CW_TMO = 0, CW_CODE = 1;
constexpr int CW_BAR = 4096;
constexpr int CW_CNT = 8192;
static_assert((CW_CNT + 64 * NE) * 4 <= (int)CTL_ZERO_BYTES, "CTL words inside the memset region");

constexpr int RING_OFF = 0, RING_BYTES = 131072;
constexpr int LDSCTL_OFF = RING_BYTES, MISC_OFF = LDSCTL_OFF + 320;
constexpr int TAB_OFF = LDSCTL_OFF + 1024;
constexpr int LDS_BYTES = 147456;
static_assert(att::LDS_BYTES <= RING_BYTES, "attention scratch fits the ring region");

#define GAS __attribute__((address_space(1)))
#define LAS __attribute__((address_space(3)))
typedef unsigned short bf16;
typedef unsigned v4u __attribute__((ext_vector_type(4)));
typedef unsigned v2u __attribute__((ext_vector_type(2)));
typedef float f32x4 __attribute__((ext_vector_type(4)));
typedef float f32x16 __attribute__((ext_vector_type(16)));
typedef short bf16x8 __attribute__((ext_vector_type(8)));
typedef GAS unsigned gu32;
typedef GAS unsigned long long gu64;
#define RLX_AGENT __ATOMIC_RELAXED, __HIP_MEMORY_SCOPE_AGENT
#define LDS_WAIT() asm volatile("s_waitcnt lgkmcnt(0)" ::: "memory")
#define VM_WAIT() asm volatile("s_waitcnt vmcnt(0)" ::: "memory")
__device__ __forceinline__ unsigned long long rt() { return __builtin_amdgcn_s_memrealtime(); }
__device__ __forceinline__ unsigned f2bf(float f) { unsigned u = __builtin_bit_cast(unsigned, f); return (u + 0x7fffu + ((u >> 16) & 1u)) >> 16; }
__device__ __forceinline__ unsigned pk2(float lo, float hi) { return f2bf(lo) | (f2bf(hi) << 16); }

#define XB_TMO      128
#define XB_XCNT(j)  (256  + 64 * (j))
#define XB_XSUB(j)  (1280 + 64 * (j))
#define XB_XGEN(j)  (2304 + 64 * (j))
#define XB_TOP      3328
#define XB_TOPGEN   3392
#define XCD_BAR_WORDS 3456
#define XB_SPIN_CAP (1u << 18)

__device__ __forceinline__ unsigned xb_ld(unsigned* p)              { return __hip_atomic_load(p, __ATOMIC_RELAXED, __HIP_MEMORY_SCOPE_AGENT); }
__device__ __forceinline__ unsigned xb_add(unsigned* p, unsigned v) { return __hip_atomic_fetch_add(p, v, __ATOMIC_RELAXED, __HIP_MEMORY_SCOPE_AGENT); }
__device__ __forceinline__ unsigned xb_xcc_id() { return (unsigned)__builtin_amdgcn_s_getreg((3 << 11) | 20) & 0xFu; }
#define XB_SPIN(cond, bar) do { unsigned _sp = 0; while (cond) { __builtin_amdgcn_s_sleep(1); \
    if ((++_sp & 255u) == 0u) { if (xb_ld(&(bar)[XB_TMO])) break; if (_sp > XB_SPIN_CAP) { atomicAdd(&(bar)[XB_TMO], 1u); break; } } } } while (0)

struct XcdBarrier {
    unsigned* bar; unsigned x;
    volatile LAS unsigned* st;
};

__device__ __forceinline__ XcdBarrier xcd_barrier_post(unsigned* bar, volatile LAS unsigned* st) {
    XcdBarrier b; b.bar = bar; b.x = xb_xcc_id(); b.st = st;
    if (threadIdx.x == 0) (void)xb_add(&bar[XB_XCNT(b.x)], 1u);
    return b;
}
__device__ __forceinline__ void xcd_barrier_complete(unsigned* bar, unsigned x, unsigned& nloc, unsigned& nx) {
    const unsigned G = gridDim.x * gridDim.y * gridDim.z;
    unsigned sum, cnt, mine, sp = 0u;
    for (;;) {
        sum = 0u; cnt = 0u; mine = 0u;
#pragma unroll
        for (unsigned j = 0; j < 16; ++j) { const unsigned c = xb_ld(&bar[XB_XCNT(j)]); sum += c; cnt += (c > 0u) ? 1u : 0u; mine = (j == x) ? c : mine; }
        if (sum == G) break;
        __builtin_amdgcn_s_sleep(1);
        if ((++sp & 255u) == 0u) { if (xb_ld(&bar[XB_TMO])) break; if (sp > XB_SPIN_CAP) { atomicAdd(&bar[XB_TMO], 1u); break; } }
    }
    nloc = mine > 0u ? mine : 1u; nx = cnt > 0u ? cnt : 1u;
}

__device__ __forceinline__ void xcd_barrier(const XcdBarrier& b) {
    asm volatile("s_waitcnt vmcnt(0)" ::: "memory");
    __syncthreads();
    if (threadIdx.x == 0) {
        unsigned* bar = b.bar;
        __builtin_amdgcn_s_waitcnt(0);
        unsigned nloc = b.st[0], nx = b.st[1];
        if (nloc == 0u) { xcd_barrier_complete(bar, b.x, nloc, nx); b.st[0] = nloc; b.st[1] = nx; }
        const unsigned old = xb_add(&bar[XB_XSUB(b.x)], 1u);
        const unsigned gen = old / nloc;
        if (old + 1u == (gen + 1u) * nloc) {
            __builtin_amdgcn_fence(__ATOMIC_RELEASE, "agent");
            asm volatile("s_waitcnt vmcnt(0)" ::: "memory");
            const unsigned og = xb_add(&bar[XB_TOP], 1u);
            const unsigned tg = og / nx;
            if (og + 1u == (tg + 1u) * nx) xb_add(&bar[XB_TOPGEN], 1u);
            else XB_SPIN(xb_ld(&bar[XB_TOPGEN]) == tg, bar);
            __builtin_amdgcn_fence(__ATOMIC_ACQUIRE, "agent");
            xb_add(&bar[XB_XGEN(b.x)], 1u);
            asm volatile("s_waitcnt vmcnt(0)" ::: "memory");
        } else {
            XB_SPIN(xb_ld(&bar[XB_XGEN(b.x)]) == gen, bar);
            __builtin_amdgcn_fence(__ATOMIC_ACQUIRE, "agent");
            asm volatile("s_waitcnt vmcnt(0)" ::: "memory");
        }
    }
    __syncthreads();
}

struct Frame {
    LAS unsigned char* lds;
    volatile LAS unsigned* MISC;
    gu32* ctl;
    int tid, lane, wave;
    int vcu, G;
    const float *x, *g_mix, *w_in, *b_forget, *b_gate, *w_psb, *w_pfx, *w_out, *g_ffn, *w_router, *b_router, *w1, *b1, *w2, *b2, *g_final;
    float* out; unsigned char* ws;
};
__device__ __forceinline__ float wave_sum(float v) {
#pragma unroll
    for (int o = 1; o < 64; o <<= 1) v += __shfl_xor(v, o);
    return v;
}
__device__ __forceinline__ unsigned pkbf(float lo, float hi) { return pg8::cvt_pk_bf16(lo, hi); }

__device__ __forceinline__ void transpose_item(const float* src  , int ldw, bf16* dst  , int K, LAS unsigned char* scr, int tid) {
    const int kb = tid & 7, ng = tid >> 3;
    const float* s = src + (size_t)(kb * 8) * ldw + ng * 4;
    f32x4 v[8];
#pragma unroll
    for (int r = 0; r < 8; ++r) v[r] = *(const f32x4*)(s + (size_t)r * ldw);
#pragma unroll
    for (int j = 0; j < 4; ++j) { v4u o; o.x = pkbf(v[0][j], v[1][j]); o.y = pkbf(v[2][j], v[3][j]); o.z = pkbf(v[4][j], v[5][j]); o.w = pkbf(v[6][j], v[7][j]);
        *(LAS v4u*)(scr + (ng * 4 + j) * 144 + kb * 16) = o; }
    __syncthreads();
    const int c = tid & 7, n = tid >> 3;
#pragma unroll
    for (int i = 0; i < 4; ++i) { const int nn = n + 64 * i; const v4u o = *(const LAS v4u*)(scr + nn * 144 + c * 16); *(v4u*)(dst + (size_t)nn * K + c * 8) = o; }
    __syncthreads();
}
__device__ __forceinline__ void p0_prologue(Frame& F) {
    LAS unsigned char* scr = F.lds + RING_OFF;
    bf16* WIN = (bf16*)(F.ws + WS_WIN); bf16* WPA = (bf16*)(F.ws + WS_WPA); bf16* WPB = (bf16*)(F.ws + WS_WPB); bf16* WOUT = (bf16*)(F.ws + WS_WOUT);
    bf16* W1T = (bf16*)(F.ws + WS_W1); bf16* W2T = (bf16*)(F.ws + WS_W2);
    constexpr int I_WIN = 32 * 40, I_WP = 16 * 8, I_WOUT = 32 * 8, I_W1E = 32 * 16, I_W2E = 32 * 8;
    constexpr int NITEMS = I_WIN + 2 * I_WP + I_WOUT + NE * I_W1E + NE * I_W2E;
    for (int it = F.vcu; it < NITEMS; it += F.G) {
        int r = it;
        if (r < I_WIN) { const int nb = r % 40, kk = r / 40, sc = nb * 256 + (nb >= 24 ? 8 : 0);
            transpose_item(F.w_in + (size_t)(kk * 64) * NIN + sc, NIN, WIN + (size_t)(nb * 256) * DM + kk * 64, DM, scr, F.tid); continue; } r -= I_WIN;
        if (r < I_WP) { const int nb = r % 8, kk = r / 8;
            transpose_item(F.w_psb + (size_t)(kk * 64) * DM + nb * 256, DM, WPA + (size_t)(nb * 256) * DH + kk * 64, DH, scr, F.tid); continue; } r -= I_WP;
        if (r < I_WP) { const int nb = r % 8, kk = r / 8;
            transpose_item(F.w_pfx + (size_t)(kk * 64) * DM + nb * 256, DM, WPB + (size_t)(nb * 256) * DH + kk * 64, DH, scr, F.tid); continue; } r -= I_WP;
        if (r < I_WOUT) { const int nb = r % 8, kk = r / 8;
            transpose_item(F.w_out + (size_t)(kk * 64) * DM + nb * 256, DM, WOUT + (size_t)(nb * 256) * DM + kk * 64, DM, scr, F.tid); continue; } r -= I_WOUT;
        if (r < NE * I_W1E) { const int e = r / I_W1E, q = r % I_W1E, nb = q % 16, kk = q / 16;
            transpose_item(F.w1 + (size_t)e * DM * 2 * DFF + (size_t)(kk * 64) * (2 * DFF) + nb * 256, 2 * DFF, W1T + (size_t)e * 2 * DFF * DM + (size_t)(nb * 256) * DM + kk * 64, DM, scr, F.tid); continue; } r -= NE * I_W1E;
        { const int e = r / I_W2E, q = r % I_W2E, nb = q % 8, kk = q / 8;
            transpose_item(F.w2 + (size_t)e * DFF * DM + (size_t)(kk * 64) * DM + nb * 256, DM, W2T + (size_t)e * DM * DFF + (size_t)(nb * 256) * DFF + kk * 64, DFF, scr, F.tid); }
    }
    bf16* HN = (bf16*)(F.ws + WS_HN); float* LOGF = (float*)(F.ws + WS_LOGF);
    LAS f32x4* wf4 = (LAS f32x4*)scr;
    for (int i = F.tid; i < DM * 2; i += NWAVES * 64) wf4[i] = *(const f32x4*)(F.w_in + (size_t)(i >> 1) * NIN + 6 * DH + (i & 1) * 4);
    __syncthreads();
    for (int tb = F.vcu; tb < T / 32; tb += F.G) {
        for (int j4 = 0; j4 < 4; ++j4) {
            const int row = tb * 32 + F.wave * 4 + j4;
            LAS f32x4* wfl = wf4; asm volatile("" : "+v"(wfl));
            const f32x4* xr = (const f32x4*)(F.x + (size_t)row * DM) + F.lane; const f32x4* gm = (const f32x4*)F.g_mix + F.lane;
            f32x4 v[8]; float ss = 0.f;
#pragma unroll
            for (int j = 0; j < 8; ++j) { v[j] = xr[64 * j]; ss += (v[j].x * v[j].x + v[j].y * v[j].y) + (v[j].z * v[j].z + v[j].w * v[j].w); }
            const float rstd = 1.0f / sqrtf(wave_sum(ss) * (1.0f / DM) + RMS_EPS);
            float f[8] = {0.f, 0.f, 0.f, 0.f, 0.f, 0.f, 0.f, 0.f};
            v2u* o8 = (v2u*)(HN + (size_t)row * DM) + F.lane;
#pragma unroll
            for (int j = 0; j < 8; ++j) { const f32x4 h = v[j] * rstd * gm[64 * j];
                v2u w; w.x = pkbf(h.x, h.y); w.y = pkbf(h.z, h.w); o8[64 * j] = w;
#pragma unroll
                for (int q = 0; q < 4; ++q) { const int k = (F.lane + 64 * j) * 4 + q; const f32x4 w0 = wfl[2 * k], w1 = wfl[2 * k + 1]; const float hq = h[q];
                    f[0] += hq * w0.x; f[1] += hq * w0.y; f[2] += hq * w0.z; f[3] += hq * w0.w; f[4] += hq * w1.x; f[5] += hq * w1.y; f[6] += hq * w1.z; f[7] += hq * w1.w; } }
#pragma unroll
            for (int q = 0; q < 8; ++q) f[q] = wave_sum(f[q]);
            if (F.lane < 8) { float z = F.lane == 0 ? f[0] : F.lane == 1 ? f[1] : F.lane == 2 ? f[2] : F.lane == 3 ? f[3] : F.lane == 4 ? f[4] : F.lane == 5 ? f[5] : F.lane == 6 ? f[6] : f[7];
                z += F.b_forget[F.lane];
                LOGF[(size_t)F.lane * T + row] = fminf(z, 0.f) - log1pf(expf(-fabsf(z))); }
        }
    }
    __syncthreads();
}
__device__ __forceinline__ void p1_scan(Frame& F) {
    const float* lf = (const float*)(F.ws + WS_LOGF) + (size_t)F.wave * T; float* Gp = (float*)(F.ws + WS_G) + (size_t)F.wave * T;
    const f32x4* lf4 = (const f32x4*)lf + F.lane * 32; f32x4* g4 = (f32x4*)Gp + F.lane * 32;
    float tot = 0.f;
    for (int i = 0; i < 32; ++i) { const f32x4 a = lf4[i]; tot += a.x; tot += a.y; tot += a.z; tot += a.w; }
    float incl = tot;
#pragma unroll
    for (int o = 1; o < 64; o <<= 1) { const float t = __shfl_up(incl, o); if (F.lane >= o) incl += t; }
    float run = incl - tot;
    for (int i = 0; i < 32; ++i) { const f32x4 a = lf4[i]; f32x4 o; run += a.x; o.x = run * att::LOG2E; run += a.y; o.y = run * att::LOG2E; run += a.z; o.z = run * att::LOG2E; run += a.w; o.w = run * att::LOG2E; g4[i] = o; }
}
__device__ __forceinline__ void p5_router(Frame& F) {
    const float* X1 = (const float*)(F.ws + WS_X1); bf16* AS = (bf16*)(F.ws + WS_AS); int* STOK = (int*)(F.ws + WS_STOK); float* SW = (float*)(F.ws + WS_SW);
    LAS float* red = (LAS float*)(F.lds + RING_OFF);
    LAS float* ssqs = red + 8 * 1024;
    LAS float* lg = ssqs + 8 * 32;
    LAS float* rstdl = lg + 32 * 33;
    LAS float* selw = rstdl + 32;
    LAS int* sele = (LAS int*)(selw + 128);
    LAS int* sellp = sele + 128;
    LAS int* dest = sellp + 128;
    LAS int* lcnt = dest + 128;
    LAS int* gbase = lcnt + 32;
    const int i32 = F.lane & 31, kk = F.lane >> 5;
    for (int tb = F.vcu; tb < T / 32; tb += F.G) {
        const int tok0 = tb * 32;
        {
            f32x16 C = {}; float ssq = 0.f; const int k0 = 256 * F.wave;
            const float* xr = X1 + (size_t)(tok0 + i32) * DM + k0 + 4 * kk;
#pragma unroll 4
            for (int u = 0; u < 32; ++u) { const f32x4 a = *(const f32x4*)(xr + 8 * u); ssq += (a.x * a.x + a.y * a.y) + (a.z * a.z + a.w * a.w);
#pragma unroll
                for (int v = 0; v < 4; ++v) { const int k = k0 + 8 * u + 4 * kk + v; const float b = F.w_router[(size_t)k * NE + i32] * F.g_ffn[k];
                    C = __builtin_amdgcn_mfma_f32_32x32x2f32(a[v], b, C, 0, 0, 0); } }
#pragma unroll
            for (int r = 0; r < 16; ++r) red[F.wave * 1024 + ((r & 3) + 8 * (r >> 2) + 4 * kk) * 32 + i32] = C[r];
            ssq += __shfl_xor(ssq, 32);
            if (kk == 0) ssqs[F.wave * 32 + i32] = ssq;
        }
        __syncthreads();
        for (int idx = F.tid; idx < 1024; idx += NWAVES * 64) { const int tk = idx >> 5, e = idx & 31; float s = 0.f, q = 0.f;
#pragma unroll
            for (int w = 0; w < 8; ++w) { s += red[w * 1024 + idx]; q += ssqs[w * 32 + tk]; }
            const float rstd = 1.0f / sqrtf(q * (1.0f / DM) + RMS_EPS);
            lg[tk * 33 + e] = s * rstd + F.b_router[e]; if (e == 0) rstdl[tk] = rstd; }
        if (F.tid < 32) lcnt[F.tid] = 0;
        __syncthreads();
        if (F.tid < 32) {
            float tv[4]; int te[4];
#pragma unroll
            for (int k = 0; k < 4; ++k) { float best = -__builtin_inff(); int bi = 0;
                for (int e = 0; e < NE; ++e) { const float v = lg[F.tid * 33 + e]; if (v > best) { best = v; bi = e; } }
                tv[k] = best; te[k] = bi; lg[F.tid * 33 + bi] = -__builtin_inff(); }
            float ew[4], sum = 0.f;
#pragma unroll
            for (int k = 0; k < 4; ++k) { ew[k] = expf(tv[k] - tv[0]); sum += ew[k]; }
            const float inv = 1.0f / sum;
#pragma unroll
            for (int k = 0; k < 4; ++k) { sele[F.tid * 4 + k] = te[k]; selw[F.tid * 4 + k] = ew[k] * inv; sellp[F.tid * 4 + k] = atomicAdd((int*)(lcnt + te[k]), 1); }
        }
        __syncthreads();
        if (F.tid < 32) { const int n = lcnt[F.tid]; gbase[F.tid] = n > 0 ? (int)__hip_atomic_fetch_add((unsigned*)(F.ctl + CW_CNT + 64 * F.tid), (unsigned)n, __ATOMIC_RELAXED, __HIP_MEMORY_SCOPE_AGENT) : 0; }
        __syncthreads();
        if (F.tid < 128) { const int e = sele[F.tid]; int pos = gbase[e] + sellp[F.tid]; if (pos >= CAP) pos = CAP - 1; const int row = e * CAP + pos;
            STOK[row] = (tok0 + (F.tid >> 2)) * 4 + (F.tid & 3); SW[row] = selw[F.tid]; dest[F.tid] = row; }
        __syncthreads();
        for (int j4 = 0; j4 < 4; ++j4) {
            const int ti = F.wave * 4 + j4; const float rstd = rstdl[ti];
            const f32x4* xr = (const f32x4*)(X1 + (size_t)(tok0 + ti) * DM) + F.lane; const f32x4* gm = (const f32x4*)F.g_ffn + F.lane;
            v2u w[8];
#pragma unroll
            for (int j = 0; j < 8; ++j) { const f32x4 h = xr[64 * j] * rstd * gm[64 * j]; w[j].x = pkbf(h.x, h.y); w[j].y = pkbf(h.z, h.w); }
#pragma unroll
            for (int k = 0; k < 4; ++k) { v2u* o8 = (v2u*)(AS + (size_t)dest[ti * 4 + k] * DM) + F.lane;
#pragma unroll
                for (int j = 0; j < 8; ++j) o8[64 * j] = w[j]; }
        }
        __syncthreads();
    }
}
__device__ __forceinline__ void p8_final(Frame& F) {
    const float* X1 = (const float*)(F.ws + WS_X1); const bf16* Y = (const bf16*)(F.ws + WS_Y);
    const int gw = F.vcu * NWAVES + F.wave, NGW = F.G * NWAVES;
    for (int row = gw; row < T; row += NGW) {
        const f32x4* xr = (const f32x4*)(X1 + (size_t)row * DM) + F.lane; const f32x4* gf = (const f32x4*)F.g_final + F.lane;
        f32x4 v[8]; float ss = 0.f;
#pragma unroll
        for (int j = 0; j < 8; ++j) { v[j] = xr[64 * j];
#pragma unroll
            for (int k = 0; k < (DBG_NO_MOE ? 0 : 4); ++k) { const v2u y = ((const v2u*)(Y + (size_t)(row * 4 + k) * DM) + F.lane)[64 * j];
                v[j].x += pg8::bf_lo(y.x); v[j].y += pg8::bf_hi(y.x); v[j].z += pg8::bf_lo(y.y); v[j].w += pg8::bf_hi(y.y); }
            ss += (v[j].x * v[j].x + v[j].y * v[j].y) + (v[j].z * v[j].z + v[j].w * v[j].w); }
        const float rstd = 1.0f / sqrtf(wave_sum(ss) * (1.0f / DM) + RMS_EPS);
        f32x4* o = (f32x4*)(F.out + (size_t)row * DM) + F.lane;
#pragma unroll
        for (int j = 0; j < 8; ++j) o[64 * j] = v[j] * rstd * gf[64 * j];
    }
}

struct Args { const float* in[16]; float* out; unsigned char* ws; int ph_lo, ph_hi; };
__global__ void __launch_bounds__(NWAVES * 64, 2) mk_fwd(Args args) {
    extern __shared__ __attribute__((aligned(16))) unsigned char lds[];
    Frame F;
    F.lds = (LAS unsigned char*)lds;
    F.MISC = (volatile LAS unsigned*)(F.lds + MISC_OFF);
    F.tid = threadIdx.x; F.lane = F.tid & 63; F.wave = __builtin_amdgcn_readfirstlane(F.tid >> 6);
    F.G = gridDim.x; { const int bx = blockIdx.x; F.vcu = (F.G % 8 == 0) ? (bx % 8) * (F.G / 8) + bx / 8 : bx; }
    unsigned char* ws = args.ws; F.ws = ws; F.out = args.out;
    F.ctl = (gu32*)(ws + WS_CTL);
    F.x = args.in[0]; F.g_mix = args.in[1]; F.w_in = args.in[2]; F.b_forget = args.in[3]; F.b_gate = args.in[4]; F.w_psb = args.in[5]; F.w_pfx = args.in[6]; F.w_out = args.in[7];
    F.g_ffn = args.in[8]; F.w_router = args.in[9]; F.b_router = args.in[10]; F.w1 = args.in[11]; F.b1 = args.in[12]; F.w2 = args.in[13]; F.b2 = args.in[14]; F.g_final = args.in[15];
    for (int u = F.tid; u < (LDS_BYTES - LDSCTL_OFF) / 4; u += NWAVES * 64) ((LAS unsigned*)(F.lds + LDSCTL_OFF))[u] = 0u;
    __syncthreads();
    XcdBarrier bar; bar.bar = (unsigned*)(F.ctl + CW_BAR); bar.x = 0; bar.st = nullptr;
    if (N_LAUNCHES != PER_PHASE) bar = xcd_barrier_post((unsigned*)(F.ctl + CW_BAR), F.MISC + 8);
#define GRID_BAR(seam) do { if (N_LAUNCHES == PER_PHASE) { if (F.tid == 0) __hip_atomic_store(F.ctl + CW_TMO, 0xBADBA0u | (unsigned)(seam), RLX_AGENT); } else { xcd_barrier(bar); } } while (0)
    const int lo = args.ph_lo, hi = args.ph_hi;
#ifndef PH_MASK
#define PH_MASK 0x1ff
#endif
#define IN(k) (((PH_MASK >> (k)) & 1) && lo <= (k) && (k) < hi)
#define BOTH(k) (IN(k) && IN((k) + 1))
    bf16* HN = (bf16*)(ws + WS_HN); bf16* QKV = (bf16*)(ws + WS_QKV); bf16* GATES = (bf16*)(ws + WS_GATES);
    bf16* OSB = (bf16*)(ws + WS_OSB); bf16* OFX = (bf16*)(ws + WS_OFX); bf16* MIXED = (bf16*)(ws + WS_MIXED);
    float* PART = (float*)(ws + WS_PART); float* X1 = (float*)(ws + WS_X1);
    bf16* AS = (bf16*)(ws + WS_AS); bf16* HB = (bf16*)(ws + WS_H); bf16* YB = (bf16*)(ws + WS_Y);

    if (IN(0)) { p0_prologue(F); if (BOTH(0)) GRID_BAR(0); }

    if (IN(1)) {
        if ((int)blockIdx.x == F.G - 1) p1_scan(F);
        pg8::TileOrder S; S.init(HN, ws + WS_WIN, T, NIN_G, DM, F.G, (int)blockIdx.x);
        pg8::EpiP1 E{QKV, QKV_STRIDE / 2, GATES, F.b_gate, DBG_GATES_FROM_COPY ? (bf16*)PART : MIXED};
        pg8::gemm_phase<pg8::EpiP1, pg8::TileOrder, true, true>(F.lds + RING_OFF, DM, S, E);
        if (BOTH(1)) GRID_BAR(1);
    }

    if (IN(2)) {
        const float* Gall = (const float*)(ws + WS_G);
        for (int it = (int)blockIdx.x; it < 128; it += F.G) {
            const int h = it & 7, j = (it >> 3) & 15;
            for (int pass = 0; pass < 2; ++pass)
                att::fox_unit(QKV + 3 * (QKV_STRIDE / 2) + h * HD, QKV + 4 * (QKV_STRIDE / 2) + h * HD, QKV + 5 * (QKV_STRIDE / 2) + h * HD, OFX + h * HD, Gall + (size_t)h * T, pass == 0 ? j : 31 - j, (att::ALAS_char_ptr)(F.lds + RING_OFF));
        }
        for (int it = (int)blockIdx.x; it < 256; it += F.G) {
            if (it < 128) continue;
            const int h = it & 7, j = (it >> 3) & 15;
            for (int pass = 0; pass < 2; ++pass)
                att::sb_unit(QKV + 0 * (QKV_STRIDE / 2) + h * HD, QKV + 1 * (QKV_STRIDE / 2) + h * HD, QKV + 2 * (QKV_STRIDE / 2) + h * HD, OSB + h * HD, pass == 0 ? j : 31 - j, (att::ALAS_char_ptr)(F.lds + RING_OFF));
        }
        if (BOTH(2)) GRID_BAR(2);
    }

    if (IN(3)) {
        pg8::MixOrder S; S.t.init(DBG_SKIP_ATT ? (QKV + 2 * (QKV_STRIDE / 2)) : OSB, ws + WS_WPA, T, DM, DH, F.G, (int)blockIdx.x); S.A1 = (const char*)(DBG_SKIP_ATT ? (QKV + 5 * (QKV_STRIDE / 2)) : OFX); S.B1 = (const char*)(ws + WS_WPB);
        pg8::EpiMix E{GATES, PART, MIXED};
        if (DBG_P3_SINGLE) { pg8::TileOrder S1; S1.init(S.A1, S.B1, T, DM, DH, F.G, (int)blockIdx.x);
            pg8::gemm_phase<pg8::EpiMix, pg8::TileOrder, true, true>(F.lds + RING_OFF, DH, S1, E); }
        else pg8::gemm_phase<pg8::EpiMix, pg8::MixOrder, true, true>(F.lds + RING_OFF, DH, S, E);
        if (BOTH(3)) GRID_BAR(3);
    }

    if (IN(4)) {
        pg8::TileOrder S; S.init(DBG_P4_FROM_HN ? HN : MIXED, ws + WS_WOUT, T, DM, DM, DBG_P4_MULTI ? 64 : F.G, DBG_P4_MULTI ? ((int)blockIdx.x < 64 ? (int)blockIdx.x : 1000000) : (int)blockIdx.x);
        pg8::EpiResid E{F.x, X1};
        pg8::gemm_phase<pg8::EpiResid, pg8::TileOrder, true, true>(F.lds + RING_OFF, DM, S, E);
        if (BOTH(4)) GRID_BAR(4);
    }

    if (IN(5)) { p5_router(F); if (BOTH(5)) GRID_BAR(5); }

    if (IN(6) || IN(7)) {
        LAS int* cntl = (LAS int*)(F.lds + TAB_OFF); LAS int* pref = cntl + 32;
        if (F.tid < 32) { int n = (int)__hip_atomic_load(F.ctl + CW_CNT + 64 * F.tid, RLX_AGENT); cntl[F.tid] = n > CAP ? CAP : n; }
        __syncthreads();
        if (F.tid == 0) { int p = 0; for (int e = 0; e < NE; ++e) { pref[e] = p; p += (cntl[e] + 255) >> 8; } pref[NE] = p; }
        __syncthreads();
        if (IN(6)) {
            pg8::MoeOrder S{(const char*)AS, (const char*)(ws + WS_W1), (const PG8_LAS int*)pref, (size_t)CAP * DM * 2, (size_t)2 * DFF * DM * 2, (size_t)256 * DM * 2, (2 * DFF) / 256, CAP / 256, F.G, F.vcu};
            pg8::EpiSwiglu E{F.b1, HB};
            pg8::gemm_phase<pg8::EpiSwiglu, pg8::MoeOrder, true, true>(F.lds + RING_OFF, DM, S, E);
            if (BOTH(6)) GRID_BAR(6);
        }
        if (IN(7)) {
            pg8::MoeOrder S{(const char*)HB, (const char*)(ws + WS_W2), (const PG8_LAS int*)pref, (size_t)CAP * DFF * 2, (size_t)DM * DFF * 2, (size_t)256 * DFF * 2, DM / 256, CAP / 256, F.G, F.vcu};
            pg8::EpiMoeOut E{F.b2, (const int*)(ws + WS_STOK), (const float*)(ws + WS_SW), (const PG8_LAS int*)cntl, YB, CAP};
            pg8::gemm_phase<pg8::EpiMoeOut, pg8::MoeOrder, true, true>(F.lds + RING_OFF, DFF, S, E);
            if (BOTH(7)) GRID_BAR(7);
        }
    }

    if (IN(8)) p8_final(F);
#undef IN
#undef BOTH
}

extern "C" void kernel_launch(void* const* d_in, const int* in_sizes, int n_in, void* d_out, int out_size, void* d_ws, size_t ws_size, hipStream_t stream) {
    static int grid = 0;
    if (grid == 0) {
        if (n_in != 16 || in_sizes[0] != T * DM || out_size != T * DM || ws_size < WS_END) { fprintf(stderr, "kernel_launch: built for 16 inputs, x/out of %d floats, >= %zu bytes of workspace; got n_in %d, in0 %d, out %d, ws %zu; nothing launched\n", T * DM, (size_t)WS_END, n_in, n_in > 0 ? in_sizes[0] : -1, out_size, ws_size); grid = -1; return; }
        int dev = 0, cus = 0, per_cu = 0;
        if (hipGetDevice(&dev) != hipSuccess || hipDeviceGetAttribute(&cus, hipDeviceAttributeMultiprocessorCount, dev) != hipSuccess) { fprintf(stderr, "kernel_launch: hipGetDevice / hipDeviceGetAttribute failed\n"); grid = -1; return; }
        if (hipFuncSetAttribute((const void*)mk_fwd, hipFuncAttributeMaxDynamicSharedMemorySize, LDS_BYTES) != hipSuccess) { fprintf(stderr, "kernel_launch: hipFuncSetAttribute failed\n"); grid = -1; return; }
        if (hipOccupancyMaxActiveBlocksPerMultiprocessor(&per_cu, (const void*)mk_fwd, NWAVES * 64, LDS_BYTES) != hipSuccess || per_cu < 1)
            fprintf(stderr, "kernel_launch: note: the occupancy query reports %d workgroups per CU\n", per_cu);
        (void)hipGetLastError();
        grid = cus;
    }
    if (grid < 0) return;
    if (hipMemsetAsync((char*)d_ws + WS_CTL, 0, CTL_ZERO_BYTES, stream) != hipSuccess) { fprintf(stderr, "kernel_launch: hipMemsetAsync failed\n"); return; }
    Args a{};
    for (int i = 0; i < 16; ++i) a.in[i] = (const float*)d_in[i];
    a.out = (float*)d_out; a.ws = (unsigned char*)d_ws;
    if (N_LAUNCHES == 1) { a.ph_lo = 0; a.ph_hi = PER_PHASE; hipLaunchKernelGGL(mk_fwd, dim3(grid), dim3(NWAVES * 64), LDS_BYTES, stream, a); }
    else for (int li = 0; li < PER_PHASE; ++li) { a.ph_lo = li; a.ph_hi = li + 1; hipLaunchKernelGGL(mk_fwd, dim3(grid), dim3(NWAVES * 64), LDS_BYTES, stream, a); }
    const hipError_t le = hipPeekAtLastError();
    if (le != hipSuccess) fprintf(stderr, "kernel_launch: launch failed: %s (grid %d)\n", hipGetErrorName(le), grid);
}
```

```cpp
#include <hip/hip_runtime.h>
#include <hip/hip_bf16.h>
#include <cstdio>
#include <cstdint>

#ifndef CONV_FIRST_OF8
#define CONV_FIRST_OF8 4
#endif
#ifndef MK_N_LAUNCHES
#define MK_N_LAUNCHES 1
#endif

namespace pg8 {
#define PG8_LAS __attribute__((address_space(3)))
typedef unsigned short bf16_t;
typedef short bf16x8 __attribute__((ext_vector_type(8)));
typedef float f32x4 __attribute__((ext_vector_type(4)));
typedef unsigned u32x4 __attribute__((ext_vector_type(4)));
typedef unsigned u32x2 __attribute__((ext_vector_type(2)));
constexpr int BM = 256, BK = 64, HALF = 128, HTB = HALF * BK * 2  , STAGE_BYTES = 8 * HTB, NXCD = 8, WGM = 8;

__host__ __device__ __forceinline__ int lds_byte(int r, int c) { const int st = (r >> 4) * 2 + (c >> 5), rr = r & 15, cc = c & 31, ob = rr * 64 + cc * 2; return st * 1024 + (ob ^ (((ob >> 9) & 1) << 5)); }
__host__ __device__ __forceinline__ void stage_rc(int b, int& R, int& C) { const int st = b / 1024, sb = b % 1024, swz = sb ^ (((sb >> 9) & 1) << 5); R = (st >> 1) * 16 + swz / 64; C = (st & 1) * 32 + (swz % 64) / 2; }
__host__ __device__ __forceinline__ int perm32(int rho) { const int n = rho >> 4, i = rho & 15; return 8 * (i >> 2) + 4 * n + (i & 3); }

struct Unit { const char* a; const char* b; int pm, pn, aux; };

typedef float f32x2_c __attribute__((ext_vector_type(2))); typedef __bf16 bf16x2_c __attribute__((ext_vector_type(2)));
__device__ __forceinline__ unsigned cvt_pk_bf16(float lo, float hi) { const f32x2_c v = {lo, hi}; const bf16x2_c b = __builtin_convertvector(v, bf16x2_c); return __builtin_bit_cast(unsigned, b); }
__device__ __forceinline__ unsigned pk4_fp8(float a, float b, float c, float d) { unsigned w = 0u; w = (unsigned)__builtin_amdgcn_cvt_pk_fp8_f32(a, b, (int)w, false); w = (unsigned)__builtin_amdgcn_cvt_pk_fp8_f32(c, d, (int)w, true); return w; }
constexpr float W8_SCALE = 64.0f, W8_INV = 1.0f / 64.0f;
__device__ __forceinline__ float bf_lo(unsigned u) { return __uint_as_float(u << 16); }
__device__ __forceinline__ float bf_hi(unsigned u) { return __uint_as_float(u & 0xffff0000u); }
__device__ __forceinline__ float sigmoidf_fast(float x) { return __builtin_amdgcn_rcpf(1.0f + __builtin_amdgcn_exp2f(-1.4426950408889634f * x)); }

struct TileOrder {
    const char* A; const char* Bt; size_t tstepA, tstepB; int nM, nN, nwg, G, c;
    __device__ __forceinline__ void init(const void* A_, const void* Bt_, int M, int N, int K, int G_, int c_, int esz = 2) { A = (const char*)A_; Bt = (const char*)Bt_; tstepA = (size_t)BM * K * esz; tstepB = tstepA; nM = M / BM; nN = N / BM; nwg = nM * nN; G = G_; c = c_; }
    __device__ __forceinline__ bool map(int L, int& pm, int& pn) const {
        if (L >= nwg) return false;
        int wgid = L; { const int q = nwg / NXCD, r = nwg % NXCD, xcd = wgid % NXCD, off = wgid / NXCD; wgid = (xcd < r ? xcd * (q + 1) : r * (q + 1) + (xcd - r) * q) + off; }
        const int nig = WGM * nN, gid = wgid / nig, fm = gid * WGM, gsz = (nM - fm) < WGM ? (nM - fm) : WGM;
        pm = fm + ((wgid % nig) % gsz); pn = (wgid % nig) / gsz; return true;
    }
    __device__ __forceinline__ bool next(int i, Unit& u) const {
        int pm, pn; if (!map(i * G + c, pm, pn)) return false;
        u.pm = pm; u.pn = pn; u.aux = 0; u.a = A + (size_t)pm * tstepA; u.b = Bt + (size_t)pn * tstepB; return true;
    }
    __device__ __forceinline__ void a_ready(const Unit&) const {}
    __device__ __forceinline__ void done(const Unit&) const {}
};
struct MixOrder {
    TileOrder t; const char* A1; const char* B1;
    __device__ __forceinline__ bool next(int i, Unit& u) const {
        int pm, pn; if (!t.map((i >> 1) * t.G + t.c, pm, pn)) return false;
        u.pm = pm; u.pn = pn; u.aux = i & 1;
        u.a = ((i & 1) ? A1 : t.A) + (size_t)pm * t.tstepA; u.b = ((i & 1) ? B1 : t.Bt) + (size_t)pn * t.tstepB; return true;
    }
    __device__ __forceinline__ void a_ready(const Unit&) const {}
    __device__ __forceinline__ void done(const Unit&) const {}
};
struct MoeOrder {
    const char* A; const char* Bt; const PG8_LAS int* pref;
    size_t a_estride, b_estride, tstep; int NT, cap_tiles, G, c;
    __device__ __forceinline__ bool next(int i, Unit& u) const {
        const int L = i * G + c; const int total = pref[32] * NT; if (L >= total) return false;
        int e = 0;
#pragma unroll 1
        for (int j = 1; j < 32; ++j) if (pref[j] * NT <= L) e = j;
        const int me = pref[e + 1] - pref[e], q = L - pref[e] * NT, nt = q / me, mt = q - nt * me;
        u.aux = e; u.pm = e * cap_tiles + mt; u.pn = nt;
        u.a = A + (size_t)e * a_estride + (size_t)mt * tstep; u.b = Bt + (size_t)e * b_estride + (size_t)nt * tstep; return true;
    }
    __device__ __forceinline__ void a_ready(const Unit&) const {}
    __device__ __forceinline__ void done(const Unit&) const {}
};

struct EpiP1 {
    static constexpr bool PERM = true, AFTER_DRAIN = false;
    bf16_t* qkv; size_t buf_stride; unsigned* km;
    __device__ __forceinline__ void operator()(const f32x4 (&acc)[2][2][4][2], const Unit& u, int wr, int wc, int fr, int fq) const {
        const int row0 = u.pm * BM + wr * 64 + fr;
        {
            bf16_t* base = qkv + (size_t)(u.pn >> 2) * buf_stride; const int col0 = (u.pn & 3) * BM + wc * 32 + 8 * fq;
            const bool kfx = u.pn >= 16 && u.pn < 20;
            float mx[2] = {0.f, 0.f};
#pragma unroll
            for (int ai = 0; ai < 2; ++ai)
#pragma unroll
                for (int m = 0; m < 4; ++m) { bf16_t* rowp = base + (size_t)(row0 + ai * HALF + m * 16) * 1024 + col0;
#pragma unroll
                    for (int bj = 0; bj < 2; ++bj) { const f32x4 v0 = acc[ai][bj][m][0], v1 = acc[ai][bj][m][1];
                        u32x4 w; w.x = cvt_pk_bf16(v0[0], v0[1]); w.y = cvt_pk_bf16(v0[2], v0[3]); w.z = cvt_pk_bf16(v1[0], v1[1]); w.w = cvt_pk_bf16(v1[2], v1[3]);
                        *(u32x4*)(rowp + bj * HALF) = w;
                        if (kfx) { float q = bf_lo(w.x) * bf_lo(w.x) + bf_hi(w.x) * bf_hi(w.x) + bf_lo(w.y) * bf_lo(w.y) + bf_hi(w.y) * bf_hi(w.y)
                                           + bf_lo(w.z) * bf_lo(w.z) + bf_hi(w.z) * bf_hi(w.z) + bf_lo(w.w) * bf_lo(w.w) + bf_hi(w.w) * bf_hi(w.w);
                            q += __shfl_xor(q, 16); q += __shfl_xor(q, 32); mx[bj] = fmaxf(mx[bj], q); } } }
            if (kfx) {
#pragma unroll
                for (int bj = 0; bj < 2; ++bj) { float q = mx[bj];
#pragma unroll
                    for (int o = 1; o < 16; o <<= 1) q = fmaxf(q, __shfl_xor(q, o));
                    if (fr == 0 && fq == 0) __hip_atomic_fetch_max(km + (2 * (u.pn - 16) + bj) * 4 + wc, __float_as_uint(q), __ATOMIC_RELAXED, __HIP_MEMORY_SCOPE_AGENT); } }
        }
    }
};
struct EpiGates {
    static constexpr bool PERM = true, AFTER_DRAIN = false;
    bf16_t* gates; const float* b_gate;
    __device__ __forceinline__ void operator()(const f32x4 (&acc)[2][2][4][2], const Unit& u, int wr, int wc, int fr, int fq) const {
        const int row0 = u.pm * BM + wr * 64 + fr, gc0 = u.pn * BM + wc * 32 + 8 * fq;
        f32x4 bv[2][2];
#pragma unroll
        for (int bj = 0; bj < 2; ++bj)
#pragma unroll
            for (int n = 0; n < 2; ++n) bv[bj][n] = *(const f32x4*)(b_gate + gc0 + bj * HALF + 4 * n);
#pragma unroll
        for (int ai = 0; ai < 2; ++ai)
#pragma unroll
            for (int m = 0; m < 4; ++m) { bf16_t* rowp = gates + (size_t)(row0 + ai * HALF + m * 16) * 4096 + gc0;
#pragma unroll
                for (int bj = 0; bj < 2; ++bj) { f32x4 v0 = acc[ai][bj][m][0] * W8_INV + bv[bj][0], v1 = acc[ai][bj][m][1] * W8_INV + bv[bj][1];
#pragma unroll
                    for (int q = 0; q < 4; ++q) { v0[q] = sigmoidf_fast(v0[q]); v1[q] = sigmoidf_fast(v1[q]); }
                    u32x4 w; w.x = cvt_pk_bf16(v0[0], v0[1]); w.y = cvt_pk_bf16(v0[2], v0[3]); w.z = cvt_pk_bf16(v1[0], v1[1]); w.w = cvt_pk_bf16(v1[2], v1[3]);
                    *(u32x4*)(rowp + bj * HALF) = w; } }
    }
};
struct EpiMix {
    static constexpr bool PERM = true, AFTER_DRAIN = false;
    const bf16_t* gates; float* part; bf16_t* mixed;
    __device__ __forceinline__ void operator()(const f32x4 (&acc)[2][2][4][2], const Unit& u, int wr, int wc, int fr, int fq) const {
        const int row0 = u.pm * BM + wr * 64 + fr, col0 = u.pn * BM + wc * 32 + 8 * fq; const int goff = u.aux ? 2048 : 0;
#pragma unroll
        for (int ai = 0; ai < 2; ++ai) {
            u32x4 g[4][2];
#pragma unroll
            for (int m = 0; m < 4; ++m)
#pragma unroll
                for (int bj = 0; bj < 2; ++bj) g[m][bj] = *(const u32x4*)(gates + (size_t)(row0 + ai * HALF + m * 16) * 4096 + goff + col0 + bj * HALF);
#pragma unroll
            for (int mp = 0; mp < 2; ++mp) {
                f32x4 p0[2][2], p1[2][2];
                if (u.aux) {
#pragma unroll
                    for (int mm = 0; mm < 2; ++mm)
#pragma unroll
                        for (int bj = 0; bj < 2; ++bj) { const float* pp = part + (size_t)(row0 + ai * HALF + (2 * mp + mm) * 16) * 2048 + col0 + bj * HALF;
                            p0[mm][bj] = *(const f32x4*)pp; p1[mm][bj] = *(const f32x4*)(pp + 4); } }
                asm volatile("" ::: "memory");
#pragma unroll
                for (int mm = 0; mm < 2; ++mm)
#pragma unroll
                    for (int bj = 0; bj < 2; ++bj) { const int m = 2 * mp + mm; const size_t row = (size_t)(row0 + ai * HALF + m * 16); const int c = col0 + bj * HALF;
                        const u32x4 gg = g[m][bj]; const f32x4 a0 = acc[ai][bj][m][0], a1 = acc[ai][bj][m][1];
                        f32x4 r0 = {bf_lo(gg.x) * a0[0], bf_hi(gg.x) * a0[1], bf_lo(gg.y) * a0[2], bf_hi(gg.y) * a0[3]};
                        f32x4 r1 = {bf_lo(gg.z) * a1[0], bf_hi(gg.z) * a1[1], bf_lo(gg.w) * a1[2], bf_hi(gg.w) * a1[3]};
                        float* pp = part + row * 2048 + c;
                        if (u.aux == 0) { *(f32x4*)pp = r0; *(f32x4*)(pp + 4) = r1; }
                        else { r0 += p0[mm][bj]; r1 += p1[mm][bj];
                            u32x4 w; w.x = cvt_pk_bf16(r0[0], r0[1]); w.y = cvt_pk_bf16(r0[2], r0[3]); w.z = cvt_pk_bf16(r1[0], r1[1]); w.w = cvt_pk_bf16(r1[2], r1[3]);
                            *(u32x4*)(mixed + row * 2048 + c) = w; } }
                asm volatile("" ::: "memory");
            }
        }
    }
};
struct EpiResid {
    static constexpr bool PERM = false, AFTER_DRAIN = false;
    const float* x; float* x1;
    __device__ __forceinline__ void operator()(const f32x4 (&acc)[2][2][4][2], const Unit& u, int wr, int wc, int fr, int fq) const {
        const int row0 = u.pm * BM + wr * 64 + fr, col0 = u.pn * BM + wc * 32 + 4 * fq;
#pragma unroll
        for (int ai = 0; ai < 2; ++ai) {
            f32x4 xv[4][2][2];
#pragma unroll
            for (int m = 0; m < 4; ++m) { const size_t off = (size_t)(row0 + ai * HALF + m * 16) * 2048 + col0;
#pragma unroll
                for (int bj = 0; bj < 2; ++bj)
#pragma unroll
                    for (int n = 0; n < 2; ++n) xv[m][bj][n] = *(const f32x4*)(x + off + bj * HALF + n * 16); }
            asm volatile("" ::: "memory");
#pragma unroll
            for (int m = 0; m < 4; ++m) { const size_t off = (size_t)(row0 + ai * HALF + m * 16) * 2048 + col0;
#pragma unroll
                for (int bj = 0; bj < 2; ++bj)
#pragma unroll
                    for (int n = 0; n < 2; ++n) *(f32x4*)(x1 + off + bj * HALF + n * 16) = xv[m][bj][n] + acc[ai][bj][m][n]; }
            asm volatile("" ::: "memory");
        }
    }
};
__device__ __forceinline__ float swiglu1(float g, float l) {
    g = fminf(g, 7.0f); l = fminf(fmaxf(l, -7.0f), 7.0f);
    return g * sigmoidf_fast(1.702f * g) * (l + 1.0f);
}
struct EpiSwiglu {
    static constexpr bool PERM = true, AFTER_DRAIN = false;
    const float* b1; unsigned char* H;
    __device__ __forceinline__ void operator()(const f32x4 (&acc)[2][2][4][2], const Unit& u, int wr, int wc, int fr, int fq) const {
        const int row0 = u.pm * BM + wr * 64 + fr, c0 = u.pn * BM + wc * 32 + 8 * fq; const float* be = b1 + (size_t)u.aux * 4096 + c0;
        f32x4 bv[2][2];
#pragma unroll
        for (int bj = 0; bj < 2; ++bj)
#pragma unroll
            for (int n = 0; n < 2; ++n) bv[bj][n] = *(const f32x4*)(be + bj * HALF + 4 * n);
#pragma unroll
        for (int ai = 0; ai < 2; ++ai)
#pragma unroll
            for (int m = 0; m < 4; ++m) { unsigned char* rowp = H + (size_t)(row0 + ai * HALF + m * 16) * 2048 + (c0 >> 1);
#pragma unroll
                for (int bj = 0; bj < 2; ++bj) { const f32x4 v0 = acc[ai][bj][m][0] * W8_INV + bv[bj][0], v1 = acc[ai][bj][m][1] * W8_INV + bv[bj][1];
                    *(unsigned*)(rowp + bj * (HALF / 2)) = pk4_fp8(swiglu1(v0[0], v0[1]), swiglu1(v0[2], v0[3]), swiglu1(v1[0], v1[1]), swiglu1(v1[2], v1[3])); } }
    }
};
struct EpiMoeOut {
    static constexpr bool PERM = true, AFTER_DRAIN = false;
    const float* b2; const float* slot_w; bf16_t* Y;
    __device__ __forceinline__ void operator()(const f32x4 (&acc)[2][2][4][2], const Unit& u, int wr, int wc, int fr, int fq) const {
        const int e = u.aux, row0 = u.pm * BM + wr * 64 + fr, c0 = u.pn * BM + wc * 32 + 8 * fq; const float* be = b2 + (size_t)e * 2048 + c0;
        f32x4 bv[2][2];
#pragma unroll
        for (int bj = 0; bj < 2; ++bj)
#pragma unroll
            for (int n = 0; n < 2; ++n) bv[bj][n] = *(const f32x4*)(be + bj * HALF + 4 * n);
        float wrow[2][4];
#pragma unroll
        for (int ai = 0; ai < 2; ++ai)
#pragma unroll
            for (int m = 0; m < 4; ++m) wrow[ai][m] = slot_w[row0 + ai * HALF + m * 16];
        asm volatile("" ::: "memory");
#pragma unroll
        for (int ai = 0; ai < 2; ++ai)
#pragma unroll
            for (int m = 0; m < 4; ++m) { const int row = row0 + ai * HALF + m * 16;
                const float w8 = wrow[ai][m]; bf16_t* rowp = Y + (size_t)row * 2048 + c0;
#pragma unroll
                for (int bj = 0; bj < 2; ++bj) { const f32x4 v0 = (acc[ai][bj][m][0] * W8_INV + bv[bj][0]) * w8, v1 = (acc[ai][bj][m][1] * W8_INV + bv[bj][1]) * w8;
                    u32x4 w; w.x = cvt_pk_bf16(v0[0], v0[1]); w.y = cvt_pk_bf16(v0[2], v0[3]); w.z = cvt_pk_bf16(v1[0], v1[1]); w.w = cvt_pk_bf16(v1[2], v1[3]);
                    *(u32x4*)(rowp + bj * HALF) = w; } }
    }
};

typedef int i32x4 __attribute__((ext_vector_type(4)));
typedef int i32x8 __attribute__((ext_vector_type(8)));
__device__ __forceinline__ i32x8 cat8(bf16x8 lo, bf16x8 hi) { return __builtin_shufflevector(__builtin_bit_cast(i32x4, lo), __builtin_bit_cast(i32x4, hi), 0, 1, 2, 3, 4, 5, 6, 7); }
template <class Epi, class Sched, bool ALIGN_EPI = false, bool SP2 = false, int ESZ = 2>
__device__ __forceinline__ void gemm_phase(PG8_LAS unsigned char* lds, const int K, const Sched& S, const Epi& E) {
    int tid = threadIdx.x; asm volatile("" : "+v"(tid));
    const int wid = __builtin_amdgcn_readfirstlane(tid >> 6), lane = tid & 63, wr = wid >> 2, wc = wid & 3, fr = lane & 15, fq = lane >> 4;
    const int nt = K / (BK * 2 / ESZ);
    unsigned voffA, voffB;
    { int R, C; stage_rc(tid * 16, R, C); const int Rb = Epi::PERM ? ((R & ~31) + perm32(R & 31)) : R;
        voffA = (unsigned)(R * K * ESZ + C * 2); voffB = (unsigned)(Rb * K * ESZ + C * 2); }
    const size_t pstep = (size_t)64 * K * ESZ;
    const size_t kstep = (size_t)(BK * 2);
    const size_t hstep = (size_t)HALF * K * ESZ;
    const unsigned ldsw = (unsigned)wid * 1024u;
    const int aoff = lds_byte(wr * 64 + fr, fq * 8), boff = lds_byte(wc * 32 + fr, fq * 8);
#define PG8_SA(b, h) (((b) * 2 + (h)) * HTB)
#define PG8_SB(b, h) ((4 + (b) * 2 + (h)) * HTB)
#define PG8_STAGE(bufoff, gbase, voff) do { _Pragma("unroll") for (int _i = 0; _i < 2; ++_i) \
        __builtin_amdgcn_global_load_lds((const unsigned*)((const char*)(gbase) + _i * pstep + (voff)), (PG8_LAS unsigned*)(lds + (bufoff) + ldsw + _i * 8192), 16, 0, 0); } while (0)
#define PG8_LDA(dst, b, h) do { _Pragma("unroll") for (int m = 0; m < 4; ++m) { const PG8_LAS unsigned char* p_ = lds + PG8_SA(b, h) + aoff + m * 2048; if constexpr (ESZ == 1) dst##8[m] = cat8(*(const PG8_LAS bf16x8*)p_, *(const PG8_LAS bf16x8*)(p_ + 1024)); else { dst[m][0] = *(const PG8_LAS bf16x8*)p_; dst[m][1] = *(const PG8_LAS bf16x8*)(p_ + 1024); } } } while (0)
#define PG8_LDB(dst, b, h) do { _Pragma("unroll") for (int n = 0; n < 2; ++n) { const PG8_LAS unsigned char* p_ = lds + PG8_SB(b, h) + boff + n * 2048; if constexpr (ESZ == 1) dst##8[n] = cat8(*(const PG8_LAS bf16x8*)p_, *(const PG8_LAS bf16x8*)(p_ + 1024)); else { dst[n][0] = *(const PG8_LAS bf16x8*)p_; dst[n][1] = *(const PG8_LAS bf16x8*)(p_ + 1024); } } } while (0)
#define PG8_MMA(ai, bj, At, Bt) do { __builtin_amdgcn_s_setprio(1); _Pragma("unroll") for (int m = 0; m < 4; ++m) _Pragma("unroll") for (int n = 0; n < 2; ++n) { \
        if constexpr (ESZ == 1) { asm volatile("v_mfma_scale_f32_16x16x128_f8f6f4 %0, %1, %2, %0, %3, %3 op_sel_hi:[0,0,0]" : "+v"(acc[ai][bj][m][n]) : "v"(Bt##8[n]), "v"(At##8[m]), "v"(sc7f)); } \
        else { _Pragma("unroll") for (int k = 0; k < 2; ++k) acc[ai][bj][m][n] = __builtin_amdgcn_mfma_f32_16x16x32_bf16(Bt[n][k], At[m][k], acc[ai][bj][m][n], 0, 0, 0); } } \
        __builtin_amdgcn_s_setprio(0); } while (0)
#define PG8_WAIT_V(n) asm volatile("s_waitcnt vmcnt(" #n ")" ::: "memory")
#define PG8_WAIT_L(n) asm volatile("s_waitcnt lgkmcnt(" #n ")" ::: "memory")
#define PG8_BAR __builtin_amdgcn_s_barrier()
#define PG8_SCHED __builtin_amdgcn_sched_barrier(0)
    Unit cur, nxt; int ui = 0;
    if (!S.next(0, cur)) return;
    f32x4 acc[2][2][4][2];
#pragma unroll
    for (int a = 0; a < 2; ++a)
#pragma unroll
        for (int b = 0; b < 2; ++b)
#pragma unroll
            for (int m = 0; m < 4; ++m)
#pragma unroll
                for (int n = 0; n < 2; ++n) acc[a][b][m][n] = (f32x4){0.f, 0.f, 0.f, 0.f};
    const int sc7f = 0x7f7f7f7f;
    bf16x8 At[4][2], B0[2][2], B1[2][2]; i32x8 At8[4], B08[2], B18[2];
    const char* cA = cur.a; const char* cB = cur.b;
    S.a_ready(cur);
    if constexpr (SP2) {
        PG8_STAGE(PG8_SB(0, 0), cB, voffB); PG8_STAGE(PG8_SB(0, 1), cB + hstep, voffB); PG8_STAGE(PG8_SA(0, 0), cA, voffA); PG8_STAGE(PG8_SA(0, 1), cA + hstep, voffA);
        if (wr == 1) PG8_BAR;
        PG8_WAIT_V(2); PG8_BAR;
        PG8_STAGE(PG8_SB(1, 0), cB + kstep, voffB); PG8_STAGE(PG8_SA(1, 0), cA + kstep, voffA); PG8_STAGE(PG8_SB(1, 1), cB + hstep + kstep, voffB);
        PG8_WAIT_V(6); PG8_BAR;
    } else {
        PG8_STAGE(PG8_SB(0, 0), cB, voffB); PG8_STAGE(PG8_SA(0, 0), cA, voffA); PG8_STAGE(PG8_SB(0, 1), cB + hstep, voffB); PG8_STAGE(PG8_SA(0, 1), cA + hstep, voffA);
        if (wr == 1) PG8_BAR;
        PG8_WAIT_V(4); PG8_BAR;
        PG8_STAGE(PG8_SB(1, 0), cB + kstep, voffB); PG8_STAGE(PG8_SA(1, 0), cA + kstep, voffA); PG8_STAGE(PG8_SB(1, 1), cB + hstep + kstep, voffB);
        PG8_WAIT_V(6); PG8_BAR;
    }
    for (;;) {
        const bool has_next = S.next(ui + 1, nxt);
        const char* nA = has_next ? nxt.a : cA; const char* nB = has_next ? nxt.b : cB;
        for (int t = 0; t < nt; t += 2) {
            const bool last = (t == nt - 2);
            const char* a1 = cA + (size_t)(t + 1) * kstep;
            const char* a2 = last ? nA : cA + (size_t)(t + 2) * kstep; const char* b2 = last ? nB : cB + (size_t)(t + 2) * kstep;
            const char* a3 = a2 + kstep; const char* b3 = b2 + kstep;
            if (last && has_next) S.a_ready(nxt);
            if constexpr (SP2) {
            PG8_LDB(B0, 0, 0); PG8_LDB(B1, 0, 1); PG8_SCHED; PG8_LDA(At, 0, 0); PG8_STAGE(PG8_SA(1, 1), a1 + hstep, voffA);
            PG8_WAIT_V(8); PG8_WAIT_L(0); PG8_BAR; PG8_MMA(0, 0, At, B0); PG8_MMA(0, 1, At, B1); PG8_BAR; PG8_SCHED;
            PG8_LDA(At, 0, 1); PG8_STAGE(PG8_SB(0, 0), b2, voffB); PG8_STAGE(PG8_SB(0, 1), b2 + hstep, voffB); PG8_STAGE(PG8_SA(0, 0), a2, voffA);
            PG8_WAIT_V(8); PG8_WAIT_L(0); PG8_BAR; PG8_MMA(1, 0, At, B0); PG8_MMA(1, 1, At, B1); PG8_BAR; PG8_SCHED;
            PG8_LDB(B0, 1, 0); PG8_LDB(B1, 1, 1); PG8_SCHED; PG8_LDA(At, 1, 0); PG8_STAGE(PG8_SA(0, 1), a2 + hstep, voffA);
            PG8_WAIT_V(8); PG8_WAIT_L(0); PG8_BAR; PG8_MMA(0, 0, At, B0); PG8_MMA(0, 1, At, B1); PG8_BAR; PG8_SCHED;
            PG8_LDA(At, 1, 1); PG8_STAGE(PG8_SB(1, 0), b3, voffB); PG8_STAGE(PG8_SB(1, 1), b3 + hstep, voffB); PG8_STAGE(PG8_SA(1, 0), a3, voffA);
            PG8_WAIT_V(8); PG8_WAIT_L(0); PG8_BAR; PG8_MMA(1, 0, At, B0); PG8_MMA(1, 1, At, B1); PG8_BAR; PG8_SCHED;
            } else {
            PG8_LDB(B0, 0, 0); PG8_SCHED; PG8_LDA(At, 0, 0); PG8_STAGE(PG8_SA(1, 1), a1 + hstep, voffA);
            PG8_WAIT_L(8); PG8_BAR; PG8_WAIT_L(0); PG8_MMA(0, 0, At, B0); PG8_BAR; PG8_SCHED;
            PG8_LDB(B1, 0, 1); PG8_STAGE(PG8_SB(0, 0), b2, voffB);
            PG8_BAR; PG8_WAIT_L(0); PG8_MMA(0, 1, At, B1); PG8_BAR;
            PG8_LDA(At, 0, 1); PG8_STAGE(PG8_SA(0, 0), a2, voffA);
            PG8_BAR; PG8_WAIT_L(0); PG8_MMA(1, 0, At, B0); PG8_BAR; PG8_SCHED;
            PG8_STAGE(PG8_SB(0, 1), b2 + hstep, voffB);
            PG8_WAIT_V(6); PG8_BAR; PG8_MMA(1, 1, At, B1); PG8_BAR;
            PG8_LDB(B0, 1, 0); PG8_SCHED; PG8_LDA(At, 1, 0); PG8_STAGE(PG8_SA(0, 1), a2 + hstep, voffA);
            PG8_WAIT_L(8); PG8_BAR; PG8_WAIT_L(0); PG8_MMA(0, 0, At, B0); PG8_BAR; PG8_SCHED;
            PG8_LDB(B1, 1, 1); PG8_STAGE(PG8_SB(1, 0), b3, voffB);
            PG8_BAR; PG8_WAIT_L(0); PG8_MMA(0, 1, At, B1); PG8_BAR;
            PG8_LDA(At, 1, 1); PG8_STAGE(PG8_SA(1, 0), a3, voffA);
            PG8_BAR; PG8_WAIT_L(0); PG8_MMA(1, 0, At, B0); PG8_BAR; PG8_SCHED;
            PG8_STAGE(PG8_SB(1, 1), b3 + hstep, voffB);
            PG8_WAIT_V(6); PG8_BAR; PG8_MMA(1, 1, At, B1); PG8_BAR;
            }
        }
        if constexpr (ESZ == 1) asm volatile("s_nop 15\n\ts_nop 15" ::: "memory");
        if constexpr (ALIGN_EPI) { if (wr == 0) PG8_BAR; }
        if constexpr (!Epi::AFTER_DRAIN) { int z_ = 0; asm volatile("" : "+v"(z_)); const int ln_ = (int)__builtin_amdgcn_mbcnt_hi(~0u, __builtin_amdgcn_mbcnt_lo(~0u, (unsigned)z_)); const int fr_ = ln_ & 15, fq_ = ln_ >> 4;
            E(acc, cur, wr, wc, fr_, fq_); S.done(cur); }
        if (!has_next) break;
#pragma unroll
        for (int a = 0; a < 2; ++a)
#pragma unroll
            for (int b = 0; b < 2; ++b)
#pragma unroll
                for (int m = 0; m < 4; ++m)
#pragma unroll
                    for (int n = 0; n < 2; ++n) acc[a][b][m][n] = (f32x4){0.f, 0.f, 0.f, 0.f};
        cur = nxt; cA = nA; cB = nB; ++ui;
        if constexpr (ALIGN_EPI) { if (wr == 1) PG8_BAR; }
    }
    PG8_WAIT_V(0);
    if constexpr (!ALIGN_EPI) { if (wr == 0) PG8_BAR; }
    PG8_BAR;
    if constexpr (Epi::AFTER_DRAIN) { E.fused(acc, cur, wr, wc, fr, fq, lds, wid, lane); S.done(cur); }
#undef PG8_SA
#undef PG8_SB
#undef PG8_STAGE
#undef PG8_LDA
#undef PG8_LDB
#undef PG8_MMA
#undef PG8_WAIT_V
#undef PG8_WAIT_L
#undef PG8_BAR
#undef PG8_SCHED
}
}

namespace att {
#define ALAS __attribute__((address_space(3)))
typedef short bf16x8 __attribute__((ext_vector_type(8)));
typedef short s16x4 __attribute__((ext_vector_type(4)));
typedef float f32x16 __attribute__((ext_vector_type(16)));
typedef float f32x4 __attribute__((ext_vector_type(4)));
typedef unsigned u32x4 __attribute__((ext_vector_type(4)));
typedef unsigned short bf16_t;
typedef ALAS char* ALAS_char_ptr;
constexpr int D = 128, PITCH = 1024, NW = 8, QBLK = 32, KVBLK = 64, QB = NW * QBLK, SEQ = 8192;
constexpr int SHM = KVBLK * D * 2;
constexpr int OFF_V = 0, OFF_K = 2 * SHM, OFF_WS = 4 * SHM, OFF_G = OFF_WS + NW * 64 * 4, OFF_FLAG = OFF_G + SEQ * 4, LDS_BYTES = OFF_FLAG + 128;
constexpr float SCALE = 0.08838834764831845f, LOG2E = 1.4426950408889634f, C2 = SCALE * LOG2E;
constexpr float THR2 = 10.0f;
constexpr float SB_EXIT = 152.0f;

#define KSWZ(row, colB) ((row) * 256 + ((colB) ^ (((row) & 7) << 4)))
#define ASBAR() __builtin_amdgcn_sched_barrier(0)
__device__ __forceinline__ int v_st(int k, int c) { const int kk = (k & ~0xC) | ((k & 4) << 1) | ((k & 8) >> 1); return ((kk >> 3) * 4 + (c >> 5)) * 512 + ((kk & 7) * 32 + (c & 31)) * 2; }
__device__ __forceinline__ int v_rd_base(int lane) { return ((lane & 3) << 3) | (((lane >> 2) & 3) << 6) | (((lane >> 4) & 1) << 5) | (((lane >> 5) & 1) << 8); }
constexpr int v_rd_off(int d0, int ks, int half) { return d0 * 512 + ks * 4096 + half * 2048; }
__device__ __forceinline__ int crow(int r, int hi) { return (r & 3) + 8 * (r >> 2) + 4 * hi; }
__device__ __forceinline__ unsigned cvtpk(float lo, float hi) { return pg8::cvt_pk_bf16(lo, hi); }

struct Stage { bf16x8 k0, k1, v0, v1; };
__device__ __forceinline__ void sload(Stage& S, const bf16_t* Kh, const bf16_t* Vh, int kbase, unsigned loff) {
    const char* Kt = (const char*)Kh + (size_t)kbase * PITCH * 2; const char* Vt = (const char*)Vh + (size_t)kbase * PITCH * 2;
    S.v0 = *(const bf16x8*)(Vt + loff); S.v1 = *(const bf16x8*)(Vt + (loff + 32u * PITCH * 2u));
    S.k0 = *(const bf16x8*)(Kt + loff); S.k1 = *(const bf16x8*)(Kt + (loff + 32u * PITCH * 2u));
}
__device__ __forceinline__ void swrite(const Stage& S, ALAS char* lds, int buf, int kws, int vst0, int vst1) {
    *(ALAS bf16x8*)(lds + OFF_K + buf * SHM + kws) = S.k0; *(ALAS bf16x8*)(lds + OFF_K + buf * SHM + kws + 32 * 256) = S.k1;
    *(ALAS bf16x8*)(lds + OFF_V + buf * SHM + vst0) = S.v0; *(ALAS bf16x8*)(lds + OFF_V + buf * SHM + vst1) = S.v1;
}
__device__ __forceinline__ void qkt(f32x16& p0, f32x16& p1, const ALAS char* Kb, int r32, int hi, const bf16x8* qr) {
    p0 = f32x16{}; p1 = f32x16{};
    const ALAS char* kb[4];
#pragma unroll
    for (int dd = 0; dd < 4; ++dd) kb[dd] = Kb + KSWZ(r32, (dd * 16 + hi * 8) * 2);
#pragma unroll
    for (int d0 = 0; d0 < 8; ++d0) { const ALAS char* a = kb[d0 & 3] + (d0 >> 2) * 128;
        const bf16x8 b0 = *(const ALAS bf16x8*)a;
        const bf16x8 b1 = *(const ALAS bf16x8*)(a + 32 * 256);
        p0 = __builtin_amdgcn_mfma_f32_32x32x16_bf16(b0, qr[d0], p0, 0, 0, 0);
        p1 = __builtin_amdgcn_mfma_f32_32x32x16_bf16(b1, qr[d0], p1, 0, 0, 0); }
}
__device__ __forceinline__ void pv_tile(f32x16* o, int vb, bf16x8 pa0, bf16x8 pa1, bf16x8 pa2, bf16x8 pa3) {
#define TRRD(dst, off) asm volatile("ds_read_b64_tr_b16 %0, %1 offset:%2" : "=&v"(dst) : "v"(vb), "i"(off) : "memory")
#define PV_D0(d0) do { s16x4 l0, l1, l2, l3, h0, h1, h2, h3; constexpr int b_ = v_rd_off(d0, 0, 0); \
        TRRD(l0, b_); TRRD(h0, b_ + 2048); TRRD(l1, b_ + 4096); TRRD(h1, b_ + 6144); TRRD(l2, b_ + 8192); TRRD(h2, b_ + 10240); TRRD(l3, b_ + 12288); TRRD(h3, b_ + 14336); \
        asm volatile("s_waitcnt lgkmcnt(0)" ::: "memory"); ASBAR(); \
        o[d0] = __builtin_amdgcn_mfma_f32_32x32x16_bf16(pa0, (bf16x8){l0[0], l0[1], l0[2], l0[3], h0[0], h0[1], h0[2], h0[3]}, o[d0], 0, 0, 0);   \
        o[d0] = __builtin_amdgcn_mfma_f32_32x32x16_bf16(pa1, (bf16x8){l1[0], l1[1], l1[2], l1[3], h1[0], h1[1], h1[2], h1[3]}, o[d0], 0, 0, 0);   \
        o[d0] = __builtin_amdgcn_mfma_f32_32x32x16_bf16(pa2, (bf16x8){l2[0], l2[1], l2[2], l2[3], h2[0], h2[1], h2[2], h2[3]}, o[d0], 0, 0, 0);   \
        o[d0] = __builtin_amdgcn_mfma_f32_32x32x16_bf16(pa3, (bf16x8){l3[0], l3[1], l3[2], l3[3], h3[0], h3[1], h3[2], h3[3]}, o[d0], 0, 0, 0); } while (0)
    PV_D0(0); PV_D0(1); PV_D0(2); PV_D0(3);
#undef PV_D0
#undef TRRD
}
__device__ __forceinline__ void pack_p(const f32x16& p0, const f32x16& p1, bf16x8& pa0, bf16x8& pa1, bf16x8& pa2, bf16x8& pa3) {
#define PK4(P, B_, OUT) do { unsigned a0 = cvtpk(P[B_+0], P[B_+1]), a1 = cvtpk(P[B_+2], P[B_+3]);                          \
        unsigned b0 = cvtpk(P[B_+4], P[B_+5]), b1 = cvtpk(P[B_+6], P[B_+7]);                                             \
        auto r0 = __builtin_amdgcn_permlane32_swap(a0, b0, false, false); auto r1 = __builtin_amdgcn_permlane32_swap(a1, b1, false, false); \
        u32x4 w = {r0[0], r1[0], r0[1], r1[1]}; OUT = *reinterpret_cast<bf16x8*>(&w); } while (0)
    PK4(p0, 0, pa0); PK4(p0, 8, pa1); PK4(p1, 0, pa2); PK4(p1, 8, pa3);
#undef PK4
}
__device__ __forceinline__ void store_o(const f32x16* o, const float* rs, bf16_t* Ow  , int r32, int hi) {
    const unsigned lo = (unsigned)((4 * hi * PITCH + r32) * 2);
#pragma unroll
    for (int r = 0; r < 16; ++r) { const int orow0 = (r & 3) + 8 * (r >> 2);
#pragma unroll
        for (int d0 = 0; d0 < 4; ++d0) { const float v = o[d0][r] * rs[r]; const float vn = __shfl_xor(v, 1);
            if ((r32 & 1) == 0) *(unsigned*)((char*)Ow + (lo + (unsigned)((orow0 * PITCH + d0 * 32) * 2))) = cvtpk(v, vn); } }
}

__device__ __forceinline__ void fox_unit(const bf16_t* Qh, const bf16_t* Kh, const bf16_t* Vh, bf16_t* Oh, const float* Gh, int qb, int t0, int t1, int mode, float* part, unsigned* flag, unsigned* tmo, const unsigned* km, ALAS char* lds) {
    int tid = threadIdx.x; asm volatile("" : "+v"(tid));
    const int wid = __builtin_amdgcn_readfirstlane(tid >> 6), lane = tid & 63, r32 = lane & 31, hi = lane >> 5;
    const int P0 = qb * QB, NT = 4 * (qb + 1);
    const int sr = tid >> 4, sc = (tid & 15) * 8, vst0 = v_st(sr, sc), vst1 = v_st(32 + sr, sc), kws = KSWZ(sr, sc * 2); const unsigned loff = (unsigned)((sr * PITCH + sc) * 2);
    const int vb0 = (int)(unsigned)(size_t)(lds + OFF_V) + v_rd_base(lane);
    ALAS float* wsf = (ALAS float*)(lds + OFF_WS) + wid * 64; ALAS float* li_l = wsf; ALAS float* al_l = wsf + 32;
    ALAS float* Gl = (ALAS float*)(lds + OFF_G);
    {
        f32x4 a[4]; float run = 0.f;
#pragma unroll
        for (int i = 0; i < 4; ++i) a[i] = *(const f32x4*)((const char*)Gh + (unsigned)((tid * 16 + i * 4) * 4));
#pragma unroll
        for (int i = 0; i < 4; ++i) { a[i].x += run; a[i].y += a[i].x; a[i].z += a[i].y; a[i].w += a[i].z; run = a[i].w; }
        float inc = run;
#pragma unroll
        for (int o = 1; o < 64; o <<= 1) { const float t = __shfl_up(inc, o); if (lane >= o) inc += t; }
        ALAS float* wtot = (ALAS float*)(lds + OFF_FLAG + 96);
        if (lane == 63) wtot[wid] = inc;
        __syncthreads();
        float off = inc - run;
#pragma unroll
        for (int w = 0; w < NW; ++w) off += w < wid ? wtot[w] : 0.f;
#pragma unroll
        for (int i = 0; i < 4; ++i) ((ALAS f32x4*)Gl)[tid * 4 + i] = (a[i] + off) * LOG2E;
    }
    bf16x8 qr[8];
#pragma unroll
    for (int d0 = 0; d0 < 8; ++d0) qr[d0] = *(const bf16x8*)((const char*)Qh + (size_t)P0 * PITCH * 2 + (unsigned)(((wid * QBLK + r32) * PITCH + hi * 8) * 2 + d0 * 32));
    Stage S; sload(S, Kh, Vh, (NT - 1 - t0) * KVBLK, loff);
    asm volatile("s_waitcnt vmcnt(0)" ::: "memory"); swrite(S, lds, 0, kws, vst0, vst1);
    __syncthreads();
    float cq;
    { float k2 = 0.f;
#pragma unroll
      for (int w = 0; w < 4; ++w) k2 += __uint_as_float(__hip_atomic_load(km + w, __ATOMIC_RELAXED, __HIP_MEMORY_SCOPE_AGENT));
      float q2 = 0.f;
#pragma unroll
      for (int d0 = 0; d0 < 8; ++d0) { const u32x4 u = __builtin_bit_cast(u32x4, qr[d0]);
#pragma unroll
          for (int j = 0; j < 4; ++j) { const float a = __uint_as_float(u[j] << 16), b = __uint_as_float(u[j] & 0xffff0000u); q2 += a * a + b * b; } }
      { auto rr = __builtin_amdgcn_permlane32_swap(__float_as_uint(q2), __float_as_uint(q2), false, false); q2 = __uint_as_float(rr[0]) + __uint_as_float(rr[1]); }
      cq = sqrtf(q2) * sqrtf(k2) * (1.01f * C2); }
    ALAS int* flg = (ALAS int*)(lds + OFF_FLAG);
    const float Gref = Gl[P0 + QB - 1];
    float m_reg = -1e30f, l_reg = 0.f; f32x16 o[4] = {};
    const int qlo = P0 + wid * QBLK, qm = qlo + r32 - 4 * hi;
    for (int t = t0; t < t1; ++t) {
        const int buf = (t - t0) & 1, kb = (NT - 1 - t) * KVBLK;
        if (t + 1 < t1) sload(S, Kh, Vh, kb - KVBLK, loff);
        ASBAR();
        if (kb <= qlo + QBLK - 1) {
            f32x16 p0, p1;
            qkt(p0, p1, lds + OFF_K + buf * SHM, r32, hi, qr);
#pragma unroll
            for (int g = 0; g < 4; ++g) { const f32x4 b0 = *(const ALAS f32x4*)(Gl + kb + 8 * g + 4 * hi), b1 = *(const ALAS f32x4*)(Gl + kb + 32 + 8 * g + 4 * hi);
#pragma unroll
                for (int i = 0; i < 4; ++i) { p0[4 * g + i] = fmaf(p0[4 * g + i], C2, Gref - b0[i]); p1[4 * g + i] = fmaf(p1[4 * g + i], C2, Gref - b1[i]); } }
            if (kb + KVBLK - 1 > qlo) {
                const int dq = qm - kb; const float NEG = -__builtin_inff();
#pragma unroll
                for (int r = 0; r < 16; ++r) { const int c = (r & 3) + 8 * (r >> 2); if (dq - c < 0) p0[r] = NEG; if (dq - c - 32 < 0) p1[r] = NEG; }
            }
            float pmax = p0[0];
#pragma unroll
            for (int r = 1; r < 16; ++r) pmax = fmaxf(pmax, p0[r]);
#pragma unroll
            for (int r = 0; r < 16; ++r) pmax = fmaxf(pmax, p1[r]);
            { auto rr = __builtin_amdgcn_permlane32_swap(__float_as_uint(pmax), __float_as_uint(pmax), false, false); pmax = fmaxf(__uint_as_float(rr[0]), __uint_as_float(rr[1])); }
            float mn, alpha;
            if (__all(pmax - m_reg <= THR2)) { mn = m_reg; alpha = 1.f; }
            else { mn = fmaxf(m_reg, pmax); alpha = __builtin_amdgcn_exp2f(m_reg - mn); m_reg = mn; }
            float ps = 0.f;
#pragma unroll
            for (int r = 0; r < 16; ++r) { p0[r] = __builtin_amdgcn_exp2f(p0[r] - mn); ps += p0[r]; }
#pragma unroll
            for (int r = 0; r < 16; ++r) { p1[r] = __builtin_amdgcn_exp2f(p1[r] - mn); ps += p1[r]; }
            { auto rr = __builtin_amdgcn_permlane32_swap(__float_as_uint(ps), __float_as_uint(ps), false, false); ps = __uint_as_float(rr[0]) + __uint_as_float(rr[1]); }
            l_reg = l_reg * alpha + ps;
            bf16x8 pa0, pa1, pa2, pa3; pack_p(p0, p1, pa0, pa1, pa2, pa3);
            if (__any(alpha < 1.f)) { if (hi == 0) al_l[r32] = alpha; asm volatile("s_waitcnt lgkmcnt(0)" ::: "memory");
#pragma unroll
                for (int d_ = 0; d_ < 4; ++d_)
#pragma unroll
                    for (int r = 0; r < 16; ++r) o[d_][r] *= al_l[crow(r, hi)]; }
            ASBAR();
            pv_tile(o, vb0 + buf * SHM, pa0, pa1, pa2, pa3);
        }
        { const float gb = kb > 0 ? Gref - Gl[kb - 1] : 0.f;
          const bool done_w = __all(cq + gb <= m_reg - SB_EXIT);
          if (lane == 0) flg[buf * 8 + wid] = done_w ? 1 : 0; }
        if (t + 1 < t1) { asm volatile("s_waitcnt vmcnt(0)" ::: "memory"); swrite(S, lds, buf ^ 1, kws, vst0, vst1); }
        __syncthreads();
        int all_done = 1;
#pragma unroll
        for (int w = 0; w < NW; ++w) all_done &= flg[buf * 8 + w];
        if (all_done) break;
    }
    if (mode == 1) {
        float* Op = part + (size_t)(wid * QBLK) * D;
#pragma unroll
        for (int r = 0; r < 16; ++r)
#pragma unroll
            for (int d0 = 0; d0 < 4; ++d0) *(float*)((char*)Op + (unsigned)((crow(r, hi) * D + d0 * 32 + r32) * 4)) = o[d0][r];
        if (hi == 0) { part[QB * D + wid * QBLK + r32] = m_reg; part[QB * D + QB + wid * QBLK + r32] = l_reg; }
        asm volatile("s_waitcnt vmcnt(0)" ::: "memory");
        __syncthreads();
        if (tid == 0) { __builtin_amdgcn_fence(__ATOMIC_RELEASE, "agent"); asm volatile("s_waitcnt vmcnt(0)" ::: "memory");
            __hip_atomic_store(flag, 1u, __ATOMIC_RELAXED, __HIP_MEMORY_SCOPE_AGENT); }
        __syncthreads();
        return;
    }
    if (mode == 2) {
        if (tid == 0) { unsigned sp = 0u;
            while (__hip_atomic_load(flag, __ATOMIC_RELAXED, __HIP_MEMORY_SCOPE_AGENT) == 0u) { __builtin_amdgcn_s_sleep(4); if (++sp > (1u << 21)) { atomicAdd(tmo, 1u); break; } }
            __builtin_amdgcn_fence(__ATOMIC_ACQUIRE, "agent"); asm volatile("s_waitcnt vmcnt(0)" ::: "memory"); }
        __syncthreads();
        const float mB = part[QB * D + wid * QBLK + r32], lB = part[QB * D + QB + wid * QBLK + r32];
        const float mN = fmaxf(m_reg, mB), fa = __builtin_amdgcn_exp2f(m_reg - mN), fb = __builtin_amdgcn_exp2f(mB - mN);
        l_reg = l_reg * fa + lB * fb;
        if (hi == 0) { al_l[r32] = fa; li_l[r32] = fb; } asm volatile("s_waitcnt lgkmcnt(0)" ::: "memory");
        const float* Op = part + (size_t)(wid * QBLK) * D;
#pragma unroll
        for (int r = 0; r < 16; ++r) { const float ar = al_l[crow(r, hi)], br = li_l[crow(r, hi)];
#pragma unroll
            for (int d0 = 0; d0 < 4; ++d0) o[d0][r] = o[d0][r] * ar + *(const float*)((const char*)Op + (unsigned)((crow(r, hi) * D + d0 * 32 + r32) * 4)) * br; }
        asm volatile("s_waitcnt lgkmcnt(0)" ::: "memory");
    }
    if (hi == 0) li_l[r32] = l_reg; asm volatile("s_waitcnt lgkmcnt(0)" ::: "memory");
    float rli[16];
#pragma unroll
    for (int r = 0; r < 16; ++r) rli[r] = __builtin_amdgcn_rcpf(li_l[crow(r, hi)]);
    store_o(o, rli, Oh + (size_t)(P0 + wid * QBLK) * PITCH, r32, hi);
    __syncthreads();
}

__device__ __forceinline__ float softplus2(float u) { return fmaxf(u, 0.f) + __builtin_amdgcn_logf(1.0f + __builtin_amdgcn_exp2f(-fabsf(u))); }
__device__ __forceinline__ void sb_unit(const bf16_t* Qh, const bf16_t* Kh, const bf16_t* Vh, bf16_t* Oh, int qb, ALAS char* lds) {
    int tid = threadIdx.x; asm volatile("" : "+v"(tid));
    const int wid = __builtin_amdgcn_readfirstlane(tid >> 6), lane = tid & 63, r32 = lane & 31, hi = lane >> 5;
    const int P0 = qb * QB, NT = 4 * (qb + 1);
    const int sr = tid >> 4, sc = (tid & 15) * 8, vst0 = v_st(sr, sc), vst1 = v_st(32 + sr, sc), kws = KSWZ(sr, sc * 2); const unsigned loff = (unsigned)((sr * PITCH + sc) * 2);
    const int vb0 = (int)(unsigned)(size_t)(lds + OFF_V) + v_rd_base(lane);
    ALAS int* flg = (ALAS int*)(lds + OFF_FLAG);
    bf16x8 qr[8];
#pragma unroll
    for (int d0 = 0; d0 < 8; ++d0) qr[d0] = *(const bf16x8*)((const char*)Qh + (size_t)P0 * PITCH * 2 + (unsigned)(((wid * QBLK + r32) * PITCH + hi * 8) * 2 + d0 * 32));
    Stage S; sload(S, Kh, Vh, (NT - 1) * KVBLK, loff);
    asm volatile("s_waitcnt vmcnt(0)" ::: "memory"); swrite(S, lds, 0, kws, vst0, vst1);
    __syncthreads();
    float carry = 0.f; f32x16 o[4] = {};
    const int qlo = P0 + wid * QBLK, qm = qlo + r32 - 4 * hi;
    for (int t = 0; t < NT; ++t) {
        const int buf = t & 1, kb = (NT - 1 - t) * KVBLK;
        if (t + 1 < NT) sload(S, Kh, Vh, kb - KVBLK, loff);
        ASBAR();
        if (kb < qlo + QBLK - 1) {
            f32x16 p0, p1, s0, s1;
            qkt(p0, p1, lds + OFF_K + buf * SHM, r32, hi, qr);
            const int dq = qm - kb - 1;
#pragma unroll
            for (int r = 0; r < 16; ++r) { const int c = (r & 3) + 8 * (r >> 2);
                p0[r] *= C2; p1[r] *= C2;
                s0[r] = (dq - c < 0) ? 0.f : softplus2(p0[r]); s1[r] = (dq - c - 32 < 0) ? 0.f : softplus2(p1[r]); }
#pragma unroll
            for (int g = 0; g < 4; ++g) { s0[4 * g + 2] += s0[4 * g + 3]; s0[4 * g + 1] += s0[4 * g + 2]; s0[4 * g] += s0[4 * g + 1];
                                          s1[4 * g + 2] += s1[4 * g + 3]; s1[4 * g + 1] += s1[4 * g + 2]; s1[4 * g] += s1[4 * g + 1]; }
            float e0[4], e1[4], running = carry;
#pragma unroll
            for (int g = 3; g >= 0; --g) { auto rb = __builtin_amdgcn_permlane32_swap(__float_as_uint(s1[4 * g]), __float_as_uint(s1[4 * g]), false, false);
                const float eh = running; running += __uint_as_float(rb[1]); const float el = running; running += __uint_as_float(rb[0]); e1[g] = hi ? eh : el; }
#pragma unroll
            for (int g = 3; g >= 0; --g) { auto ra = __builtin_amdgcn_permlane32_swap(__float_as_uint(s0[4 * g]), __float_as_uint(s0[4 * g]), false, false);
                const float eh = running; running += __uint_as_float(ra[1]); const float el = running; running += __uint_as_float(ra[0]); e0[g] = hi ? eh : el; }
            carry = running;
#pragma unroll
            for (int g = 0; g < 4; ++g) {
#pragma unroll
                for (int i = 0; i < 4; ++i) { const int r = 4 * g + i, c = (r & 3) + 8 * (r >> 2);
                    p0[r] = (dq - c < 0) ? 0.f : __builtin_amdgcn_exp2f(p0[r] - (e0[g] + s0[r]));
                    p1[r] = (dq - c - 32 < 0) ? 0.f : __builtin_amdgcn_exp2f(p1[r] - (e1[g] + s1[r])); } }
            bf16x8 pa0, pa1, pa2, pa3; pack_p(p0, p1, pa0, pa1, pa2, pa3);
            ASBAR();
            pv_tile(o, vb0 + buf * SHM, pa0, pa1, pa2, pa3);
        }
        const bool done_w = __all(carry > SB_EXIT);
        if (lane == 0) flg[buf * 8 + wid] = done_w ? 1 : 0;
        if (t + 1 < NT) { asm volatile("s_waitcnt vmcnt(0)" ::: "memory"); swrite(S, lds, buf ^ 1, kws, vst0, vst1); }
        __syncthreads();
        int all_done = 1;
#pragma unroll
        for (int w = 0; w < NW; ++w) all_done &= flg[buf * 8 + w];
        if (all_done) break;
    }
    float one[16];
#pragma unroll
    for (int r = 0; r < 16; ++r) one[r] = 1.f;
    store_o(o, one, Oh + (size_t)(P0 + wid * QBLK) * PITCH, r32, hi);
    __syncthreads();
}
#undef KSWZ
#undef ASBAR
}

constexpr int NWAVES = 8;
constexpr int N_LAUNCHES = MK_N_LAUNCHES;
constexpr int PER_PHASE = 9;

constexpr int T = 8192, DM = 2048, NH = 8, HD = 128, DH = NH * HD  ;
constexpr int NIN = 3 * DH + 3 * DH + NH + 2 * DM;
constexpr int NIN_G = 6 * DH + 2 * DM;
constexpr int NE = 32, TOPK = 4, DFF = DM, CAP = T;
constexpr float RMS_EPS = 1e-5f;

constexpr size_t MiB = 1u << 20;
constexpr size_t WS_CTL = 0, CTL_ZERO_BYTES = 128 * 1024;
constexpr size_t WS_WIN = 1 * MiB;
constexpr size_t WS_WPA = 41 * MiB, WS_WPB = 45 * MiB;
constexpr size_t WS_WOUT = 49 * MiB;
constexpr size_t WS_W1 = 57 * MiB;
constexpr size_t WS_W2 = 569 * MiB;
constexpr size_t WS_HN = 825 * MiB;
constexpr size_t WS_QKV = 857 * MiB, QKV_STRIDE = 16 * MiB;
constexpr size_t WS_GATES = 1050 * MiB;
constexpr size_t WS_LOGF = 1017 * MiB, WS_G = WS_LOGF + 512 * 1024;
constexpr size_t WS_OSB = 1018 * MiB, WS_OFX = 1034 * MiB;
constexpr size_t WS_PART = 953 * MiB;
constexpr size_t WS_MIXED = 1114 * MiB;
constexpr size_t WS_X1 = 1146 * MiB;
constexpr size_t WS_STOK = 1210 * MiB, WS_SW = 1211 * MiB;
constexpr size_t WS_Y = 2365 * MiB;
constexpr size_t WS_AS = 1341 * MiB;
constexpr size_t WS_H = 1853 * MiB;
constexpr size_t WS_HN8 = 3389 * MiB;
constexpr size_t WS_WIN8 = 3405 * MiB;
constexpr size_t WS_END = 3413 * MiB;
constexpr int CW_TMO = 0, CW_CODE = 1;
constexpr int CW_BAR = 4096;
constexpr int CW_CNT = 8192;
constexpr int CW_QF = 12288, CW_QS = CW_QF + 64 * 8;
constexpr int CW_QC = CW_QS + 64 * 8;
constexpr int CW_KM = CW_QC + 64;
constexpr int CW_FLAG = 16384;
static_assert((CW_FLAG + 64 * 128) * 4 <= (int)CTL_ZERO_BYTES && (CW_CNT + 64 * NE) <= CW_QF, "CTL words inside the memset region");

constexpr int RING_OFF = 0, RING_BYTES = 131072;
constexpr int LDSCTL_OFF = RING_BYTES, MISC_OFF = LDSCTL_OFF + 320;
constexpr int TAB_OFF = LDSCTL_OFF + 1024;
constexpr int LDS_BYTES = 147456;
static_assert(att::LDS_BYTES <= RING_BYTES, "attention scratch fits the ring region");

#define GAS __attribute__((address_space(1)))
#define LAS __attribute__((address_space(3)))
typedef unsigned short bf16;
typedef unsigned v4u __attribute__((ext_vector_type(4)));
typedef unsigned v2u __attribute__((ext_vector_type(2)));
typedef float f32x4 __attribute__((ext_vector_type(4)));
typedef float f32x16 __attribute__((ext_vector_type(16)));
typedef short bf16x8 __attribute__((ext_vector_type(8)));
typedef GAS unsigned gu32;
typedef GAS unsigned long long gu64;
#define RLX_AGENT __ATOMIC_RELAXED, __HIP_MEMORY_SCOPE_AGENT
#define LDS_WAIT() asm volatile("s_waitcnt lgkmcnt(0)" ::: "memory")
#define VM_WAIT() asm volatile("s_waitcnt vmcnt(0)" ::: "memory")
__device__ __forceinline__ unsigned long long rt() { return __builtin_amdgcn_s_memrealtime(); }
__device__ __forceinline__ unsigned f2bf(float f) { unsigned u = __builtin_bit_cast(unsigned, f); return (u + 0x7fffu + ((u >> 16) & 1u)) >> 16; }
__device__ __forceinline__ unsigned pk2(float lo, float hi) { return f2bf(lo) | (f2bf(hi) << 16); }

#define XB_TMO      128
#define XB_XCNT(j)  (256  + 64 * (j))
#define XB_XSUB(j)  (1280 + 64 * (j))
#define XB_XGEN(j)  (2304 + 64 * (j))
#define XB_TOP      3328
#define XB_TOPGEN   3392
#define XCD_BAR_WORDS 3456
#define XB_SPIN_CAP (1u << 18)

__device__ __forceinline__ unsigned xb_ld(unsigned* p)              { return __hip_atomic_load(p, __ATOMIC_RELAXED, __HIP_MEMORY_SCOPE_AGENT); }
__device__ __forceinline__ unsigned xb_add(unsigned* p, unsigned v) { return __hip_atomic_fetch_add(p, v, __ATOMIC_RELAXED, __HIP_MEMORY_SCOPE_AGENT); }
__device__ __forceinline__ unsigned xb_xcc_id() { return (unsigned)__builtin_amdgcn_s_getreg((3 << 11) | 20) & 0xFu; }
#define XB_SPIN(cond, bar) do { unsigned _sp = 0; while (cond) { __builtin_amdgcn_s_sleep(1); \
    if ((++_sp & 255u) == 0u) { if (xb_ld(&(bar)[XB_TMO])) break; if (_sp > XB_SPIN_CAP) { atomicAdd(&(bar)[XB_TMO], 1u); break; } } } } while (0)

struct XcdBarrier {
    unsigned* bar; unsigned x;
    volatile LAS unsigned* st;
};

__device__ __forceinline__ XcdBarrier xcd_barrier_post(unsigned* bar, volatile LAS unsigned* st) {
    XcdBarrier b; b.bar = bar; b.x = xb_xcc_id(); b.st = st;
    if (threadIdx.x == 0) (void)xb_add(&bar[XB_XCNT(b.x)], 1u);
    return b;
}
__device__ __forceinline__ void xcd_barrier_complete(unsigned* bar, unsigned x, unsigned& nloc, unsigned& nx) {
    const unsigned G = gridDim.x * gridDim.y * gridDim.z;
    unsigned sum, cnt, mine, sp = 0u;
    for (;;) {
        sum = 0u; cnt = 0u; mine = 0u;
#pragma unroll
        for (unsigned j = 0; j < 16; ++j) { const unsigned c = xb_ld(&bar[XB_XCNT(j)]); sum += c; cnt += (c > 0u) ? 1u : 0u; mine = (j == x) ? c : mine; }
        if (sum == G) break;
        __builtin_amdgcn_s_sleep(1);
        if ((++sp & 255u) == 0u) { if (xb_ld(&bar[XB_TMO])) break; if (sp > XB_SPIN_CAP) { atomicAdd(&bar[XB_TMO], 1u); break; } }
    }
    nloc = mine > 0u ? mine : 1u; nx = cnt > 0u ? cnt : 1u;
}

__device__ __forceinline__ void xcd_barrier(const XcdBarrier& b) {
    asm volatile("s_waitcnt vmcnt(0)" ::: "memory");
    __syncthreads();
    if (threadIdx.x == 0) {
        unsigned* bar = b.bar;
        __builtin_amdgcn_s_waitcnt(0);
        unsigned nloc = b.st[0], nx = b.st[1];
        if (nloc == 0u) { xcd_barrier_complete(bar, b.x, nloc, nx); b.st[0] = nloc; b.st[1] = nx; }
        const unsigned old = xb_add(&bar[XB_XSUB(b.x)], 1u);
        const unsigned gen = old / nloc;
        if (old + 1u == (gen + 1u) * nloc) {
            __builtin_amdgcn_fence(__ATOMIC_RELEASE, "agent");
            asm volatile("s_waitcnt vmcnt(0)" ::: "memory");
            const unsigned og = xb_add(&bar[XB_TOP], 1u);
            const unsigned tg = og / nx;
            if (og + 1u == (tg + 1u) * nx) xb_add(&bar[XB_TOPGEN], 1u);
            else XB_SPIN(xb_ld(&bar[XB_TOPGEN]) == tg, bar);
            __builtin_amdgcn_fence(__ATOMIC_ACQUIRE, "agent");
            xb_add(&bar[XB_XGEN(b.x)], 1u);
            asm volatile("s_waitcnt vmcnt(0)" ::: "memory");
        } else {
            XB_SPIN(xb_ld(&bar[XB_XGEN(b.x)]) == gen, bar);
            __builtin_amdgcn_fence(__ATOMIC_ACQUIRE, "agent");
            asm volatile("s_waitcnt vmcnt(0)" ::: "memory");
        }
    }
    __syncthreads();
}

struct Frame {
    LAS unsigned char* lds;
    volatile LAS unsigned* MISC;
    gu32* ctl;
    int tid, lane, wave;
    int vcu, G;
    const float *x, *g_mix, *w_in, *b_forget, *b_gate, *w_psb, *w_pfx, *w_out, *g_ffn, *w_router, *b_router, *w1, *b1, *w2, *b2, *g_final;
    float* out; unsigned char* ws;
};
__device__ __forceinline__ float wave_sum(float v) {
#pragma unroll
    for (int o = 1; o < 64; o <<= 1) v += __shfl_xor(v, o);
    return v;
}
__device__ __forceinline__ unsigned pkbf(float lo, float hi) { return pg8::cvt_pk_bf16(lo, hi); }

__device__ __forceinline__ void transpose_item(const float* src  , int ldw, bf16* dst  , int K, LAS unsigned char* scr, int tid) {
    const int kb = tid & 7, ng = tid >> 3;
    const float* s = src + (size_t)(kb * 8) * ldw + ng * 4;
    f32x4 v[8];
#pragma unroll
    for (int r = 0; r < 8; ++r) v[r] = *(const f32x4*)(s + (size_t)r * ldw);
#pragma unroll
    for (int j = 0; j < 4; ++j) { v4u o; o.x = pkbf(v[0][j], v[1][j]); o.y = pkbf(v[2][j], v[3][j]); o.z = pkbf(v[4][j], v[5][j]); o.w = pkbf(v[6][j], v[7][j]);
        *(LAS v4u*)(scr + (ng * 4 + j) * 144 + kb * 16) = o; }
    __syncthreads();
    const int c = tid & 7, n = tid >> 3;
#pragma unroll
    for (int i = 0; i < 4; ++i) { const int nn = n + 64 * i; const v4u o = *(const LAS v4u*)(scr + nn * 144 + c * 16); *(v4u*)(dst + (size_t)nn * K + c * 8) = o; }
    __syncthreads();
}
__device__ __forceinline__ void transpose_item_fp8(const float* src  , int ldw, unsigned char* dst  , int K, LAS unsigned char* scr, int tid) {
    const int kb = tid & 7, ng = tid >> 3;
#pragma unroll
    for (int p = 0; p < 2; ++p) {
        const float* s = src + (size_t)(p * 64 + kb * 8) * ldw + ng * 4;
        f32x4 v[8];
#pragma unroll
        for (int r = 0; r < 8; ++r) v[r] = *(const f32x4*)(s + (size_t)r * ldw) * pg8::W8_SCALE;
#pragma unroll
        for (int j = 0; j < 4; ++j) { v2u o; o.x = pg8::pk4_fp8(v[0][j], v[1][j], v[2][j], v[3][j]); o.y = pg8::pk4_fp8(v[4][j], v[5][j], v[6][j], v[7][j]);
            *(LAS v2u*)(scr + (ng * 4 + j) * 144 + p * 64 + kb * 8) = o; }
    }
    __syncthreads();
    const int c = tid & 7, n = tid >> 3;
#pragma unroll
    for (int i = 0; i < 4; ++i) { const int nn = n + 64 * i; const v4u o = *(const LAS v4u*)(scr + nn * 144 + c * 16); *(v4u*)(dst + (size_t)nn * K + c * 16) = o; }
    __syncthreads();
}
__device__ __forceinline__ void conv_load(f32x4 (&v)[8], const float* src, int ldw, int p, int kg, int cg) {
    const float* s = src + (size_t)(p * 64 + kg * 8) * ldw + cg * 4;
#pragma unroll
    for (int r = 0; r < 8; ++r) v[r] = __builtin_nontemporal_load((const f32x4*)(s + (size_t)r * ldw));
}
__device__ __forceinline__ void conv_to_lds(const f32x4 (&v)[8], LAS unsigned char* wscr, int p, int kg, int cg) {
#pragma unroll
    for (int j = 0; j < 4; ++j) { v2u o; o.x = pg8::pk4_fp8(v[0][j] * pg8::W8_SCALE, v[1][j] * pg8::W8_SCALE, v[2][j] * pg8::W8_SCALE, v[3][j] * pg8::W8_SCALE);
        o.y = pg8::pk4_fp8(v[4][j] * pg8::W8_SCALE, v[5][j] * pg8::W8_SCALE, v[6][j] * pg8::W8_SCALE, v[7][j] * pg8::W8_SCALE);
        *(LAS v2u*)(wscr + (cg * 4 + j) * 144 + p * 64 + kg * 8) = o; }
}
__device__ __forceinline__ void p0_prologue(Frame& F) {
    LAS unsigned char* scr = F.lds + RING_OFF;
    bf16* WIN = (bf16*)(F.ws + WS_WIN); bf16* WPA = (bf16*)(F.ws + WS_WPA); bf16* WPB = (bf16*)(F.ws + WS_WPB); bf16* WOUT = (bf16*)(F.ws + WS_WOUT);
    constexpr int I_WIN = 32 * 24, I_WP = 16 * 8, I_WOUT = 32 * 8;
    constexpr int NITEMS = I_WIN + 2 * I_WP + I_WOUT;
    {
        LAS unsigned char* wscr = scr + F.wave * (32 * 144);
        const int kg = F.lane >> 3, cg = F.lane & 7, c = F.lane & 7, n = F.lane >> 3;
        auto item = [&](int it, const float*& src, bf16*& dst, int& ldw, int& K) {
            int r = it;
            if (r < I_WIN) { const int nb = r % 24, kk = r / 24; src = F.w_in + (size_t)(kk * 64) * NIN + nb * 256; ldw = NIN; dst = WIN + (size_t)(nb * 256) * DM + kk * 64; K = DM; return; } r -= I_WIN;
            if (r < I_WP) { const int nb = r % 8, kk = r / 8; src = F.w_psb + (size_t)(kk * 64) * DM + nb * 256; ldw = DM; dst = WPA + (size_t)(nb * 256) * DH + kk * 64; K = DH; return; } r -= I_WP;
            if (r < I_WP) { const int nb = r % 8, kk = r / 8; src = F.w_pfx + (size_t)(kk * 64) * DM + nb * 256; ldw = DM; dst = WPB + (size_t)(nb * 256) * DH + kk * 64; K = DH; return; } r -= I_WP;
            { const int nb = r % 8, kk = r / 8; src = F.w_out + (size_t)(kk * 64) * DM + nb * 256; ldw = DM; dst = WOUT + (size_t)(nb * 256) * DM + kk * 64; K = DM; }
        };
        auto load8 = [&](f32x4 (&v)[8], const float* src, int ldw) { const float* p = src + (size_t)(kg * 8) * ldw + F.wave * 32 + cg * 4;
#pragma unroll
            for (int r = 0; r < 8; ++r) v[r] = __builtin_nontemporal_load((const f32x4*)(p + (size_t)r * ldw)); };
        f32x4 va[8], vb[8]; const float* src; bf16* dst; int ldw, K;
        int it = F.vcu;
        if (it < NITEMS) { item(it, src, dst, ldw, K); load8(va, src, ldw); }
        for (; it < NITEMS; it += 2 * F.G) {
#define P0_FLUSH(V, DST, KK) do { _Pragma("unroll") for (int j = 0; j < 4; ++j) { v4u o; o.x = pkbf(V[0][j], V[1][j]); o.y = pkbf(V[2][j], V[3][j]); o.z = pkbf(V[4][j], V[5][j]); o.w = pkbf(V[6][j], V[7][j]); \
                *(LAS v4u*)(wscr + (cg * 4 + j) * 144 + kg * 16) = o; } \
            asm volatile("s_waitcnt lgkmcnt(0)" ::: "memory"); \
            _Pragma("unroll") for (int i = 0; i < 4; ++i) { const int nn = n + 8 * i; const v4u o = *(const LAS v4u*)(wscr + nn * 144 + c * 16); *(v4u*)((DST) + (size_t)(F.wave * 32 + nn) * (KK) + c * 8) = o; } \
            asm volatile("s_waitcnt lgkmcnt(0)" ::: "memory"); } while (0)
            bf16* dA = dst; const int KA = K; const int itb = it + F.G;
            const float* sB = src; bf16* dB = dst; int lB = ldw, KB = K;
            if (itb < NITEMS) { item(itb, sB, dB, lB, KB); load8(vb, sB, lB); }
            P0_FLUSH(va, dA, KA);
            if (itb + F.G < NITEMS) { item(itb + F.G, src, dst, ldw, K); load8(va, src, ldw); }
            if (itb < NITEMS) P0_FLUSH(vb, dB, KB);
#undef P0_FLUSH
        }
    }
    {
        LAS unsigned char* wscr = scr + F.wave * (32 * 144); unsigned char* WIN8 = F.ws + WS_WIN8;
        const int kg = F.lane >> 3, cg = F.lane & 7, c = F.lane & 7, n = F.lane >> 3;
        for (int it = F.vcu; it < 256; it += F.G) { const int nb = it & 15, kk = it >> 4;
            const float* src = F.w_in + (size_t)(kk * 128) * NIN + 6 * DH + NH + nb * 256 + F.wave * 32; unsigned char* dst = WIN8 + (size_t)(nb * 256 + F.wave * 32) * DM + kk * 128;
            f32x4 va[8], vb[8]; conv_load(va, src, NIN, 0, kg, cg); conv_load(vb, src, NIN, 1, kg, cg);
            conv_to_lds(va, wscr, 0, kg, cg); conv_to_lds(vb, wscr, 1, kg, cg);
            asm volatile("s_waitcnt lgkmcnt(0)" ::: "memory");
#pragma unroll
            for (int i = 0; i < 4; ++i) { const int nn = n + 8 * i; const v4u o = *(const LAS v4u*)(wscr + nn * 144 + c * 16); *(v4u*)(dst + (size_t)nn * DM + c * 16) = o; }
            asm volatile("s_waitcnt lgkmcnt(0)" ::: "memory");
        }
    }
    __syncthreads();
    bf16* HN = (bf16*)(F.ws + WS_HN); float* LOGF = (float*)(F.ws + WS_LOGF);
    LAS f32x4* wf4 = (LAS f32x4*)scr;
    for (int i = F.tid; i < DM * 2; i += NWAVES * 64) wf4[i] = *(const f32x4*)(F.w_in + (size_t)(i >> 1) * NIN + 6 * DH + (i & 1) * 4);
    __syncthreads();
    for (int tb = F.vcu; tb < T / 32; tb += F.G) {
        for (int j4 = 0; j4 < 4; ++j4) {
            const int row = tb * 32 + F.wave * 4 + j4;
            LAS f32x4* wfl = wf4; asm volatile("" : "+v"(wfl));
            const f32x4* xr = (const f32x4*)(F.x + (size_t)row * DM) + F.lane; const f32x4* gm = (const f32x4*)F.g_mix + F.lane;
            f32x4 v[8]; float ss = 0.f;
#pragma unroll
            for (int j = 0; j < 8; ++j) { v[j] = xr[64 * j]; ss += (v[j].x * v[j].x + v[j].y * v[j].y) + (v[j].z * v[j].z + v[j].w * v[j].w); }
            const float rstd = 1.0f / sqrtf(wave_sum(ss) * (1.0f / DM) + RMS_EPS);
            float f[8] = {0.f, 0.f, 0.f, 0.f, 0.f, 0.f, 0.f, 0.f};
            v2u* o8 = (v2u*)(HN + (size_t)row * DM) + F.lane; unsigned* o4 = (unsigned*)(F.ws + WS_HN8 + (size_t)row * DM) + F.lane;
#pragma unroll
            for (int j = 0; j < 8; ++j) { const f32x4 h = v[j] * rstd * gm[64 * j];
                v2u w; w.x = pkbf(h.x, h.y); w.y = pkbf(h.z, h.w); o8[64 * j] = w; o4[64 * j] = pg8::pk4_fp8(h.x, h.y, h.z, h.w);
#pragma unroll
                for (int q = 0; q < 4; ++q) { const int k = (F.lane + 64 * j) * 4 + q; const f32x4 w0 = wfl[2 * k], w1 = wfl[2 * k + 1]; const float hq = h[q];
                    f[0] += hq * w0.x; f[1] += hq * w0.y; f[2] += hq * w0.z; f[3] += hq * w0.w; f[4] += hq * w1.x; f[5] += hq * w1.y; f[6] += hq * w1.z; f[7] += hq * w1.w; } }
#pragma unroll
            for (int q = 0; q < 8; ++q) f[q] = wave_sum(f[q]);
            if (F.lane < 8) { float z = F.lane == 0 ? f[0] : F.lane == 1 ? f[1] : F.lane == 2 ? f[2] : F.lane == 3 ? f[3] : F.lane == 4 ? f[4] : F.lane == 5 ? f[5] : F.lane == 6 ? f[6] : f[7];
                z += F.b_forget[F.lane];
                LOGF[(size_t)F.lane * T + row] = fminf(z, 0.f) - log1pf(expf(-fabsf(z))); }
        }
    }
    __syncthreads();
}
constexpr int CONV_BATCHES = NE * 24;
__device__ __forceinline__ void conv_ptrs(const Frame& F, int e, int rb, int j, const float*& src, unsigned char*& dst, int& ldw) {
    if (rb < 16) { const int kk = rb, nb = j; ldw = 2 * DFF;
        src = F.w1 + (size_t)e * DM * 2 * DFF + (size_t)(kk * 128) * (2 * DFF) + nb * 256; dst = F.ws + WS_W1 + (size_t)e * 2 * DFF * DM + (size_t)(nb * 256) * DM + kk * 128; }
    else { const int q = (rb - 16) * 16 + j, nb = q & 7, kk = q >> 3; ldw = DM;
        src = F.w2 + (size_t)e * DFF * DM + (size_t)(kk * 128) * DM + nb * 256; dst = F.ws + WS_W2 + (size_t)e * DM * DFF + (size_t)(nb * 256) * DFF + kk * 128; }
}
__device__ __forceinline__ void p2_convert(Frame& F, unsigned* qhead, LAS int* qslot) {
    LAS unsigned char* wscr = F.lds + RING_OFF + F.wave * (32 * 144);
    const int kg = F.lane >> 3, cg = F.lane & 7, c = F.lane & 7, n = F.lane >> 3;
    for (;;) {
        if (F.tid == 0) *qslot = (int)__hip_atomic_fetch_add(qhead, 1u, __ATOMIC_RELAXED, __HIP_MEMORY_SCOPE_AGENT);
        __syncthreads(); const int b = *qslot; __syncthreads();
        if (b >= CONV_BATCHES) break;
        const int e = b / 24, rb = b - e * 24;
        f32x4 va[8], vb[8]; const float* src; unsigned char* dst; int ldw; const int K = rb < 16 ? DM : DFF;
        conv_ptrs(F, e, rb, 0, src, dst, ldw); src += F.wave * 32; conv_load(va, src, ldw, 0, kg, cg);
        for (int j = 0; j < 16; ++j) {
            conv_load(vb, src, ldw, 1, kg, cg);
            conv_to_lds(va, wscr, 0, kg, cg);
            unsigned char* dcur = dst + (size_t)(F.wave * 32) * K;
            if (j + 1 < 16) { conv_ptrs(F, e, rb, j + 1, src, dst, ldw); src += F.wave * 32; conv_load(va, src, ldw, 0, kg, cg); }
            conv_to_lds(vb, wscr, 1, kg, cg);
            asm volatile("s_waitcnt lgkmcnt(0)" ::: "memory");
#pragma unroll
            for (int i = 0; i < 4; ++i) { const int nn = n + 8 * i; const v4u o = *(const LAS v4u*)(wscr + nn * 144 + c * 16); __builtin_nontemporal_store(o, (v4u*)(dcur + (size_t)nn * K + c * 16)); }
            asm volatile("s_waitcnt lgkmcnt(0)" ::: "memory");
        }
    }
}
__device__ __forceinline__ void p5_router(Frame& F) {
    const float* X1 = (const float*)(F.ws + WS_X1); unsigned char* AS = F.ws + WS_AS; int* STOK = (int*)(F.ws + WS_STOK); float* SW = (float*)(F.ws + WS_SW);
    LAS float* red = (LAS float*)(F.lds + RING_OFF);
    LAS float* ssqs = red + 8 * 1024;
    LAS float* lg = ssqs + 8 * 32;
    LAS float* rstdl = lg + 32 * 33;
    LAS float* selw = rstdl + 32;
    LAS int* sele = (LAS int*)(selw + 128);
    LAS int* sellp = sele + 128;
    LAS int* dest = sellp + 128;
    LAS int* lcnt = dest + 128;
    LAS int* gbase = lcnt + 32;
    const int i32 = F.lane & 31, kk = F.lane >> 5;
    for (int tb = F.vcu; tb < T / 32; tb += F.G) {
        const int tok0 = tb * 32;
        {
            f32x16 C = {}; float ssq = 0.f; const int k0 = 256 * F.wave;
            const float* xr = X1 + (size_t)(tok0 + i32) * DM + k0 + 4 * kk;
#pragma unroll 4
            for (int u = 0; u < 32; ++u) { const f32x4 a = *(const f32x4*)(xr + 8 * u); ssq += (a.x * a.x + a.y * a.y) + (a.z * a.z + a.w * a.w);
#pragma unroll
                for (int v = 0; v < 4; ++v) { const int k = k0 + 8 * u + 4 * kk + v; const float b = F.w_router[(size_t)k * NE + i32] * F.g_ffn[k];
                    C = __builtin_amdgcn_mfma_f32_32x32x2f32(a[v], b, C, 0, 0, 0); } }
#pragma unroll
            for (int r = 0; r < 16; ++r) red[F.wave * 1024 + ((r & 3) + 8 * (r >> 2) + 4 * kk) * 32 + i32] = C[r];
            ssq += __shfl_xor(ssq, 32);
            if (kk == 0) ssqs[F.wave * 32 + i32] = ssq;
        }
        __syncthreads();
        for (int idx = F.tid; idx < 1024; idx += NWAVES * 64) { const int tk = idx >> 5, e = idx & 31; float s = 0.f, q = 0.f;
#pragma unroll
            for (int w = 0; w < 8; ++w) { s += red[w * 1024 + idx]; q += ssqs[w * 32 + tk]; }
            const float rstd = 1.0f / sqrtf(q * (1.0f / DM) + RMS_EPS);
            lg[tk * 33 + e] = s * rstd + F.b_router[e]; if (e == 0) rstdl[tk] = rstd; }
        if (F.tid < 32) lcnt[F.tid] = 0;
        __syncthreads();
        if (F.tid < 32) {
            float tv[4]; int te[4];
#pragma unroll
            for (int k = 0; k < 4; ++k) { float best = -__builtin_inff(); int bi = 0;
                for (int e = 0; e < NE; ++e) { const float v = lg[F.tid * 33 + e]; if (v > best) { best = v; bi = e; } }
                tv[k] = best; te[k] = bi; lg[F.tid * 33 + bi] = -__builtin_inff(); }
            float ew[4], sum = 0.f;
#pragma unroll
            for (int k = 0; k < 4; ++k) { ew[k] = expf(tv[k] - tv[0]); sum += ew[k]; }
            const float inv = 1.0f / sum;
#pragma unroll
            for (int k = 0; k < 4; ++k) { sele[F.tid * 4 + k] = te[k]; selw[F.tid * 4 + k] = ew[k] * inv; sellp[F.tid * 4 + k] = atomicAdd((int*)(lcnt + te[k]), 1); }
        }
        __syncthreads();
        if (F.tid < 32) { const int n = lcnt[F.tid]; gbase[F.tid] = n > 0 ? (int)__hip_atomic_fetch_add((unsigned*)(F.ctl + CW_CNT + 64 * F.tid), (unsigned)n, __ATOMIC_RELAXED, __HIP_MEMORY_SCOPE_AGENT) : 0; }
        __syncthreads();
        if (F.tid < 128) { const int e = sele[F.tid]; int pos = gbase[e] + sellp[F.tid]; if (pos >= CAP) pos = CAP - 1; const int row = e * CAP + pos;
            STOK[(tok0 + (F.tid >> 2)) * 4 + (F.tid & 3)] = row; SW[row] = selw[F.tid]; dest[F.tid] = row; }
        __syncthreads();
        for (int j4 = 0; j4 < 4; ++j4) {
            const int ti = F.wave * 4 + j4; const float rstd = rstdl[ti];
            const f32x4* xr = (const f32x4*)(X1 + (size_t)(tok0 + ti) * DM) + F.lane; const f32x4* gm = (const f32x4*)F.g_ffn + F.lane;
            unsigned w[8];
#pragma unroll
            for (int j = 0; j < 8; ++j) { const f32x4 h = xr[64 * j] * rstd * gm[64 * j]; w[j] = pg8::pk4_fp8(h.x, h.y, h.z, h.w); }
#pragma unroll
            for (int k = 0; k < 4; ++k) { unsigned* o4 = (unsigned*)(AS + (size_t)dest[ti * 4 + k] * DM) + F.lane;
#pragma unroll
                for (int j = 0; j < 8; ++j) o4[64 * j] = w[j]; }
        }
        __syncthreads();
    }
}
__device__ __forceinline__ void p8_final(Frame& F) {
    const float* X1 = (const float*)(F.ws + WS_X1); const bf16* Y = (const bf16*)(F.ws + WS_Y); const int* TSLOT = (const int*)(F.ws + WS_STOK);
    const int gw = F.vcu * NWAVES + F.wave, NGW = F.G * NWAVES;
    for (int row = gw; row < T; row += NGW) {
        const f32x4* xr = (const f32x4*)(X1 + (size_t)row * DM) + F.lane; const f32x4* gf = (const f32x4*)F.g_final + F.lane;
        const int sl = (int)__hip_atomic_load((const unsigned*)TSLOT + row * 4 + (F.lane & 3), __ATOMIC_RELAXED, __HIP_MEMORY_SCOPE_AGENT);
        int slot[4];
#pragma unroll
        for (int k = 0; k < 4; ++k) slot[k] = __shfl(sl, k);
        f32x4 v[8]; float ss = 0.f;
#pragma unroll
        for (int j = 0; j < 8; ++j) { v[j] = xr[64 * j];
#pragma unroll
            for (int k = 0; k < 4; ++k) { const v2u y = ((const v2u*)(Y + (size_t)slot[k] * DM) + F.lane)[64 * j];
                v[j].x += pg8::bf_lo(y.x); v[j].y += pg8::bf_hi(y.x); v[j].z += pg8::bf_lo(y.y); v[j].w += pg8::bf_hi(y.y); }
            ss += (v[j].x * v[j].x + v[j].y * v[j].y) + (v[j].z * v[j].z + v[j].w * v[j].w); }
        const float rstd = 1.0f / sqrtf(wave_sum(ss) * (1.0f / DM) + RMS_EPS);
        f32x4* o = (f32x4*)(F.out + (size_t)row * DM) + F.lane;
#pragma unroll
        for (int j = 0; j < 8; ++j) o[64 * j] = v[j] * rstd * gf[64 * j];
    }
}

struct Args { const float* in[16]; float* out; unsigned char* ws; int ph_lo, ph_hi; };
__global__ void __launch_bounds__(NWAVES * 64, 2) mk_fwd(Args args) {
    extern __shared__ __attribute__((aligned(16))) unsigned char lds[];
    Frame F;
    F.lds = (LAS unsigned char*)lds;
    F.MISC = (volatile LAS unsigned*)(F.lds + MISC_OFF);
    F.tid = threadIdx.x; F.lane = F.tid & 63; F.wave = __builtin_amdgcn_readfirstlane(F.tid >> 6);
    F.G = gridDim.x; { const int bx = blockIdx.x; F.vcu = (F.G % 8 == 0) ? (bx % 8) * (F.G / 8) + bx / 8 : bx; }
    unsigned char* ws = args.ws; F.ws = ws; F.out = args.out;
    F.ctl = (gu32*)(ws + WS_CTL);
    F.x = args.in[0]; F.g_mix = args.in[1]; F.w_in = args.in[2]; F.b_forget = args.in[3]; F.b_gate = args.in[4]; F.w_psb = args.in[5]; F.w_pfx = args.in[6]; F.w_out = args.in[7];
    F.g_ffn = args.in[8]; F.w_router = args.in[9]; F.b_router = args.in[10]; F.w1 = args.in[11]; F.b1 = args.in[12]; F.w2 = args.in[13]; F.b2 = args.in[14]; F.g_final = args.in[15];
    for (int u = F.tid; u < (LDS_BYTES - LDSCTL_OFF) / 4; u += NWAVES * 64) ((LAS unsigned*)(F.lds + LDSCTL_OFF))[u] = 0u;
    __syncthreads();
    XcdBarrier bar; bar.bar = (unsigned*)(F.ctl + CW_BAR); bar.x = 0; bar.st = nullptr;
    if (N_LAUNCHES != PER_PHASE) bar = xcd_barrier_post((unsigned*)(F.ctl + CW_BAR), F.MISC + 8);
#define GRID_BAR(seam) do { if (N_LAUNCHES == PER_PHASE) { if (F.tid == 0) __hip_atomic_store(F.ctl + CW_TMO, 0xBADBA0u | (unsigned)(seam), RLX_AGENT); } else { xcd_barrier(bar); } } while (0)
    const int lo = args.ph_lo, hi = args.ph_hi;
#define IN(k) (lo <= (k) && (k) < hi)
#define BOTH(k) (IN(k) && IN((k) + 1))
    bf16* HN = (bf16*)(ws + WS_HN); bf16* QKV = (bf16*)(ws + WS_QKV); bf16* GATES = (bf16*)(ws + WS_GATES);
    bf16* OSB = (bf16*)(ws + WS_OSB); bf16* OFX = (bf16*)(ws + WS_OFX); bf16* MIXED = (bf16*)(ws + WS_MIXED);
    float* PART = (float*)(ws + WS_PART); float* X1 = (float*)(ws + WS_X1);
    unsigned char* AS = ws + WS_AS; unsigned char* HB = ws + WS_H; bf16* YB = (bf16*)(ws + WS_Y);

    if (IN(0)) { p0_prologue(F); if (BOTH(0)) GRID_BAR(0); }

    if (IN(1)) {
        { pg8::TileOrder S; S.init(HN, ws + WS_WIN, T, 6 * DH, DM, F.G, (int)blockIdx.x);
          pg8::EpiP1 E{QKV, QKV_STRIDE / 2, (unsigned*)(F.ctl + CW_KM)};
          pg8::gemm_phase<pg8::EpiP1, pg8::TileOrder, true, true>(F.lds + RING_OFF, DM, S, E); }
        { pg8::TileOrder S; S.init(ws + WS_HN8, ws + WS_WIN8, T, 2 * DM, DM, F.G, (int)blockIdx.x, 1);
          pg8::EpiGates E{GATES, F.b_gate};
          pg8::gemm_phase<pg8::EpiGates, pg8::TileOrder, true, true, 1>(F.lds + RING_OFF, DM, S, E); }
        if (BOTH(1)) GRID_BAR(1);
    }

    if (IN(2)) {
        const float* LOGFall = (const float*)(ws + WS_LOGF);
        const int hq = (int)blockIdx.x & 7;
        att::ALAS_char_ptr alds = (att::ALAS_char_ptr)(F.lds + RING_OFF);
        LAS int* qslot = (LAS int*)(F.lds + RING_OFF + att::OFF_FLAG + 64);
        float* PARTF = (float*)(ws + WS_PART);
        const bool conv_first = (((int)blockIdx.x >> 3) & 7) < CONV_FIRST_OF8;
        if (conv_first) p2_convert(F, (unsigned*)(F.ctl + CW_QC), qslot);
#define P2_PULL(cw, limit) do { if (F.wave == 0) { int c_ = (limit); if (F.lane < 8) c_ = (int)__hip_atomic_load((const unsigned*)(F.ctl + (cw) + 64 * F.lane), __ATOMIC_RELAXED, __HIP_MEMORY_SCOPE_AGENT); \
            int bh_ = -1, bc_ = (limit); _Pragma("unroll") for (int j_ = 0; j_ < 8; ++j_) { const int cj_ = __shfl(c_, j_); if (cj_ < bc_) { bc_ = cj_; bh_ = j_; } } \
            { const int own_ = __shfl(c_, hq); if (own_ < (limit)) bh_ = hq; } \
            if (F.lane == 0) { int it_ = (limit); if (bh_ >= 0) it_ = (int)__hip_atomic_fetch_add((unsigned*)(F.ctl + (cw) + 64 * bh_), 1u, __ATOMIC_RELAXED, __HIP_MEMORY_SCOPE_AGENT); qslot[0] = bh_; qslot[1] = it_; } } \
        __syncthreads(); } while (0)
        for (;;) {
            P2_PULL(CW_QF, 48);
            const int h = qslot[0], it = qslot[1]; __syncthreads();
            if (h < 0) break;
            if (it >= 48) continue;
            int qb, mode;
            if (it < 16) { qb = 31 - it; mode = 1; }
            else { const int k = it - 16; if (k < 24) { const int g = k / 3, j = k - 3 * g; qb = j == 0 ? 15 - g : 31 - 2 * g - (j - 1); } else qb = 31 - k; mode = qb >= 16 ? 2 : 0; }
            const int NT = 4 * (qb + 1), t0 = mode == 1 ? NT / 2 : 0, t1 = mode == 2 ? NT / 2 : NT;
            const int slot = h * 16 + (qb & 15);
            att::fox_unit(QKV + 3 * (QKV_STRIDE / 2) + h * HD, QKV + 4 * (QKV_STRIDE / 2) + h * HD, QKV + 5 * (QKV_STRIDE / 2) + h * HD, OFX + h * HD, LOGFall + (size_t)h * T, qb, t0, t1, mode,
                          PARTF + (size_t)slot * (att::QB * att::D + 2 * att::QB), (unsigned*)(F.ctl + CW_FLAG + 64 * slot), (unsigned*)(F.ctl + CW_TMO), (const unsigned*)(F.ctl + CW_KM + 4 * h), alds);
        }
        for (;;) {
            P2_PULL(CW_QS, 32);
            const int h = qslot[0], it = qslot[1]; __syncthreads();
            if (h < 0) break;
            if (it >= 32) continue;
            att::sb_unit(QKV + 0 * (QKV_STRIDE / 2) + h * HD, QKV + 1 * (QKV_STRIDE / 2) + h * HD, QKV + 2 * (QKV_STRIDE / 2) + h * HD, OSB + h * HD, 31 - it, alds);
        }
#undef P2_PULL
        if (!conv_first) p2_convert(F, (unsigned*)(F.ctl + CW_QC), qslot);
        if (BOTH(2)) GRID_BAR(2);
    }

    if (IN(3)) {
        pg8::MixOrder S; S.t.init(OSB, ws + WS_WPA, T, DM, DH, F.G, (int)blockIdx.x); S.A1 = (const char*)OFX; S.B1 = (const char*)(ws + WS_WPB);
        pg8::EpiMix E{GATES, PART, MIXED};
        pg8::gemm_phase<pg8::EpiMix, pg8::MixOrder, false, true>(F.lds + RING_OFF, DH, S, E);
        if (BOTH(3)) GRID_BAR(3);
    }

    if (IN(4)) {
        pg8::TileOrder S; S.init(MIXED, ws + WS_WOUT, T, DM, DM, F.G, (int)blockIdx.x);
        pg8::EpiResid E{F.x, X1};
        pg8::gemm_phase<pg8::EpiResid, pg8::TileOrder, false, true>(F.lds + RING_OFF, DM, S, E);
        if (BOTH(4)) GRID_BAR(4);
    }

    if (IN(5)) { p5_router(F); if (BOTH(5)) GRID_BAR(5); }

    if (IN(6) || IN(7)) {
        LAS int* cntl = (LAS int*)(F.lds + TAB_OFF); LAS int* pref = cntl + 32;
        if (F.tid < 32) { int n = (int)__hip_atomic_load(F.ctl + CW_CNT + 64 * F.tid, RLX_AGENT); cntl[F.tid] = n > CAP ? CAP : n; }
        __syncthreads();
        if (F.tid == 0) { int p = 0; for (int e = 0; e < NE; ++e) { pref[e] = p; p += (cntl[e] + 255) >> 8; } pref[NE] = p; }
        __syncthreads();
        if (IN(6)) {
            pg8::MoeOrder S{(const char*)AS, (const char*)(ws + WS_W1), (const PG8_LAS int*)pref, (size_t)CAP * DM, (size_t)2 * DFF * DM, (size_t)256 * DM, (2 * DFF) / 256, CAP / 256, F.G, F.vcu};
            pg8::EpiSwiglu E{F.b1, HB};
            pg8::gemm_phase<pg8::EpiSwiglu, pg8::MoeOrder, true, true, 1>(F.lds + RING_OFF, DM, S, E);
            if (BOTH(6)) GRID_BAR(6);
        }
        if (IN(7)) {
            pg8::MoeOrder S{(const char*)HB, (const char*)(ws + WS_W2), (const PG8_LAS int*)pref, (size_t)CAP * DFF, (size_t)DM * DFF, (size_t)256 * DFF, DM / 256, CAP / 256, F.G, F.vcu};
            pg8::EpiMoeOut E{F.b2, (const float*)(ws + WS_SW), YB};
            pg8::gemm_phase<pg8::EpiMoeOut, pg8::MoeOrder, true, true, 1>(F.lds + RING_OFF, DFF, S, E);
            if (BOTH(7)) GRID_BAR(7);
        }
    }

    if (IN(8)) p8_final(F);
#undef IN
#undef BOTH
}

extern "C" void kernel_launch(void* const* d_in, const int* in_sizes, int n_in, void* d_out, int out_size, void* d_ws, size_t ws_size, hipStream_t stream) {
    static int grid = 0;
    if (grid == 0) {
        if (n_in != 16 || in_sizes[0] != T * DM || out_size != T * DM || ws_size < WS_END) { fprintf(stderr, "kernel_launch: built for 16 inputs, x/out of %d floats, >= %zu bytes of workspace; got n_in %d, in0 %d, out %d, ws %zu; nothing launched\n", T * DM, (size_t)WS_END, n_in, n_in > 0 ? in_sizes[0] : -1, out_size, ws_size); grid = -1; return; }
        int dev = 0, cus = 0, per_cu = 0;
        if (hipGetDevice(&dev) != hipSuccess || hipDeviceGetAttribute(&cus, hipDeviceAttributeMultiprocessorCount, dev) != hipSuccess) { fprintf(stderr, "kernel_launch: hipGetDevice / hipDeviceGetAttribute failed\n"); grid = -1; return; }
        if (hipFuncSetAttribute((const void*)mk_fwd, hipFuncAttributeMaxDynamicSharedMemorySize, LDS_BYTES) != hipSuccess) { fprintf(stderr, "kernel_launch: hipFuncSetAttribute failed\n"); grid = -1; return; }
        if (hipOccupancyMaxActiveBlocksPerMultiprocessor(&per_cu, (const void*)mk_fwd, NWAVES * 64, LDS_BYTES) != hipSuccess || per_cu < 1)
            fprintf(stderr, "kernel_launch: note: the occupancy query reports %d workgroups per CU\n", per_cu);
        (void)hipGetLastError();
        grid = cus;
    }
    if (grid < 0) return;
    if (hipMemsetAsync((char*)d_ws + WS_CTL, 0, CTL_ZERO_BYTES, stream) != hipSuccess) { fprintf(stderr, "kernel_launch: hipMemsetAsync failed\n"); return; }
    Args a{};
    for (int i = 0; i < 16; ++i) a.in[i] = (const float*)d_in[i];
    a.out = (float*)d_out; a.ws = (unsigned char*)d_ws;
    if (N_LAUNCHES == 1) { a.ph_lo = 0; a.ph_hi = PER_PHASE; hipLaunchKernelGGL(mk_fwd, dim3(grid), dim3(NWAVES * 64), LDS_BYTES, stream, a); }
    else for (int li = 0; li < PER_PHASE; ++li) { a.ph_lo = li; a.ph_hi = li + 1; hipLaunchKernelGGL(mk_fwd, dim3(grid), dim3(NWAVES * 64), LDS_BYTES, stream, a); }
    const hipError_t le = hipPeekAtLastError();
    if (le != hipSuccess) fprintf(stderr, "kernel_launch: launch failed: %s (grid %d)\n", hipGetErrorName(le), grid);
}
```

```cpp
#include <hip/hip_runtime.h>
#include <hip/hip_bf16.h>
#include <cstdio>
#include <cstdint>

#ifndef CONV_FIRST_OF8
#define CONV_FIRST_OF8 5
#endif
#ifndef MK_N_LAUNCHES
#define MK_N_LAUNCHES 1
#endif

namespace pg8 {
#define PG8_LAS __attribute__((address_space(3)))
typedef unsigned short bf16_t;
typedef short bf16x8 __attribute__((ext_vector_type(8)));
typedef float f32x4 __attribute__((ext_vector_type(4)));
typedef unsigned u32x4 __attribute__((ext_vector_type(4)));
typedef unsigned u32x2 __attribute__((ext_vector_type(2)));
constexpr int BM = 256, BK = 64, HALF = 128, HTB = HALF * BK * 2  , STAGE_BYTES = 8 * HTB, NXCD = 8, WGM = 8;

__host__ __device__ __forceinline__ int lds_byte(int r, int c) { const int st = (r >> 4) * 2 + (c >> 5), rr = r & 15, cc = c & 31, ob = rr * 64 + cc * 2; return st * 1024 + (ob ^ (((ob >> 9) & 1) << 5)); }
__host__ __device__ __forceinline__ void stage_rc(int b, int& R, int& C) { const int st = b / 1024, sb = b % 1024, swz = sb ^ (((sb >> 9) & 1) << 5); R = (st >> 1) * 16 + swz / 64; C = (st & 1) * 32 + (swz % 64) / 2; }
__host__ __device__ __forceinline__ int perm32(int rho) { const int n = rho >> 4, i = rho & 15; return 8 * (i >> 2) + 4 * n + (i & 3); }

struct Unit { const char* a; const char* b; int pm, pn, aux; };

typedef float f32x2_c __attribute__((ext_vector_type(2))); typedef __bf16 bf16x2_c __attribute__((ext_vector_type(2)));
__device__ __forceinline__ unsigned cvt_pk_bf16(float lo, float hi) { const f32x2_c v = {lo, hi}; const bf16x2_c b = __builtin_convertvector(v, bf16x2_c); return __builtin_bit_cast(unsigned, b); }
__device__ __forceinline__ unsigned pk4_fp8(float a, float b, float c, float d) { unsigned w = 0u; w = (unsigned)__builtin_amdgcn_cvt_pk_fp8_f32(a, b, (int)w, false); w = (unsigned)__builtin_amdgcn_cvt_pk_fp8_f32(c, d, (int)w, true); return w; }
constexpr float W8_SCALE = 64.0f, W8_INV = 1.0f / 64.0f;
__device__ __forceinline__ float bf_lo(unsigned u) { return __uint_as_float(u << 16); }
__device__ __forceinline__ float bf_hi(unsigned u) { return __uint_as_float(u & 0xffff0000u); }
__device__ __forceinline__ float sigmoidf_fast(float x) { return __builtin_amdgcn_rcpf(1.0f + __builtin_amdgcn_exp2f(-1.4426950408889634f * x)); }

struct TileOrder {
    const char* A; const char* Bt; size_t tstepA, tstepB; int nM, nN, nwg, G, c;
    __device__ __forceinline__ void init(const void* A_, const void* Bt_, int M, int N, int K, int G_, int c_, int esz = 2) { A = (const char*)A_; Bt = (const char*)Bt_; tstepA = (size_t)BM * K * esz; tstepB = tstepA; nM = M / BM; nN = N / BM; nwg = nM * nN; G = G_; c = c_; }
    __device__ __forceinline__ bool map(int L, int& pm, int& pn) const {
        if (L >= nwg) return false;
        int wgid = L; { const int q = nwg / NXCD, r = nwg % NXCD, xcd = wgid % NXCD, off = wgid / NXCD; wgid = (xcd < r ? xcd * (q + 1) : r * (q + 1) + (xcd - r) * q) + off; }
        const int nig = WGM * nN, gid = wgid / nig, fm = gid * WGM, gsz = (nM - fm) < WGM ? (nM - fm) : WGM;
        pm = fm + ((wgid % nig) % gsz); pn = (wgid % nig) / gsz; return true;
    }
    __device__ __forceinline__ bool next(int i, Unit& u) const {
        int pm, pn; if (!map(i * G + c, pm, pn)) return false;
        u.pm = pm; u.pn = pn; u.aux = 0; u.a = A + (size_t)pm * tstepA; u.b = Bt + (size_t)pn * tstepB; return true;
    }
    __device__ __forceinline__ void a_ready(const Unit&) const {}
    __device__ __forceinline__ void done(const Unit&) const {}
};
struct MixOrder {
    TileOrder t; const char* A1; const char* B1;
    __device__ __forceinline__ bool next(int i, Unit& u) const {
        int pm, pn; if (!t.map((i >> 1) * t.G + t.c, pm, pn)) return false;
        u.pm = pm; u.pn = pn; u.aux = i & 1;
        u.a = ((i & 1) ? A1 : t.A) + (size_t)pm * t.tstepA; u.b = ((i & 1) ? B1 : t.Bt) + (size_t)pn * t.tstepB; return true;
    }
    __device__ __forceinline__ void a_ready(const Unit&) const {}
    __device__ __forceinline__ void done(const Unit&) const {}
};
struct MoeOrder {
    const char* A; const char* Bt; const PG8_LAS int* pref;
    size_t a_estride, b_estride, tstep; int NT, cap_tiles, G, c;
    __device__ __forceinline__ bool next(int i, Unit& u) const {
        const int L = i * G + c; const int total = pref[32] * NT; if (L >= total) return false;
        int e = 0;
#pragma unroll 1
        for (int j = 1; j < 32; ++j) if (pref[j] * NT <= L) e = j;
        const int me = pref[e + 1] - pref[e], q = L - pref[e] * NT, nt = q / me, mt = q - nt * me;
        u.aux = e; u.pm = e * cap_tiles + mt; u.pn = nt;
        u.a = A + (size_t)e * a_estride + (size_t)mt * tstep; u.b = Bt + (size_t)e * b_estride + (size_t)nt * tstep; return true;
    }
    __device__ __forceinline__ void a_ready(const Unit&) const {}
    __device__ __forceinline__ void done(const Unit&) const {}
};

struct EpiP1 {
    static constexpr bool PERM = true, AFTER_DRAIN = false;
    bf16_t* qkv; size_t buf_stride; unsigned* km;
    __device__ __forceinline__ void operator()(const f32x4 (&acc)[2][2][4][2], const Unit& u, int wr, int wc, int fr, int fq) const {
        const int row0 = u.pm * BM + wr * 64 + fr;
        {
            bf16_t* base = qkv + (size_t)(u.pn >> 2) * buf_stride; const int col0 = (u.pn & 3) * BM + wc * 32 + 8 * fq;
            const bool kfx = u.pn >= 16 && u.pn < 20;
            float mx[2] = {0.f, 0.f};
#pragma unroll
            for (int ai = 0; ai < 2; ++ai)
#pragma unroll
                for (int m = 0; m < 4; ++m) { bf16_t* rowp = base + (size_t)(row0 + ai * HALF + m * 16) * 1024 + col0;
#pragma unroll
                    for (int bj = 0; bj < 2; ++bj) { const f32x4 v0 = acc[ai][bj][m][0], v1 = acc[ai][bj][m][1];
                        u32x4 w; w.x = cvt_pk_bf16(v0[0], v0[1]); w.y = cvt_pk_bf16(v0[2], v0[3]); w.z = cvt_pk_bf16(v1[0], v1[1]); w.w = cvt_pk_bf16(v1[2], v1[3]);
                        *(u32x4*)(rowp + bj * HALF) = w;
                        if (kfx) { float q = bf_lo(w.x) * bf_lo(w.x) + bf_hi(w.x) * bf_hi(w.x) + bf_lo(w.y) * bf_lo(w.y) + bf_hi(w.y) * bf_hi(w.y)
                                           + bf_lo(w.z) * bf_lo(w.z) + bf_hi(w.z) * bf_hi(w.z) + bf_lo(w.w) * bf_lo(w.w) + bf_hi(w.w) * bf_hi(w.w);
                            q += __shfl_xor(q, 16); q += __shfl_xor(q, 32); mx[bj] = fmaxf(mx[bj], q); } } }
            if (kfx) {
#pragma unroll
                for (int bj = 0; bj < 2; ++bj) { float q = mx[bj];
#pragma unroll
                    for (int o = 1; o < 16; o <<= 1) q = fmaxf(q, __shfl_xor(q, o));
                    if (fr == 0 && fq == 0) __hip_atomic_fetch_max(km + (2 * (u.pn - 16) + bj) * 4 + wc, __float_as_uint(q), __ATOMIC_RELAXED, __HIP_MEMORY_SCOPE_AGENT); } }
        }
    }
};
struct EpiGates {
    static constexpr bool PERM = true, AFTER_DRAIN = false;
    bf16_t* gates; const float* b_gate;
    __device__ __forceinline__ void operator()(const f32x4 (&acc)[2][2][4][2], const Unit& u, int wr, int wc, int fr, int fq) const {
        const int row0 = u.pm * BM + wr * 64 + fr, gc0 = u.pn * BM + wc * 32 + 8 * fq;
        f32x4 bv[2][2];
#pragma unroll
        for (int bj = 0; bj < 2; ++bj)
#pragma unroll
            for (int n = 0; n < 2; ++n) bv[bj][n] = *(const f32x4*)(b_gate + gc0 + bj * HALF + 4 * n);
#pragma unroll
        for (int ai = 0; ai < 2; ++ai)
#pragma unroll
            for (int m = 0; m < 4; ++m) { bf16_t* rowp = gates + (size_t)(row0 + ai * HALF + m * 16) * 4096 + gc0;
#pragma unroll
                for (int bj = 0; bj < 2; ++bj) { f32x4 v0 = acc[ai][bj][m][0] * W8_INV + bv[bj][0], v1 = acc[ai][bj][m][1] * W8_INV + bv[bj][1];
#pragma unroll
                    for (int q = 0; q < 4; ++q) { v0[q] = sigmoidf_fast(v0[q]); v1[q] = sigmoidf_fast(v1[q]); }
                    u32x4 w; w.x = cvt_pk_bf16(v0[0], v0[1]); w.y = cvt_pk_bf16(v0[2], v0[3]); w.z = cvt_pk_bf16(v1[0], v1[1]); w.w = cvt_pk_bf16(v1[2], v1[3]);
                    *(u32x4*)(rowp + bj * HALF) = w; } }
    }
};
struct EpiMix {
    static constexpr bool PERM = true, AFTER_DRAIN = false;
    const bf16_t* gates; float* part; bf16_t* mixed;
    __device__ __forceinline__ void operator()(const f32x4 (&acc)[2][2][4][2], const Unit& u, int wr, int wc, int fr, int fq) const {
        const int row0 = u.pm * BM + wr * 64 + fr, col0 = u.pn * BM + wc * 32 + 8 * fq; const int goff = u.aux ? 2048 : 0;
#pragma unroll
        for (int ai = 0; ai < 2; ++ai) {
            u32x4 g[4][2];
#pragma unroll
            for (int m = 0; m < 4; ++m)
#pragma unroll
                for (int bj = 0; bj < 2; ++bj) g[m][bj] = *(const u32x4*)(gates + (size_t)(row0 + ai * HALF + m * 16) * 4096 + goff + col0 + bj * HALF);
#pragma unroll
            for (int mp = 0; mp < 2; ++mp) {
                f32x4 p0[2][2], p1[2][2];
                if (u.aux) {
#pragma unroll
                    for (int mm = 0; mm < 2; ++mm)
#pragma unroll
                        for (int bj = 0; bj < 2; ++bj) { const float* pp = part + (size_t)(row0 + ai * HALF + (2 * mp + mm) * 16) * 2048 + col0 + bj * HALF;
                            p0[mm][bj] = *(const f32x4*)pp; p1[mm][bj] = *(const f32x4*)(pp + 4); } }
                asm volatile("" ::: "memory");
#pragma unroll
                for (int mm = 0; mm < 2; ++mm)
#pragma unroll
                    for (int bj = 0; bj < 2; ++bj) { const int m = 2 * mp + mm; const size_t row = (size_t)(row0 + ai * HALF + m * 16); const int c = col0 + bj * HALF;
                        const u32x4 gg = g[m][bj]; const f32x4 a0 = acc[ai][bj][m][0], a1 = acc[ai][bj][m][1];
                        f32x4 r0 = {bf_lo(gg.x) * a0[0], bf_hi(gg.x) * a0[1], bf_lo(gg.y) * a0[2], bf_hi(gg.y) * a0[3]};
                        f32x4 r1 = {bf_lo(gg.z) * a1[0], bf_hi(gg.z) * a1[1], bf_lo(gg.w) * a1[2], bf_hi(gg.w) * a1[3]};
                        float* pp = part + row * 2048 + c;
                        if (u.aux == 0) { *(f32x4*)pp = r0; *(f32x4*)(pp + 4) = r1; }
                        else { r0 += p0[mm][bj]; r1 += p1[mm][bj];
                            u32x4 w; w.x = cvt_pk_bf16(r0[0], r0[1]); w.y = cvt_pk_bf16(r0[2], r0[3]); w.z = cvt_pk_bf16(r1[0], r1[1]); w.w = cvt_pk_bf16(r1[2], r1[3]);
                            *(u32x4*)(mixed + row * 2048 + c) = w; } }
                asm volatile("" ::: "memory");
            }
        }
    }
};
struct EpiResid {
    static constexpr bool PERM = false, AFTER_DRAIN = false;
    const float* x; float* x1;
    __device__ __forceinline__ void operator()(const f32x4 (&acc)[2][2][4][2], const Unit& u, int wr, int wc, int fr, int fq) const {
        const int row0 = u.pm * BM + wr * 64 + fr, col0 = u.pn * BM + wc * 32 + 4 * fq;
#pragma unroll
        for (int ai = 0; ai < 2; ++ai) {
            f32x4 xv[4][2][2];
#pragma unroll
            for (int m = 0; m < 4; ++m) { const size_t off = (size_t)(row0 + ai * HALF + m * 16) * 2048 + col0;
#pragma unroll
                for (int bj = 0; bj < 2; ++bj)
#pragma unroll
                    for (int n = 0; n < 2; ++n) xv[m][bj][n] = *(const f32x4*)(x + off + bj * HALF + n * 16); }
            asm volatile("" ::: "memory");
#pragma unroll
            for (int m = 0; m < 4; ++m) { const size_t off = (size_t)(row0 + ai * HALF + m * 16) * 2048 + col0;
#pragma unroll
                for (int bj = 0; bj < 2; ++bj)
#pragma unroll
                    for (int n = 0; n < 2; ++n) *(f32x4*)(x1 + off + bj * HALF + n * 16) = xv[m][bj][n] + acc[ai][bj][m][n]; }
            asm volatile("" ::: "memory");
        }
    }
};
__device__ __forceinline__ float swiglu1(float g, float l) {
    g = fminf(g, 7.0f); l = fminf(fmaxf(l, -7.0f), 7.0f);
    return g * sigmoidf_fast(1.702f * g) * (l + 1.0f);
}
struct EpiSwiglu {
    static constexpr bool PERM = true, AFTER_DRAIN = false;
    const float* b1; unsigned char* H;
    __device__ __forceinline__ void operator()(const f32x4 (&acc)[2][2][4][2], const Unit& u, int wr, int wc, int fr, int fq) const {
        const int row0 = u.pm * BM + wr * 64 + fr, c0 = u.pn * BM + wc * 32 + 8 * fq; const float* be = b1 + (size_t)u.aux * 4096 + c0;
        f32x4 bv[2][2];
#pragma unroll
        for (int bj = 0; bj < 2; ++bj)
#pragma unroll
            for (int n = 0; n < 2; ++n) bv[bj][n] = *(const f32x4*)(be + bj * HALF + 4 * n);
#pragma unroll
        for (int ai = 0; ai < 2; ++ai)
#pragma unroll
            for (int m = 0; m < 4; ++m) { unsigned char* rowp = H + (size_t)(row0 + ai * HALF + m * 16) * 2048 + (c0 >> 1);
#pragma unroll
                for (int bj = 0; bj < 2; ++bj) { const f32x4 v0 = acc[ai][bj][m][0] * W8_INV + bv[bj][0], v1 = acc[ai][bj][m][1] * W8_INV + bv[bj][1];
                    *(unsigned*)(rowp + bj * (HALF / 2)) = pk4_fp8(swiglu1(v0[0], v0[1]), swiglu1(v0[2], v0[3]), swiglu1(v1[0], v1[1]), swiglu1(v1[2], v1[3])); } }
    }
};
struct EpiMoeOut {
    static constexpr bool PERM = true, AFTER_DRAIN = false;
    const float* b2; const float* slot_w; bf16_t* Y;
    __device__ __forceinline__ void operator()(const f32x4 (&acc)[2][2][4][2], const Unit& u, int wr, int wc, int fr, int fq) const {
        const int e = u.aux, row0 = u.pm * BM + wr * 64 + fr, c0 = u.pn * BM + wc * 32 + 8 * fq; const float* be = b2 + (size_t)e * 2048 + c0;
        f32x4 bv[2][2];
#pragma unroll
        for (int bj = 0; bj < 2; ++bj)
#pragma unroll
            for (int n = 0; n < 2; ++n) bv[bj][n] = *(const f32x4*)(be + bj * HALF + 4 * n);
        float wrow[2][4];
#pragma unroll
        for (int ai = 0; ai < 2; ++ai)
#pragma unroll
            for (int m = 0; m < 4; ++m) wrow[ai][m] = slot_w[row0 + ai * HALF + m * 16];
        asm volatile("" ::: "memory");
#pragma unroll
        for (int ai = 0; ai < 2; ++ai)
#pragma unroll
            for (int m = 0; m < 4; ++m) { const int row = row0 + ai * HALF + m * 16;
                const float w8 = wrow[ai][m]; bf16_t* rowp = Y + (size_t)row * 2048 + c0;
#pragma unroll
                for (int bj = 0; bj < 2; ++bj) { const f32x4 v0 = (acc[ai][bj][m][0] * W8_INV + bv[bj][0]) * w8, v1 = (acc[ai][bj][m][1] * W8_INV + bv[bj][1]) * w8;
                    u32x4 w; w.x = cvt_pk_bf16(v0[0], v0[1]); w.y = cvt_pk_bf16(v0[2], v0[3]); w.z = cvt_pk_bf16(v1[0], v1[1]); w.w = cvt_pk_bf16(v1[2], v1[3]);
                    *(u32x4*)(rowp + bj * HALF) = w; } }
    }
};

typedef int i32x4 __attribute__((ext_vector_type(4)));
typedef int i32x8 __attribute__((ext_vector_type(8)));
__device__ __forceinline__ i32x8 cat8(bf16x8 lo, bf16x8 hi) { return __builtin_shufflevector(__builtin_bit_cast(i32x4, lo), __builtin_bit_cast(i32x4, hi), 0, 1, 2, 3, 4, 5, 6, 7); }
template <class Epi, class Sched, bool ALIGN_EPI = false, bool SP2 = false, int ESZ = 2>
__device__ __forceinline__ void gemm_phase(PG8_LAS unsigned char* lds, const int K, const Sched& S, const Epi& E) {
    int tid = threadIdx.x; asm volatile("" : "+v"(tid));
    const int wid = __builtin_amdgcn_readfirstlane(tid >> 6), lane = tid & 63, wr = wid >> 2, wc = wid & 3, fr = lane & 15, fq = lane >> 4;
    const int nt = K / (BK * 2 / ESZ);
    unsigned voffA, voffB;
    { int R, C; stage_rc(tid * 16, R, C); const int Rb = Epi::PERM ? ((R & ~31) + perm32(R & 31)) : R;
        voffA = (unsigned)(R * K * ESZ + C * 2); voffB = (unsigned)(Rb * K * ESZ + C * 2); }
    const size_t pstep = (size_t)64 * K * ESZ;
    const size_t kstep = (size_t)(BK * 2);
    const size_t hstep = (size_t)HALF * K * ESZ;
    const unsigned ldsw = (unsigned)wid * 1024u;
    const int aoff = lds_byte(wr * 64 + fr, fq * 8), boff = lds_byte(wc * 32 + fr, fq * 8);
#define PG8_SA(b, h) (((b) * 2 + (h)) * HTB)
#define PG8_SB(b, h) ((4 + (b) * 2 + (h)) * HTB)
#define PG8_STAGE(bufoff, gbase, voff) do { _Pragma("unroll") for (int _i = 0; _i < 2; ++_i) \
        __builtin_amdgcn_global_load_lds((const unsigned*)((const char*)(gbase) + _i * pstep + (voff)), (PG8_LAS unsigned*)(lds + (bufoff) + ldsw + _i * 8192), 16, 0, 0); } while (0)
#define PG8_LDA(dst, b, h) do { _Pragma("unroll") for (int m = 0; m < 4; ++m) { const PG8_LAS unsigned char* p_ = lds + PG8_SA(b, h) + aoff + m * 2048; if constexpr (ESZ == 1) dst##8[m] = cat8(*(const PG8_LAS bf16x8*)p_, *(const PG8_LAS bf16x8*)(p_ + 1024)); else { dst[m][0] = *(const PG8_LAS bf16x8*)p_; dst[m][1] = *(const PG8_LAS bf16x8*)(p_ + 1024); } } } while (0)
#define PG8_LDB(dst, b, h) do { _Pragma("unroll") for (int n = 0; n < 2; ++n) { const PG8_LAS unsigned char* p_ = lds + PG8_SB(b, h) + boff + n * 2048; if constexpr (ESZ == 1) dst##8[n] = cat8(*(const PG8_LAS bf16x8*)p_, *(const PG8_LAS bf16x8*)(p_ + 1024)); else { dst[n][0] = *(const PG8_LAS bf16x8*)p_; dst[n][1] = *(const PG8_LAS bf16x8*)(p_ + 1024); } } } while (0)
#define PG8_MMA(ai, bj, At, Bt) do { __builtin_amdgcn_s_setprio(1); _Pragma("unroll") for (int m = 0; m < 4; ++m) _Pragma("unroll") for (int n = 0; n < 2; ++n) { \
        if constexpr (ESZ == 1) { asm volatile("v_mfma_scale_f32_16x16x128_f8f6f4 %0, %1, %2, %0, %3, %3 op_sel_hi:[0,0,0]" : "+v"(acc[ai][bj][m][n]) : "v"(Bt##8[n]), "v"(At##8[m]), "v"(sc7f)); } \
        else { _Pragma("unroll") for (int k = 0; k < 2; ++k) acc[ai][bj][m][n] = __builtin_amdgcn_mfma_f32_16x16x32_bf16(Bt[n][k], At[m][k], acc[ai][bj][m][n], 0, 0, 0); } } \
        __builtin_amdgcn_s_setprio(0); } while (0)
#define PG8_WAIT_V(n) asm volatile("s_waitcnt vmcnt(" #n ")" ::: "memory")
#define PG8_WAIT_L(n) asm volatile("s_waitcnt lgkmcnt(" #n ")" ::: "memory")
#define PG8_BAR __builtin_amdgcn_s_barrier()
#define PG8_SCHED __builtin_amdgcn_sched_barrier(0)
    Unit cur, nxt; int ui = 0;
    if (!S.next(0, cur)) return;
    f32x4 acc[2][2][4][2];
#pragma unroll
    for (int a = 0; a < 2; ++a)
#pragma unroll
        for (int b = 0; b < 2; ++b)
#pragma unroll
            for (int m = 0; m < 4; ++m)
#pragma unroll
                for (int n = 0; n < 2; ++n) acc[a][b][m][n] = (f32x4){0.f, 0.f, 0.f, 0.f};
    const int sc7f = 0x7f7f7f7f;
    bf16x8 At[4][2], B0[2][2], B1[2][2]; i32x8 At8[4], B08[2], B18[2];
    const char* cA = cur.a; const char* cB = cur.b;
    S.a_ready(cur);
    if constexpr (SP2) {
        PG8_STAGE(PG8_SB(0, 0), cB, voffB); PG8_STAGE(PG8_SB(0, 1), cB + hstep, voffB); PG8_STAGE(PG8_SA(0, 0), cA, voffA); PG8_STAGE(PG8_SA(0, 1), cA + hstep, voffA);
        if (wr == 1) PG8_BAR;
        PG8_WAIT_V(2); PG8_BAR;
        PG8_STAGE(PG8_SB(1, 0), cB + kstep, voffB); PG8_STAGE(PG8_SA(1, 0), cA + kstep, voffA); PG8_STAGE(PG8_SB(1, 1), cB + hstep + kstep, voffB);
        PG8_WAIT_V(6); PG8_BAR;
    } else {
        PG8_STAGE(PG8_SB(0, 0), cB, voffB); PG8_STAGE(PG8_SA(0, 0), cA, voffA); PG8_STAGE(PG8_SB(0, 1), cB + hstep, voffB); PG8_STAGE(PG8_SA(0, 1), cA + hstep, voffA);
        if (wr == 1) PG8_BAR;
        PG8_WAIT_V(4); PG8_BAR;
        PG8_STAGE(PG8_SB(1, 0), cB + kstep, voffB); PG8_STAGE(PG8_SA(1, 0), cA + kstep, voffA); PG8_STAGE(PG8_SB(1, 1), cB + hstep + kstep, voffB);
        PG8_WAIT_V(6); PG8_BAR;
    }
    for (;;) {
        const bool has_next = S.next(ui + 1, nxt);
        const char* nA = has_next ? nxt.a : cA; const char* nB = has_next ? nxt.b : cB;
        for (int t = 0; t < nt; t += 2) {
            const bool last = (t == nt - 2);
            const char* a1 = cA + (size_t)(t + 1) * kstep;
            const char* a2 = last ? nA : cA + (size_t)(t + 2) * kstep; const char* b2 = last ? nB : cB + (size_t)(t + 2) * kstep;
            const char* a3 = a2 + kstep; const char* b3 = b2 + kstep;
            if (last && has_next) S.a_ready(nxt);
            if constexpr (SP2) {
            PG8_LDB(B0, 0, 0); PG8_LDB(B1, 0, 1); PG8_SCHED; PG8_LDA(At, 0, 0); PG8_STAGE(PG8_SA(1, 1), a1 + hstep, voffA);
            PG8_WAIT_V(8); PG8_WAIT_L(0); PG8_BAR; PG8_MMA(0, 0, At, B0); PG8_MMA(0, 1, At, B1); PG8_BAR; PG8_SCHED;
            PG8_LDA(At, 0, 1); PG8_STAGE(PG8_SB(0, 0), b2, voffB); PG8_STAGE(PG8_SB(0, 1), b2 + hstep, voffB); PG8_STAGE(PG8_SA(0, 0), a2, voffA);
            PG8_WAIT_V(8); PG8_WAIT_L(0); PG8_BAR; PG8_MMA(1, 0, At, B0); PG8_MMA(1, 1, At, B1); PG8_BAR; PG8_SCHED;
            PG8_LDB(B0, 1, 0); PG8_LDB(B1, 1, 1); PG8_SCHED; PG8_LDA(At, 1, 0); PG8_STAGE(PG8_SA(0, 1), a2 + hstep, voffA);
            PG8_WAIT_V(8); PG8_WAIT_L(0); PG8_BAR; PG8_MMA(0, 0, At, B0); PG8_MMA(0, 1, At, B1); PG8_BAR; PG8_SCHED;
            PG8_LDA(At, 1, 1); PG8_STAGE(PG8_SB(1, 0), b3, voffB); PG8_STAGE(PG8_SB(1, 1), b3 + hstep, voffB); PG8_STAGE(PG8_SA(1, 0), a3, voffA);
            PG8_WAIT_V(8); PG8_WAIT_L(0); PG8_BAR; PG8_MMA(1, 0, At, B0); PG8_MMA(1, 1, At, B1); PG8_BAR; PG8_SCHED;
            } else {
            PG8_LDB(B0, 0, 0); PG8_SCHED; PG8_LDA(At, 0, 0); PG8_STAGE(PG8_SA(1, 1), a1 + hstep, voffA);
            PG8_WAIT_L(8); PG8_BAR; PG8_WAIT_L(0); PG8_MMA(0, 0, At, B0); PG8_BAR; PG8_SCHED;
            PG8_LDB(B1, 0, 1); PG8_STAGE(PG8_SB(0, 0), b2, voffB);
            PG8_BAR; PG8_WAIT_L(0); PG8_MMA(0, 1, At, B1); PG8_BAR;
            PG8_LDA(At, 0, 1); PG8_STAGE(PG8_SA(0, 0), a2, voffA);
            PG8_BAR; PG8_WAIT_L(0); PG8_MMA(1, 0, At, B0); PG8_BAR; PG8_SCHED;
            PG8_STAGE(PG8_SB(0, 1), b2 + hstep, voffB);
            PG8_WAIT_V(6); PG8_BAR; PG8_MMA(1, 1, At, B1); PG8_BAR;
            PG8_LDB(B0, 1, 0); PG8_SCHED; PG8_LDA(At, 1, 0); PG8_STAGE(PG8_SA(0, 1), a2 + hstep, voffA);
            PG8_WAIT_L(8); PG8_BAR; PG8_WAIT_L(0); PG8_MMA(0, 0, At, B0); PG8_BAR; PG8_SCHED;
            PG8_LDB(B1, 1, 1); PG8_STAGE(PG8_SB(1, 0), b3, voffB);
            PG8_BAR; PG8_WAIT_L(0); PG8_MMA(0, 1, At, B1); PG8_BAR;
            PG8_LDA(At, 1, 1); PG8_STAGE(PG8_SA(1, 0), a3, voffA);
            PG8_BAR; PG8_WAIT_L(0); PG8_MMA(1, 0, At, B0); PG8_BAR; PG8_SCHED;
            PG8_STAGE(PG8_SB(1, 1), b3 + hstep, voffB);
            PG8_WAIT_V(6); PG8_BAR; PG8_MMA(1, 1, At, B1); PG8_BAR;
            }
        }
        if constexpr (ESZ == 1) asm volatile("s_nop 15\n\ts_nop 15" ::: "memory");
        if constexpr (ALIGN_EPI) { if (wr == 0) PG8_BAR; }
        if constexpr (!Epi::AFTER_DRAIN) { int z_ = 0; asm volatile("" : "+v"(z_)); const int ln_ = (int)__builtin_amdgcn_mbcnt_hi(~0u, __builtin_amdgcn_mbcnt_lo(~0u, (unsigned)z_)); const int fr_ = ln_ & 15, fq_ = ln_ >> 4;
            E(acc, cur, wr, wc, fr_, fq_); S.done(cur); }
        if (!has_next) break;
#pragma unroll
        for (int a = 0; a < 2; ++a)
#pragma unroll
            for (int b = 0; b < 2; ++b)
#pragma unroll
                for (int m = 0; m < 4; ++m)
#pragma unroll
                    for (int n = 0; n < 2; ++n) acc[a][b][m][n] = (f32x4){0.f, 0.f, 0.f, 0.f};
        cur = nxt; cA = nA; cB = nB; ++ui;
        if constexpr (ALIGN_EPI) { if (wr == 1) PG8_BAR; }
    }
    PG8_WAIT_V(0);
    if constexpr (!ALIGN_EPI) { if (wr == 0) PG8_BAR; }
    PG8_BAR;
    if constexpr (Epi::AFTER_DRAIN) { E.fused(acc, cur, wr, wc, fr, fq, lds, wid, lane); S.done(cur); }
#undef PG8_SA
#undef PG8_SB
#undef PG8_STAGE
#undef PG8_LDA
#undef PG8_LDB
#undef PG8_MMA
#undef PG8_WAIT_V
#undef PG8_WAIT_L
#undef PG8_BAR
#undef PG8_SCHED
}
}

namespace att {
#define ALAS __attribute__((address_space(3)))
typedef short bf16x8 __attribute__((ext_vector_type(8)));
typedef short s16x4 __attribute__((ext_vector_type(4)));
typedef float f32x16 __attribute__((ext_vector_type(16)));
typedef float f32x4 __attribute__((ext_vector_type(4)));
typedef unsigned u32x4 __attribute__((ext_vector_type(4)));
typedef unsigned short bf16_t;
typedef ALAS char* ALAS_char_ptr;
constexpr int D = 128, PITCH = 1024, NW = 8, QBLK = 32, KVBLK = 64, QB = NW * QBLK, SEQ = 8192;
constexpr int SHM = KVBLK * D * 2;
constexpr int OFF_V = 0, OFF_K = 2 * SHM, OFF_WS = 4 * SHM, OFF_G = OFF_WS + NW * 64 * 4, OFF_FLAG = OFF_G + SEQ * 4, LDS_BYTES = OFF_FLAG + 256;
constexpr float SCALE = 0.08838834764831845f, LOG2E = 1.4426950408889634f, C2 = SCALE * LOG2E;
constexpr float THR2 = 10.0f;
constexpr float SB_EXIT = 152.0f;

#define KSWZ(row, colB) ((row) * 256 + ((colB) ^ (((row) & 7) << 4)))
#define ASBAR() __builtin_amdgcn_sched_barrier(0)
__device__ __forceinline__ int v_st(int k, int c) { const int kk = (k & ~0xC) | ((k & 4) << 1) | ((k & 8) >> 1); return ((kk >> 3) * 4 + (c >> 5)) * 512 + ((kk & 7) * 32 + (c & 31)) * 2; }
__device__ __forceinline__ int v_rd_base(int lane) { return ((lane & 3) << 3) | (((lane >> 2) & 3) << 6) | (((lane >> 4) & 1) << 5) | (((lane >> 5) & 1) << 8); }
constexpr int v_rd_off(int d0, int ks, int half) { return d0 * 512 + ks * 4096 + half * 2048; }
__device__ __forceinline__ int crow(int r, int hi) { return (r & 3) + 8 * (r >> 2) + 4 * hi; }
__device__ __forceinline__ unsigned cvtpk(float lo, float hi) { return pg8::cvt_pk_bf16(lo, hi); }

struct Stage { bf16x8 k0, k1, v0, v1; };
__device__ __forceinline__ void sload(Stage& S, const bf16_t* Kh, const bf16_t* Vh, int kbase, unsigned loff) {
    const char* Kt = (const char*)Kh + (size_t)kbase * PITCH * 2; const char* Vt = (const char*)Vh + (size_t)kbase * PITCH * 2;
    S.v0 = *(const bf16x8*)(Vt + loff); S.v1 = *(const bf16x8*)(Vt + (loff + 32u * PITCH * 2u));
    S.k0 = *(const bf16x8*)(Kt + loff); S.k1 = *(const bf16x8*)(Kt + (loff + 32u * PITCH * 2u));
}
__device__ __forceinline__ void swrite(const Stage& S, ALAS char* lds, int buf, int kws, int vst0, int vst1) {
    *(ALAS bf16x8*)(lds + OFF_K + buf * SHM + kws) = S.k0; *(ALAS bf16x8*)(lds + OFF_K + buf * SHM + kws + 32 * 256) = S.k1;
    *(ALAS bf16x8*)(lds + OFF_V + buf * SHM + vst0) = S.v0; *(ALAS bf16x8*)(lds + OFF_V + buf * SHM + vst1) = S.v1;
}
__device__ __forceinline__ void qkt(f32x16& p0, f32x16& p1, const ALAS char* Kb, int r32, int hi, const bf16x8* qr) {
    p0 = f32x16{}; p1 = f32x16{};
    const ALAS char* kb[4];
#pragma unroll
    for (int dd = 0; dd < 4; ++dd) kb[dd] = Kb + KSWZ(r32, (dd * 16 + hi * 8) * 2);
#pragma unroll
    for (int d0 = 0; d0 < 8; ++d0) { const ALAS char* a = kb[d0 & 3] + (d0 >> 2) * 128;
        const bf16x8 b0 = *(const ALAS bf16x8*)a;
        const bf16x8 b1 = *(const ALAS bf16x8*)(a + 32 * 256);
        p0 = __builtin_amdgcn_mfma_f32_32x32x16_bf16(b0, qr[d0], p0, 0, 0, 0);
        p1 = __builtin_amdgcn_mfma_f32_32x32x16_bf16(b1, qr[d0], p1, 0, 0, 0); }
}
__device__ __forceinline__ void pv_tile(f32x16* o, int vb, bf16x8 pa0, bf16x8 pa1, bf16x8 pa2, bf16x8 pa3) {
#define TRRD(dst, off) asm volatile("ds_read_b64_tr_b16 %0, %1 offset:%2" : "=&v"(dst) : "v"(vb), "i"(off) : "memory")
#define PV_D0(d0) do { s16x4 l0, l1, l2, l3, h0, h1, h2, h3; constexpr int b_ = v_rd_off(d0, 0, 0); \
        TRRD(l0, b_); TRRD(h0, b_ + 2048); TRRD(l1, b_ + 4096); TRRD(h1, b_ + 6144); TRRD(l2, b_ + 8192); TRRD(h2, b_ + 10240); TRRD(l3, b_ + 12288); TRRD(h3, b_ + 14336); \
        asm volatile("s_waitcnt lgkmcnt(0)" ::: "memory"); ASBAR(); \
        o[d0] = __builtin_amdgcn_mfma_f32_32x32x16_bf16(pa0, (bf16x8){l0[0], l0[1], l0[2], l0[3], h0[0], h0[1], h0[2], h0[3]}, o[d0], 0, 0, 0);   \
        o[d0] = __builtin_amdgcn_mfma_f32_32x32x16_bf16(pa1, (bf16x8){l1[0], l1[1], l1[2], l1[3], h1[0], h1[1], h1[2], h1[3]}, o[d0], 0, 0, 0);   \
        o[d0] = __builtin_amdgcn_mfma_f32_32x32x16_bf16(pa2, (bf16x8){l2[0], l2[1], l2[2], l2[3], h2[0], h2[1], h2[2], h2[3]}, o[d0], 0, 0, 0);   \
        o[d0] = __builtin_amdgcn_mfma_f32_32x32x16_bf16(pa3, (bf16x8){l3[0], l3[1], l3[2], l3[3], h3[0], h3[1], h3[2], h3[3]}, o[d0], 0, 0, 0); } while (0)
    PV_D0(0); PV_D0(1); PV_D0(2); PV_D0(3);
#undef PV_D0
#undef TRRD
}
__device__ __forceinline__ void pack_p(const f32x16& p0, const f32x16& p1, bf16x8& pa0, bf16x8& pa1, bf16x8& pa2, bf16x8& pa3) {
#define PK4(P, B_, OUT) do { unsigned a0 = cvtpk(P[B_+0], P[B_+1]), a1 = cvtpk(P[B_+2], P[B_+3]);                          \
        unsigned b0 = cvtpk(P[B_+4], P[B_+5]), b1 = cvtpk(P[B_+6], P[B_+7]);                                             \
        auto r0 = __builtin_amdgcn_permlane32_swap(a0, b0, false, false); auto r1 = __builtin_amdgcn_permlane32_swap(a1, b1, false, false); \
        u32x4 w = {r0[0], r1[0], r0[1], r1[1]}; OUT = *reinterpret_cast<bf16x8*>(&w); } while (0)
    PK4(p0, 0, pa0); PK4(p0, 8, pa1); PK4(p1, 0, pa2); PK4(p1, 8, pa3);
#undef PK4
}
__device__ __forceinline__ void store_o(const f32x16* o, const float* rs, bf16_t* Ow  , int r32, int hi) {
    const unsigned lo = (unsigned)((4 * hi * PITCH + r32) * 2);
#pragma unroll
    for (int r = 0; r < 16; ++r) { const int orow0 = (r & 3) + 8 * (r >> 2);
#pragma unroll
        for (int d0 = 0; d0 < 4; ++d0) { const float v = o[d0][r] * rs[r]; const float vn = __shfl_xor(v, 1);
            if ((r32 & 1) == 0) *(unsigned*)((char*)Ow + (lo + (unsigned)((orow0 * PITCH + d0 * 32) * 2))) = cvtpk(v, vn); } }
}

__device__ __forceinline__ void fox_unit(const bf16_t* Qh, const bf16_t* Kh, const bf16_t* Vh, bf16_t* Oh, const float* Gh, int qb, int t0, int t1, int mode, float* part, unsigned* flag, unsigned* tmo, const unsigned* km, ALAS char* lds) {
    int tid = threadIdx.x; asm volatile("" : "+v"(tid));
    const int wid = __builtin_amdgcn_readfirstlane(tid >> 6), lane = tid & 63, r32 = lane & 31, hi = lane >> 5;
    const int P0 = qb * QB, NT = 4 * (qb + 1);
    const int sr = tid >> 4, sc = (tid & 15) * 8, vst0 = v_st(sr, sc), vst1 = v_st(32 + sr, sc), kws = KSWZ(sr, sc * 2); const unsigned loff = (unsigned)((sr * PITCH + sc) * 2);
    const int vb0 = (int)(unsigned)(size_t)(lds + OFF_V) + v_rd_base(lane);
    ALAS float* wsf = (ALAS float*)(lds + OFF_WS) + wid * 64; ALAS float* li_l = wsf; ALAS float* al_l = wsf + 32;
    ALAS float* Gl = (ALAS float*)(lds + OFF_G);
    {
        f32x4 a[4]; float run = 0.f;
#pragma unroll
        for (int i = 0; i < 4; ++i) a[i] = *(const f32x4*)((const char*)Gh + (unsigned)((tid * 16 + i * 4) * 4));
#pragma unroll
        for (int i = 0; i < 4; ++i) { a[i].x += run; a[i].y += a[i].x; a[i].z += a[i].y; a[i].w += a[i].z; run = a[i].w; }
        float inc = run;
#pragma unroll
        for (int o = 1; o < 64; o <<= 1) { const float t = __shfl_up(inc, o); if (lane >= o) inc += t; }
        ALAS float* wtot = (ALAS float*)(lds + OFF_FLAG + 96);
        if (lane == 63) wtot[wid] = inc;
        __syncthreads();
        float off = inc - run;
#pragma unroll
        for (int w = 0; w < NW; ++w) off += w < wid ? wtot[w] : 0.f;
#pragma unroll
        for (int i = 0; i < 4; ++i) ((ALAS f32x4*)Gl)[tid * 4 + i] = (a[i] + off) * LOG2E;
    }
    bf16x8 qr[8];
#pragma unroll
    for (int d0 = 0; d0 < 8; ++d0) qr[d0] = *(const bf16x8*)((const char*)Qh + (size_t)P0 * PITCH * 2 + (unsigned)(((wid * QBLK + r32) * PITCH + hi * 8) * 2 + d0 * 32));
    Stage S; sload(S, Kh, Vh, (NT - 1 - t0) * KVBLK, loff);
    asm volatile("s_waitcnt vmcnt(0)" ::: "memory"); swrite(S, lds, 0, kws, vst0, vst1);
    __syncthreads();
    float cq;
    { float k2 = 0.f;
#pragma unroll
      for (int w = 0; w < 4; ++w) k2 += __uint_as_float(__hip_atomic_load(km + w, __ATOMIC_RELAXED, __HIP_MEMORY_SCOPE_AGENT));
      float q2 = 0.f;
#pragma unroll
      for (int d0 = 0; d0 < 8; ++d0) { const u32x4 u = __builtin_bit_cast(u32x4, qr[d0]);
#pragma unroll
          for (int j = 0; j < 4; ++j) { const float a = __uint_as_float(u[j] << 16), b = __uint_as_float(u[j] & 0xffff0000u); q2 += a * a + b * b; } }
      { auto rr = __builtin_amdgcn_permlane32_swap(__float_as_uint(q2), __float_as_uint(q2), false, false); q2 = __uint_as_float(rr[0]) + __uint_as_float(rr[1]); }
      cq = sqrtf(q2) * sqrtf(k2) * (1.01f * C2); }
    ALAS int* flg = (ALAS int*)(lds + OFF_FLAG);
    const float Gref = Gl[P0 + QB - 1];
    float m_reg = -1e30f, l_reg = 0.f; f32x16 o[4] = {};
    const int qlo = P0 + wid * QBLK, qm = qlo + r32 - 4 * hi;
    const float mlb = (Gref - Gl[qlo + r32]) - cq;
    bool skip_all = false;
    { const float gb0 = Gref - Gl[(NT - 1 - t0) * KVBLK + KVBLK - 1];
      const bool done_w = __all(cq + gb0 <= mlb - SB_EXIT);
      if (lane == 0) flg[32 + wid] = done_w ? 1 : 0;
      __syncthreads();
      int all_done = 1;
#pragma unroll
      for (int w = 0; w < NW; ++w) all_done &= flg[32 + w];
      skip_all = all_done != 0; }
    for (int t = t0; t < t1 && !skip_all; ++t) {
        const int buf = (t - t0) & 1, kb = (NT - 1 - t) * KVBLK;
        if (t + 1 < t1) sload(S, Kh, Vh, kb - KVBLK, loff);
        ASBAR();
        if (kb <= qlo + QBLK - 1) {
            f32x16 p0, p1;
            qkt(p0, p1, lds + OFF_K + buf * SHM, r32, hi, qr);
#pragma unroll
            for (int g = 0; g < 4; ++g) { const f32x4 b0 = *(const ALAS f32x4*)(Gl + kb + 8 * g + 4 * hi), b1 = *(const ALAS f32x4*)(Gl + kb + 32 + 8 * g + 4 * hi);
#pragma unroll
                for (int i = 0; i < 4; ++i) { p0[4 * g + i] = fmaf(p0[4 * g + i], C2, Gref - b0[i]); p1[4 * g + i] = fmaf(p1[4 * g + i], C2, Gref - b1[i]); } }
            if (kb + KVBLK - 1 > qlo) {
                const int dq = qm - kb; const float NEG = -__builtin_inff();
#pragma unroll
                for (int r = 0; r < 16; ++r) { const int c = (r & 3) + 8 * (r >> 2); if (dq - c < 0) p0[r] = NEG; if (dq - c - 32 < 0) p1[r] = NEG; }
            }
            float pmax = p0[0];
#pragma unroll
            for (int r = 1; r < 16; ++r) pmax = fmaxf(pmax, p0[r]);
#pragma unroll
            for (int r = 0; r < 16; ++r) pmax = fmaxf(pmax, p1[r]);
            { auto rr = __builtin_amdgcn_permlane32_swap(__float_as_uint(pmax), __float_as_uint(pmax), false, false); pmax = fmaxf(__uint_as_float(rr[0]), __uint_as_float(rr[1])); }
            float mn, alpha;
            if (__all(pmax - m_reg <= THR2)) { mn = m_reg; alpha = 1.f; }
            else { mn = fmaxf(m_reg, pmax); alpha = __builtin_amdgcn_exp2f(m_reg - mn); m_reg = mn; }
            float ps = 0.f;
#pragma unroll
            for (int r = 0; r < 16; ++r) { p0[r] = __builtin_amdgcn_exp2f(p0[r] - mn); ps += p0[r]; }
#pragma unroll
            for (int r = 0; r < 16; ++r) { p1[r] = __builtin_amdgcn_exp2f(p1[r] - mn); ps += p1[r]; }
            { auto rr = __builtin_amdgcn_permlane32_swap(__float_as_uint(ps), __float_as_uint(ps), false, false); ps = __uint_as_float(rr[0]) + __uint_as_float(rr[1]); }
            l_reg = l_reg * alpha + ps;
            bf16x8 pa0, pa1, pa2, pa3; pack_p(p0, p1, pa0, pa1, pa2, pa3);
            if (__any(alpha < 1.f)) { if (hi == 0) al_l[r32] = alpha; asm volatile("s_waitcnt lgkmcnt(0)" ::: "memory");
#pragma unroll
                for (int d_ = 0; d_ < 4; ++d_)
#pragma unroll
                    for (int r = 0; r < 16; ++r) o[d_][r] *= al_l[crow(r, hi)]; }
            ASBAR();
            pv_tile(o, vb0 + buf * SHM, pa0, pa1, pa2, pa3);
        }
        { const float gb = kb > 0 ? Gref - Gl[kb - 1] : 0.f;
          const bool done_w = __all(cq + gb <= fmaxf(m_reg, mlb) - SB_EXIT);
          if (lane == 0) flg[buf * 8 + wid] = done_w ? 1 : 0; }
        if (t + 1 < t1) { asm volatile("s_waitcnt vmcnt(0)" ::: "memory"); swrite(S, lds, buf ^ 1, kws, vst0, vst1); }
        __syncthreads();
        int all_done = 1;
#pragma unroll
        for (int w = 0; w < NW; ++w) all_done &= flg[buf * 8 + w];
        if (all_done) break;
    }
    if (mode == 1) {
        float* Op = part + (size_t)(wid * QBLK) * D;
#pragma unroll
        for (int r = 0; r < 16; ++r)
#pragma unroll
            for (int d0 = 0; d0 < 4; ++d0) *(float*)((char*)Op + (unsigned)((crow(r, hi) * D + d0 * 32 + r32) * 4)) = o[d0][r];
        if (hi == 0) { part[QB * D + wid * QBLK + r32] = m_reg; part[QB * D + QB + wid * QBLK + r32] = l_reg; }
        asm volatile("s_waitcnt vmcnt(0)" ::: "memory");
        __syncthreads();
        if (tid == 0) { __builtin_amdgcn_fence(__ATOMIC_RELEASE, "agent"); asm volatile("s_waitcnt vmcnt(0)" ::: "memory");
            __hip_atomic_store(flag, 1u, __ATOMIC_RELAXED, __HIP_MEMORY_SCOPE_AGENT); }
        __syncthreads();
        return;
    }
    if (mode == 2) {
        if (tid == 0) { unsigned sp = 0u;
            while (__hip_atomic_load(flag, __ATOMIC_RELAXED, __HIP_MEMORY_SCOPE_AGENT) == 0u) { __builtin_amdgcn_s_sleep(4); if (++sp > (1u << 21)) { atomicAdd(tmo, 1u); break; } }
            __builtin_amdgcn_fence(__ATOMIC_ACQUIRE, "agent"); asm volatile("s_waitcnt vmcnt(0)" ::: "memory"); }
        __syncthreads();
        const float mB = part[QB * D + wid * QBLK + r32], lB = part[QB * D + QB + wid * QBLK + r32];
        const float mN = fmaxf(m_reg, mB), fa = __builtin_amdgcn_exp2f(m_reg - mN), fb = __builtin_amdgcn_exp2f(mB - mN);
        l_reg = l_reg * fa + lB * fb;
        if (hi == 0) { al_l[r32] = fa; li_l[r32] = fb; } asm volatile("s_waitcnt lgkmcnt(0)" ::: "memory");
        const float* Op = part + (size_t)(wid * QBLK) * D;
#pragma unroll
        for (int r = 0; r < 16; ++r) { const float ar = al_l[crow(r, hi)], br = li_l[crow(r, hi)];
#pragma unroll
            for (int d0 = 0; d0 < 4; ++d0) o[d0][r] = o[d0][r] * ar + *(const float*)((const char*)Op + (unsigned)((crow(r, hi) * D + d0 * 32 + r32) * 4)) * br; }
        asm volatile("s_waitcnt lgkmcnt(0)" ::: "memory");
    }
    if (hi == 0) li_l[r32] = l_reg; asm volatile("s_waitcnt lgkmcnt(0)" ::: "memory");
    float rli[16];
#pragma unroll
    for (int r = 0; r < 16; ++r) rli[r] = __builtin_amdgcn_rcpf(li_l[crow(r, hi)]);
    store_o(o, rli, Oh + (size_t)(P0 + wid * QBLK) * PITCH, r32, hi);
    __syncthreads();
}

__device__ __forceinline__ float softplus2(float u) { return fmaxf(u, 0.f) + __builtin_amdgcn_logf(1.0f + __builtin_amdgcn_exp2f(-fabsf(u))); }
__device__ __forceinline__ void sb_unit(const bf16_t* Qh, const bf16_t* Kh, const bf16_t* Vh, bf16_t* Oh, int qb, ALAS char* lds) {
    int tid = threadIdx.x; asm volatile("" : "+v"(tid));
    const int wid = __builtin_amdgcn_readfirstlane(tid >> 6), lane = tid & 63, r32 = lane & 31, hi = lane >> 5;
    const int P0 = qb * QB, NT = 4 * (qb + 1);
    const int sr = tid >> 4, sc = (tid & 15) * 8, vst0 = v_st(sr, sc), vst1 = v_st(32 + sr, sc), kws = KSWZ(sr, sc * 2); const unsigned loff = (unsigned)((sr * PITCH + sc) * 2);
    const int vb0 = (int)(unsigned)(size_t)(lds + OFF_V) + v_rd_base(lane);
    ALAS int* flg = (ALAS int*)(lds + OFF_FLAG);
    bf16x8 qr[8];
#pragma unroll
    for (int d0 = 0; d0 < 8; ++d0) qr[d0] = *(const bf16x8*)((const char*)Qh + (size_t)P0 * PITCH * 2 + (unsigned)(((wid * QBLK + r32) * PITCH + hi * 8) * 2 + d0 * 32));
    Stage S; sload(S, Kh, Vh, (NT - 1) * KVBLK, loff);
    asm volatile("s_waitcnt vmcnt(0)" ::: "memory"); swrite(S, lds, 0, kws, vst0, vst1);
    __syncthreads();
    float carry = 0.f; f32x16 o[4] = {};
    const int qlo = P0 + wid * QBLK, qm = qlo + r32 - 4 * hi;
    for (int t = 0; t < NT; ++t) {
        const int buf = t & 1, kb = (NT - 1 - t) * KVBLK;
        if (t + 1 < NT) sload(S, Kh, Vh, kb - KVBLK, loff);
        ASBAR();
        if (kb < qlo + QBLK - 1) {
            f32x16 p0, p1, s0, s1;
            qkt(p0, p1, lds + OFF_K + buf * SHM, r32, hi, qr);
            const int dq = qm - kb - 1;
#pragma unroll
            for (int r = 0; r < 16; ++r) { const int c = (r & 3) + 8 * (r >> 2);
                p0[r] *= C2; p1[r] *= C2;
                s0[r] = (dq - c < 0) ? 0.f : softplus2(p0[r]); s1[r] = (dq - c - 32 < 0) ? 0.f : softplus2(p1[r]); }
#pragma unroll
            for (int g = 0; g < 4; ++g) { s0[4 * g + 2] += s0[4 * g + 3]; s0[4 * g + 1] += s0[4 * g + 2]; s0[4 * g] += s0[4 * g + 1];
                                          s1[4 * g + 2] += s1[4 * g + 3]; s1[4 * g + 1] += s1[4 * g + 2]; s1[4 * g] += s1[4 * g + 1]; }
            float e0[4], e1[4], running = carry;
#pragma unroll
            for (int g = 3; g >= 0; --g) { auto rb = __builtin_amdgcn_permlane32_swap(__float_as_uint(s1[4 * g]), __float_as_uint(s1[4 * g]), false, false);
                const float eh = running; running += __uint_as_float(rb[1]); const float el = running; running += __uint_as_float(rb[0]); e1[g] = hi ? eh : el; }
#pragma unroll
            for (int g = 3; g >= 0; --g) { auto ra = __builtin_amdgcn_permlane32_swap(__float_as_uint(s0[4 * g]), __float_as_uint(s0[4 * g]), false, false);
                const float eh = running; running += __uint_as_float(ra[1]); const float el = running; running += __uint_as_float(ra[0]); e0[g] = hi ? eh : el; }
            carry = running;
#pragma unroll
            for (int g = 0; g < 4; ++g) {
#pragma unroll
                for (int i = 0; i < 4; ++i) { const int r = 4 * g + i, c = (r & 3) + 8 * (r >> 2);
                    p0[r] = (dq - c < 0) ? 0.f : __builtin_amdgcn_exp2f(p0[r] - (e0[g] + s0[r]));
                    p1[r] = (dq - c - 32 < 0) ? 0.f : __builtin_amdgcn_exp2f(p1[r] - (e1[g] + s1[r])); } }
            bf16x8 pa0, pa1, pa2, pa3; pack_p(p0, p1, pa0, pa1, pa2, pa3);
            ASBAR();
            pv_tile(o, vb0 + buf * SHM, pa0, pa1, pa2, pa3);
        }
        const bool done_w = __all(carry > SB_EXIT);
        if (lane == 0) flg[buf * 8 + wid] = done_w ? 1 : 0;
        if (t + 1 < NT) { asm volatile("s_waitcnt vmcnt(0)" ::: "memory"); swrite(S, lds, buf ^ 1, kws, vst0, vst1); }
        __syncthreads();
        int all_done = 1;
#pragma unroll
        for (int w = 0; w < NW; ++w) all_done &= flg[buf * 8 + w];
        if (all_done) break;
    }
    float one[16];
#pragma unroll
    for (int r = 0; r < 16; ++r) one[r] = 1.f;
    store_o(o, one, Oh + (size_t)(P0 + wid * QBLK) * PITCH, r32, hi);
    __syncthreads();
}
#undef KSWZ
#undef ASBAR
}

constexpr int NWAVES = 8;
constexpr int N_LAUNCHES = MK_N_LAUNCHES;
constexpr int PER_PHASE = 9;

constexpr int T = 8192, DM = 2048, NH = 8, HD = 128, DH = NH * HD  ;
constexpr int NIN = 3 * DH + 3 * DH + NH + 2 * DM;
constexpr int NIN_G = 6 * DH + 2 * DM;
constexpr int NE = 32, TOPK = 4, DFF = DM, CAP = T;
constexpr float RMS_EPS = 1e-5f;

constexpr size_t MiB = 1u << 20;
constexpr size_t WS_CTL = 0, CTL_ZERO_BYTES = 128 * 1024;
constexpr size_t WS_WIN = 1 * MiB;
constexpr size_t WS_WPA = 41 * MiB, WS_WPB = 45 * MiB;
constexpr size_t WS_WOUT = 49 * MiB;
constexpr size_t WS_W1 = 57 * MiB;
constexpr size_t WS_W2 = 569 * MiB;
constexpr size_t WS_HN = 825 * MiB;
constexpr size_t WS_QKV = 857 * MiB, QKV_STRIDE = 16 * MiB;
constexpr size_t WS_GATES = 1050 * MiB;
constexpr size_t WS_LOGF = 1017 * MiB, WS_G = WS_LOGF + 512 * 1024;
constexpr size_t WS_OSB = 1018 * MiB, WS_OFX = 1034 * MiB;
constexpr size_t WS_PART = 953 * MiB;
constexpr size_t WS_MIXED = 1114 * MiB;
constexpr size_t WS_X1 = 1146 * MiB;
constexpr size_t WS_STOK = 1210 * MiB, WS_SW = 1211 * MiB;
constexpr size_t WS_Y = 2365 * MiB;
constexpr size_t WS_AS = 1341 * MiB;
constexpr size_t WS_H = 1853 * MiB;
constexpr size_t WS_HN8 = 3389 * MiB;
constexpr size_t WS_WIN8 = 3405 * MiB;
constexpr size_t WS_END = 3413 * MiB;
constexpr int CW_TMO = 0, CW_CODE = 1;
constexpr int CW_BAR = 4096;
constexpr int CW_CNT = 8192;
constexpr int CW_QF = 12288, CW_QS = CW_QF + 64 * 8;
constexpr int CW_QC = CW_QS + 64 * 8;
constexpr int CW_KM = CW_QC + 64;
constexpr int CW_FLAG = 16384;
static_assert((CW_FLAG + 64 * 128) * 4 <= (int)CTL_ZERO_BYTES && (CW_CNT + 64 * NE) <= CW_QF, "CTL words inside the memset region");

constexpr int RING_OFF = 0, RING_BYTES = 131072;
constexpr int LDSCTL_OFF = RING_BYTES, MISC_OFF = LDSCTL_OFF + 320;
constexpr int TAB_OFF = LDSCTL_OFF + 1024;
constexpr int LDS_BYTES = 147456;
static_assert(att::LDS_BYTES <= RING_BYTES, "attention scratch fits the ring region");

#define GAS __attribute__((address_space(1)))
#define LAS __attribute__((address_space(3)))
typedef unsigned short bf16;
typedef unsigned v4u __attribute__((ext_vector_type(4)));
typedef unsigned v2u __attribute__((ext_vector_type(2)));
typedef float f32x4 __attribute__((ext_vector_type(4)));
typedef float f32x16 __attribute__((ext_vector_type(16)));
typedef short bf16x8 __attribute__((ext_vector_type(8)));
typedef GAS unsigned gu32;
typedef GAS unsigned long long gu64;
#define RLX_AGENT __ATOMIC_RELAXED, __HIP_MEMORY_SCOPE_AGENT
#define LDS_WAIT() asm volatile("s_waitcnt lgkmcnt(0)" ::: "memory")
#define VM_WAIT() asm volatile("s_waitcnt vmcnt(0)" ::: "memory")
__device__ __forceinline__ unsigned long long rt() { return __builtin_amdgcn_s_memrealtime(); }
__device__ __forceinline__ unsigned f2bf(float f) { unsigned u = __builtin_bit_cast(unsigned, f); return (u + 0x7fffu + ((u >> 16) & 1u)) >> 16; }
__device__ __forceinline__ unsigned pk2(float lo, float hi) { return f2bf(lo) | (f2bf(hi) << 16); }

#define XB_TMO      128
#define XB_XCNT(j)  (256  + 64 * (j))
#define XB_XSUB(j)  (1280 + 64 * (j))
#define XB_XGEN(j)  (2304 + 64 * (j))
#define XB_TOP      3328
#define XB_TOPGEN   3392
#define XCD_BAR_WORDS 3456
#define XB_SPIN_CAP (1u << 18)

__device__ __forceinline__ unsigned xb_ld(unsigned* p)              { return __hip_atomic_load(p, __ATOMIC_RELAXED, __HIP_MEMORY_SCOPE_AGENT); }
__device__ __forceinline__ unsigned xb_add(unsigned* p, unsigned v) { return __hip_atomic_fetch_add(p, v, __ATOMIC_RELAXED, __HIP_MEMORY_SCOPE_AGENT); }
__device__ __forceinline__ unsigned xb_xcc_id() { return (unsigned)__builtin_amdgcn_s_getreg((3 << 11) | 20) & 0xFu; }
#define XB_SPIN(cond, bar) do { unsigned _sp = 0; while (cond) { __builtin_amdgcn_s_sleep(1); \
    if ((++_sp & 255u) == 0u) { if (xb_ld(&(bar)[XB_TMO])) break; if (_sp > XB_SPIN_CAP) { atomicAdd(&(bar)[XB_TMO], 1u); break; } } } } while (0)

struct XcdBarrier {
    unsigned* bar; unsigned x;
    volatile LAS unsigned* st;
};

__device__ __forceinline__ XcdBarrier xcd_barrier_post(unsigned* bar, volatile LAS unsigned* st) {
    XcdBarrier b; b.bar = bar; b.x = xb_xcc_id(); b.st = st;
    if (threadIdx.x == 0) (void)xb_add(&bar[XB_XCNT(b.x)], 1u);
    return b;
}
__device__ __forceinline__ void xcd_barrier_complete(unsigned* bar, unsigned x, unsigned& nloc, unsigned& nx) {
    const unsigned G = gridDim.x * gridDim.y * gridDim.z;
    unsigned sum, cnt, mine, sp = 0u;
    for (;;) {
        sum = 0u; cnt = 0u; mine = 0u;
#pragma unroll
        for (unsigned j = 0; j < 16; ++j) { const unsigned c = xb_ld(&bar[XB_XCNT(j)]); sum += c; cnt += (c > 0u) ? 1u : 0u; mine = (j == x) ? c : mine; }
        if (sum == G) break;
        __builtin_amdgcn_s_sleep(1);
        if ((++sp & 255u) == 0u) { if (xb_ld(&bar[XB_TMO])) break; if (sp > XB_SPIN_CAP) { atomicAdd(&bar[XB_TMO], 1u); break; } }
    }
    nloc = mine > 0u ? mine : 1u; nx = cnt > 0u ? cnt : 1u;
}

__device__ __forceinline__ void xcd_barrier(const XcdBarrier& b) {
    asm volatile("s_waitcnt vmcnt(0)" ::: "memory");
    __syncthreads();
    if (threadIdx.x == 0) {
        unsigned* bar = b.bar;
        __builtin_amdgcn_s_waitcnt(0);
        unsigned nloc = b.st[0], nx = b.st[1];
        if (nloc == 0u) { xcd_barrier_complete(bar, b.x, nloc, nx); b.st[0] = nloc; b.st[1] = nx; }
        const unsigned old = xb_add(&bar[XB_XSUB(b.x)], 1u);
        const unsigned gen = old / nloc;
        if (old + 1u == (gen + 1u) * nloc) {
            __builtin_amdgcn_fence(__ATOMIC_RELEASE, "agent");
            asm volatile("s_waitcnt vmcnt(0)" ::: "memory");
            const unsigned og = xb_add(&bar[XB_TOP], 1u);
            const unsigned tg = og / nx;
            if (og + 1u == (tg + 1u) * nx) xb_add(&bar[XB_TOPGEN], 1u);
            else XB_SPIN(xb_ld(&bar[XB_TOPGEN]) == tg, bar);
            __builtin_amdgcn_fence(__ATOMIC_ACQUIRE, "agent");
            xb_add(&bar[XB_XGEN(b.x)], 1u);
            asm volatile("s_waitcnt vmcnt(0)" ::: "memory");
        } else {
            XB_SPIN(xb_ld(&bar[XB_XGEN(b.x)]) == gen, bar);
            __builtin_amdgcn_fence(__ATOMIC_ACQUIRE, "agent");
            asm volatile("s_waitcnt vmcnt(0)" ::: "memory");
        }
    }
    __syncthreads();
}

struct Frame {
    LAS unsigned char* lds;
    volatile LAS unsigned* MISC;
    gu32* ctl;
    int tid, lane, wave;
    int vcu, G;
    const float *x, *g_mix, *w_in, *b_forget, *b_gate, *w_psb, *w_pfx, *w_out, *g_ffn, *w_router, *b_router, *w1, *b1, *w2, *b2, *g_final;
    float* out; unsigned char* ws;
};
__device__ __forceinline__ float wave_sum(float v) {
#pragma unroll
    for (int o = 1; o < 64; o <<= 1) v += __shfl_xor(v, o);
    return v;
}
__device__ __forceinline__ unsigned pkbf(float lo, float hi) { return pg8::cvt_pk_bf16(lo, hi); }

__device__ __forceinline__ void transpose_item(const float* src  , int ldw, bf16* dst  , int K, LAS unsigned char* scr, int tid) {
    const int kb = tid & 7, ng = tid >> 3;
    const float* s = src + (size_t)(kb * 8) * ldw + ng * 4;
    f32x4 v[8];
#pragma unroll
    for (int r = 0; r < 8; ++r) v[r] = *(const f32x4*)(s + (size_t)r * ldw);
#pragma unroll
    for (int j = 0; j < 4; ++j) { v4u o; o.x = pkbf(v[0][j], v[1][j]); o.y = pkbf(v[2][j], v[3][j]); o.z = pkbf(v[4][j], v[5][j]); o.w = pkbf(v[6][j], v[7][j]);
        *(LAS v4u*)(scr + (ng * 4 + j) * 144 + kb * 16) = o; }
    __syncthreads();
    const int c = tid & 7, n = tid >> 3;
#pragma unroll
    for (int i = 0; i < 4; ++i) { const int nn = n + 64 * i; const v4u o = *(const LAS v4u*)(scr + nn * 144 + c * 16); *(v4u*)(dst + (size_t)nn * K + c * 8) = o; }
    __syncthreads();
}
__device__ __forceinline__ void transpose_item_fp8(const float* src  , int ldw, unsigned char* dst  , int K, LAS unsigned char* scr, int tid) {
    const int kb = tid & 7, ng = tid >> 3;
#pragma unroll
    for (int p = 0; p < 2; ++p) {
        const float* s = src + (size_t)(p * 64 + kb * 8) * ldw + ng * 4;
        f32x4 v[8];
#pragma unroll
        for (int r = 0; r < 8; ++r) v[r] = *(const f32x4*)(s + (size_t)r * ldw) * pg8::W8_SCALE;
#pragma unroll
        for (int j = 0; j < 4; ++j) { v2u o; o.x = pg8::pk4_fp8(v[0][j], v[1][j], v[2][j], v[3][j]); o.y = pg8::pk4_fp8(v[4][j], v[5][j], v[6][j], v[7][j]);
            *(LAS v2u*)(scr + (ng * 4 + j) * 144 + p * 64 + kb * 8) = o; }
    }
    __syncthreads();
    const int c = tid & 7, n = tid >> 3;
#pragma unroll
    for (int i = 0; i < 4; ++i) { const int nn = n + 64 * i; const v4u o = *(const LAS v4u*)(scr + nn * 144 + c * 16); *(v4u*)(dst + (size_t)nn * K + c * 16) = o; }
    __syncthreads();
}
__device__ __forceinline__ void conv_load(f32x4 (&v)[8], const float* src, int ldw, int p, int kg, int cg) {
    const float* s = src + (size_t)(p * 64 + kg * 8) * ldw + cg * 4;
#pragma unroll
    for (int r = 0; r < 8; ++r) v[r] = __builtin_nontemporal_load((const f32x4*)(s + (size_t)r * ldw));
}
__device__ __forceinline__ void conv_to_lds(const f32x4 (&v)[8], LAS unsigned char* wscr, int p, int kg, int cg) {
#pragma unroll
    for (int j = 0; j < 4; ++j) { v2u o; o.x = pg8::pk4_fp8(v[0][j] * pg8::W8_SCALE, v[1][j] * pg8::W8_SCALE, v[2][j] * pg8::W8_SCALE, v[3][j] * pg8::W8_SCALE);
        o.y = pg8::pk4_fp8(v[4][j] * pg8::W8_SCALE, v[5][j] * pg8::W8_SCALE, v[6][j] * pg8::W8_SCALE, v[7][j] * pg8::W8_SCALE);
        *(LAS v2u*)(wscr + (cg * 4 + j) * 144 + p * 64 + kg * 8) = o; }
}
__device__ __forceinline__ void p0_prologue(Frame& F) {
    LAS unsigned char* scr = F.lds + RING_OFF;
    bf16* WIN = (bf16*)(F.ws + WS_WIN); bf16* WPA = (bf16*)(F.ws + WS_WPA); bf16* WPB = (bf16*)(F.ws + WS_WPB); bf16* WOUT = (bf16*)(F.ws + WS_WOUT);
    constexpr int I_WIN = 32 * 24, I_WP = 16 * 8, I_WOUT = 32 * 8;
    constexpr int NITEMS = I_WIN + 2 * I_WP + I_WOUT;
    {
        LAS unsigned char* wscr = scr + F.wave * (32 * 144);
        const int kg = F.lane >> 3, cg = F.lane & 7, c = F.lane & 7, n = F.lane >> 3;
        auto item = [&](int it, const float*& src, bf16*& dst, int& ldw, int& K) {
            int r = it;
            if (r < I_WIN) { const int nb = r % 24, kk = r / 24; src = F.w_in + (size_t)(kk * 64) * NIN + nb * 256; ldw = NIN; dst = WIN + (size_t)(nb * 256) * DM + kk * 64; K = DM; return; } r -= I_WIN;
            if (r < I_WP) { const int nb = r % 8, kk = r / 8; src = F.w_psb + (size_t)(kk * 64) * DM + nb * 256; ldw = DM; dst = WPA + (size_t)(nb * 256) * DH + kk * 64; K = DH; return; } r -= I_WP;
            if (r < I_WP) { const int nb = r % 8, kk = r / 8; src = F.w_pfx + (size_t)(kk * 64) * DM + nb * 256; ldw = DM; dst = WPB + (size_t)(nb * 256) * DH + kk * 64; K = DH; return; } r -= I_WP;
            { const int nb = r % 8, kk = r / 8; src = F.w_out + (size_t)(kk * 64) * DM + nb * 256; ldw = DM; dst = WOUT + (size_t)(nb * 256) * DM + kk * 64; K = DM; }
        };
        auto load8 = [&](f32x4 (&v)[8], const float* src, int ldw) { const float* p = src + (size_t)(kg * 8) * ldw + F.wave * 32 + cg * 4;
#pragma unroll
            for (int r = 0; r < 8; ++r) v[r] = __builtin_nontemporal_load((const f32x4*)(p + (size_t)r * ldw)); };
        f32x4 va[8], vb[8]; const float* src; bf16* dst; int ldw, K;
        int it = F.vcu;
        if (it < NITEMS) { item(it, src, dst, ldw, K); load8(va, src, ldw); }
        for (; it < NITEMS; it += 2 * F.G) {
#define P0_FLUSH(V, DST, KK) do { _Pragma("unroll") for (int j = 0; j < 4; ++j) { v4u o; o.x = pkbf(V[0][j], V[1][j]); o.y = pkbf(V[2][j], V[3][j]); o.z = pkbf(V[4][j], V[5][j]); o.w = pkbf(V[6][j], V[7][j]); \
                *(LAS v4u*)(wscr + (cg * 4 + j) * 144 + kg * 16) = o; } \
            asm volatile("s_waitcnt lgkmcnt(0)" ::: "memory"); \
            _Pragma("unroll") for (int i = 0; i < 4; ++i) { const int nn = n + 8 * i; const v4u o = *(const LAS v4u*)(wscr + nn * 144 + c * 16); *(v4u*)((DST) + (size_t)(F.wave * 32 + nn) * (KK) + c * 8) = o; } \
            asm volatile("s_waitcnt lgkmcnt(0)" ::: "memory"); } while (0)
            bf16* dA = dst; const int KA = K; const int itb = it + F.G;
            const float* sB = src; bf16* dB = dst; int lB = ldw, KB = K;
            if (itb < NITEMS) { item(itb, sB, dB, lB, KB); load8(vb, sB, lB); }
            P0_FLUSH(va, dA, KA);
            if (itb + F.G < NITEMS) { item(itb + F.G, src, dst, ldw, K); load8(va, src, ldw); }
            if (itb < NITEMS) P0_FLUSH(vb, dB, KB);
#undef P0_FLUSH
        }
    }
    {
        LAS unsigned char* wscr = scr + F.wave * (32 * 144); unsigned char* WIN8 = F.ws + WS_WIN8;
        const int kg = F.lane >> 3, cg = F.lane & 7, c = F.lane & 7, n = F.lane >> 3;
        for (int it = F.vcu; it < 256; it += F.G) { const int nb = it & 15, kk = it >> 4;
            const float* src = F.w_in + (size_t)(kk * 128) * NIN + 6 * DH + NH + nb * 256 + F.wave * 32; unsigned char* dst = WIN8 + (size_t)(nb * 256 + F.wave * 32) * DM + kk * 128;
            f32x4 va[8], vb[8]; conv_load(va, src, NIN, 0, kg, cg); conv_load(vb, src, NIN, 1, kg, cg);
            conv_to_lds(va, wscr, 0, kg, cg); conv_to_lds(vb, wscr, 1, kg, cg);
            asm volatile("s_waitcnt lgkmcnt(0)" ::: "memory");
#pragma unroll
            for (int i = 0; i < 4; ++i) { const int nn = n + 8 * i; const v4u o = *(const LAS v4u*)(wscr + nn * 144 + c * 16); *(v4u*)(dst + (size_t)nn * DM + c * 16) = o; }
            asm volatile("s_waitcnt lgkmcnt(0)" ::: "memory");
        }
    }
    __syncthreads();
    bf16* HN = (bf16*)(F.ws + WS_HN); float* LOGF = (float*)(F.ws + WS_LOGF);
    LAS f32x4* wf4 = (LAS f32x4*)scr;
    for (int i = F.tid; i < DM * 2; i += NWAVES * 64) wf4[i] = *(const f32x4*)(F.w_in + (size_t)(i >> 1) * NIN + 6 * DH + (i & 1) * 4);
    __syncthreads();
    for (int tb = F.vcu; tb < T / 32; tb += F.G) {
        for (int j4 = 0; j4 < 4; ++j4) {
            const int row = tb * 32 + F.wave * 4 + j4;
            LAS f32x4* wfl = wf4; asm volatile("" : "+v"(wfl));
            const f32x4* xr = (const f32x4*)(F.x + (size_t)row * DM) + F.lane; const f32x4* gm = (const f32x4*)F.g_mix + F.lane;
            f32x4 v[8]; float ss = 0.f;
#pragma unroll
            for (int j = 0; j < 8; ++j) { v[j] = xr[64 * j]; ss += (v[j].x * v[j].x + v[j].y * v[j].y) + (v[j].z * v[j].z + v[j].w * v[j].w); }
            const float rstd = 1.0f / sqrtf(wave_sum(ss) * (1.0f / DM) + RMS_EPS);
            float f[8] = {0.f, 0.f, 0.f, 0.f, 0.f, 0.f, 0.f, 0.f};
            v2u* o8 = (v2u*)(HN + (size_t)row * DM) + F.lane; unsigned* o4 = (unsigned*)(F.ws + WS_HN8 + (size_t)row * DM) + F.lane;
#pragma unroll
            for (int j = 0; j < 8; ++j) { const f32x4 h = v[j] * rstd * gm[64 * j];
                v2u w; w.x = pkbf(h.x, h.y); w.y = pkbf(h.z, h.w); o8[64 * j] = w; o4[64 * j] = pg8::pk4_fp8(h.x, h.y, h.z, h.w);
#pragma unroll
                for (int q = 0; q < 4; ++q) { const int k = (F.lane + 64 * j) * 4 + q; const f32x4 w0 = wfl[2 * k], w1 = wfl[2 * k + 1]; const float hq = h[q];
                    f[0] += hq * w0.x; f[1] += hq * w0.y; f[2] += hq * w0.z; f[3] += hq * w0.w; f[4] += hq * w1.x; f[5] += hq * w1.y; f[6] += hq * w1.z; f[7] += hq * w1.w; } }
#pragma unroll
            for (int q = 0; q < 8; ++q) f[q] = wave_sum(f[q]);
            if (F.lane < 8) { float z = F.lane == 0 ? f[0] : F.lane == 1 ? f[1] : F.lane == 2 ? f[2] : F.lane == 3 ? f[3] : F.lane == 4 ? f[4] : F.lane == 5 ? f[5] : F.lane == 6 ? f[6] : f[7];
                z += F.b_forget[F.lane];
                LOGF[(size_t)F.lane * T + row] = fminf(z, 0.f) - log1pf(expf(-fabsf(z))); }
        }
    }
    __syncthreads();
}
constexpr int CONV_BATCHES = NE * 24;
__device__ __forceinline__ void conv_ptrs(const Frame& F, int e, int rb, int j, const float*& src, unsigned char*& dst, int& ldw) {
    if (rb < 16) { const int kk = j, nb = rb; ldw = 2 * DFF;
        src = F.w1 + (size_t)e * DM * 2 * DFF + (size_t)(kk * 128) * (2 * DFF) + nb * 256; dst = F.ws + WS_W1 + (size_t)e * 2 * DFF * DM + (size_t)(nb * 256) * DM + kk * 128; }
    else { const int nb = rb - 16, kk = j; ldw = DM;
        src = F.w2 + (size_t)e * DFF * DM + (size_t)(kk * 128) * DM + nb * 256; dst = F.ws + WS_W2 + (size_t)e * DM * DFF + (size_t)(nb * 256) * DFF + kk * 128; }
}
__device__ __forceinline__ void p2_convert(Frame& F, unsigned* qhead, LAS int* qslot) {
    LAS unsigned char* wscr = F.lds + RING_OFF + F.wave * (32 * 144);
    const int kg = F.lane >> 3, cg = F.lane & 7, c = F.lane & 7, n = F.lane >> 3;
    for (;;) {
        if (F.tid == 0) *qslot = (int)__hip_atomic_fetch_add(qhead, 1u, __ATOMIC_RELAXED, __HIP_MEMORY_SCOPE_AGENT);
        __syncthreads(); const int b = *qslot; __syncthreads();
        if (b >= CONV_BATCHES) break;
        const int e = b / 24, rb = b - e * 24;
        f32x4 va[8], vb[8]; const float* src; unsigned char* dst; int ldw; const int K = rb < 16 ? DM : DFF;
        conv_ptrs(F, e, rb, 0, src, dst, ldw); src += F.wave * 32; conv_load(va, src, ldw, 0, kg, cg);
        for (int j = 0; j < 16; ++j) {
            conv_load(vb, src, ldw, 1, kg, cg);
            conv_to_lds(va, wscr, 0, kg, cg);
            unsigned char* dcur = dst + (size_t)(F.wave * 32) * K;
            if (j + 1 < 16) { conv_ptrs(F, e, rb, j + 1, src, dst, ldw); src += F.wave * 32; conv_load(va, src, ldw, 0, kg, cg); }
            conv_to_lds(vb, wscr, 1, kg, cg);
            asm volatile("s_waitcnt lgkmcnt(0)" ::: "memory");
#pragma unroll
            for (int i = 0; i < 4; ++i) { const int nn = n + 8 * i; const v4u o = *(const LAS v4u*)(wscr + nn * 144 + c * 16); __builtin_nontemporal_store(o, (v4u*)(dcur + (size_t)nn * K + c * 16)); }
            asm volatile("s_waitcnt lgkmcnt(0)" ::: "memory");
        }
    }
}
__device__ __forceinline__ void p5_router(Frame& F) {
    const float* X1 = (const float*)(F.ws + WS_X1); unsigned char* AS = F.ws + WS_AS; int* STOK = (int*)(F.ws + WS_STOK); float* SW = (float*)(F.ws + WS_SW);
    LAS float* red = (LAS float*)(F.lds + RING_OFF);
    LAS float* ssqs = red + 8 * 1024;
    LAS float* lg = ssqs + 8 * 32;
    LAS float* rstdl = lg + 32 * 33;
    LAS float* selw = rstdl + 32;
    LAS int* sele = (LAS int*)(selw + 128);
    LAS int* sellp = sele + 128;
    LAS int* dest = sellp + 128;
    LAS int* lcnt = dest + 128;
    LAS int* gbase = lcnt + 32;
    const int i32 = F.lane & 31, kk = F.lane >> 5;
    for (int tb = F.vcu; tb < T / 32; tb += F.G) {
        const int tok0 = tb * 32;
        {
            f32x16 C = {}; float ssq = 0.f; const int k0 = 256 * F.wave;
            const float* xr = X1 + (size_t)(tok0 + i32) * DM + k0 + 4 * kk;
#pragma unroll 4
            for (int u = 0; u < 32; ++u) { const f32x4 a = *(const f32x4*)(xr + 8 * u); ssq += (a.x * a.x + a.y * a.y) + (a.z * a.z + a.w * a.w);
#pragma unroll
                for (int v = 0; v < 4; ++v) { const int k = k0 + 8 * u + 4 * kk + v; const float b = F.w_router[(size_t)k * NE + i32] * F.g_ffn[k];
                    C = __builtin_amdgcn_mfma_f32_32x32x2f32(a[v], b, C, 0, 0, 0); } }
#pragma unroll
            for (int r = 0; r < 16; ++r) red[F.wave * 1024 + ((r & 3) + 8 * (r >> 2) + 4 * kk) * 32 + i32] = C[r];
            ssq += __shfl_xor(ssq, 32);
            if (kk == 0) ssqs[F.wave * 32 + i32] = ssq;
        }
        __syncthreads();
        for (int idx = F.tid; idx < 1024; idx += NWAVES * 64) { const int tk = idx >> 5, e = idx & 31; float s = 0.f, q = 0.f;
#pragma unroll
            for (int w = 0; w < 8; ++w) { s += red[w * 1024 + idx]; q += ssqs[w * 32 + tk]; }
            const float rstd = 1.0f / sqrtf(q * (1.0f / DM) + RMS_EPS);
            lg[tk * 33 + e] = s * rstd + F.b_router[e]; if (e == 0) rstdl[tk] = rstd; }
        if (F.tid < 32) lcnt[F.tid] = 0;
        __syncthreads();
        if (F.tid < 32) {
            float tv[4]; int te[4];
#pragma unroll
            for (int k = 0; k < 4; ++k) { float best = -__builtin_inff(); int bi = 0;
                for (int e = 0; e < NE; ++e) { const float v = lg[F.tid * 33 + e]; if (v > best) { best = v; bi = e; } }
                tv[k] = best; te[k] = bi; lg[F.tid * 33 + bi] = -__builtin_inff(); }
            float ew[4], sum = 0.f;
#pragma unroll
            for (int k = 0; k < 4; ++k) { ew[k] = expf(tv[k] - tv[0]); sum += ew[k]; }
            const float inv = 1.0f / sum;
#pragma unroll
            for (int k = 0; k < 4; ++k) { sele[F.tid * 4 + k] = te[k]; selw[F.tid * 4 + k] = ew[k] * inv; sellp[F.tid * 4 + k] = atomicAdd((int*)(lcnt + te[k]), 1); }
        }
        __syncthreads();
        if (F.tid < 32) { const int n = lcnt[F.tid]; gbase[F.tid] = n > 0 ? (int)__hip_atomic_fetch_add((unsigned*)(F.ctl + CW_CNT + 64 * F.tid), (unsigned)n, __ATOMIC_RELAXED, __HIP_MEMORY_SCOPE_AGENT) : 0; }
        __syncthreads();
        if (F.tid < 128) { const int e = sele[F.tid]; int pos = gbase[e] + sellp[F.tid]; if (pos >= CAP) pos = CAP - 1; const int row = e * CAP + pos;
            STOK[(tok0 + (F.tid >> 2)) * 4 + (F.tid & 3)] = row; SW[row] = selw[F.tid]; dest[F.tid] = row; }
        __syncthreads();
        for (int j4 = 0; j4 < 4; ++j4) {
            const int ti = F.wave * 4 + j4; const float rstd = rstdl[ti];
            const f32x4* xr = (const f32x4*)(X1 + (size_t)(tok0 + ti) * DM) + F.lane; const f32x4* gm = (const f32x4*)F.g_ffn + F.lane;
            unsigned w[8];
#pragma unroll
            for (int j = 0; j < 8; ++j) { const f32x4 h = xr[64 * j] * rstd * gm[64 * j]; w[j] = pg8::pk4_fp8(h.x, h.y, h.z, h.w); }
#pragma unroll
            for (int k = 0; k < 4; ++k) { unsigned* o4 = (unsigned*)(AS + (size_t)dest[ti * 4 + k] * DM) + F.lane;
#pragma unroll
                for (int j = 0; j < 8; ++j) o4[64 * j] = w[j]; }
        }
        __syncthreads();
    }
}
__device__ __forceinline__ void p8_final(Frame& F) {
    const float* X1 = (const float*)(F.ws + WS_X1); const bf16* Y = (const bf16*)(F.ws + WS_Y); const int* TSLOT = (const int*)(F.ws + WS_STOK);
    const int gw = F.vcu * NWAVES + F.wave, NGW = F.G * NWAVES;
    for (int row = gw; row < T; row += NGW) {
        const f32x4* xr = (const f32x4*)(X1 + (size_t)row * DM) + F.lane; const f32x4* gf = (const f32x4*)F.g_final + F.lane;
        const int sl = (int)__hip_atomic_load((const unsigned*)TSLOT + row * 4 + (F.lane & 3), __ATOMIC_RELAXED, __HIP_MEMORY_SCOPE_AGENT);
        int slot[4];
#pragma unroll
        for (int k = 0; k < 4; ++k) slot[k] = __shfl(sl, k);
        f32x4 v[8]; float ss = 0.f;
#pragma unroll
        for (int j = 0; j < 8; ++j) { v[j] = xr[64 * j];
#pragma unroll
            for (int k = 0; k < 4; ++k) { const v2u y = ((const v2u*)(Y + (size_t)slot[k] * DM) + F.lane)[64 * j];
                v[j].x += pg8::bf_lo(y.x); v[j].y += pg8::bf_hi(y.x); v[j].z += pg8::bf_lo(y.y); v[j].w += pg8::bf_hi(y.y); }
            ss += (v[j].x * v[j].x + v[j].y * v[j].y) + (v[j].z * v[j].z + v[j].w * v[j].w); }
        const float rstd = 1.0f / sqrtf(wave_sum(ss) * (1.0f / DM) + RMS_EPS);
        f32x4* o = (f32x4*)(F.out + (size_t)row * DM) + F.lane;
#pragma unroll
        for (int j = 0; j < 8; ++j) o[64 * j] = v[j] * rstd * gf[64 * j];
    }
}

struct Args { const float* in[16]; float* out; unsigned char* ws; int ph_lo, ph_hi; };
__global__ void __launch_bounds__(NWAVES * 64, 2) mk_fwd(Args args) {
    extern __shared__ __attribute__((aligned(16))) unsigned char lds[];
    Frame F;
    F.lds = (LAS unsigned char*)lds;
    F.MISC = (volatile LAS unsigned*)(F.lds + MISC_OFF);
    F.tid = threadIdx.x; F.lane = F.tid & 63; F.wave = __builtin_amdgcn_readfirstlane(F.tid >> 6);
    F.G = gridDim.x; { const int bx = blockIdx.x; F.vcu = (F.G % 8 == 0) ? (bx % 8) * (F.G / 8) + bx / 8 : bx; }
    unsigned char* ws = args.ws; F.ws = ws; F.out = args.out;
    F.ctl = (gu32*)(ws + WS_CTL);
    F.x = args.in[0]; F.g_mix = args.in[1]; F.w_in = args.in[2]; F.b_forget = args.in[3]; F.b_gate = args.in[4]; F.w_psb = args.in[5]; F.w_pfx = args.in[6]; F.w_out = args.in[7];
    F.g_ffn = args.in[8]; F.w_router = args.in[9]; F.b_router = args.in[10]; F.w1 = args.in[11]; F.b1 = args.in[12]; F.w2 = args.in[13]; F.b2 = args.in[14]; F.g_final = args.in[15];
    for (int u = F.tid; u < (LDS_BYTES - LDSCTL_OFF) / 4; u += NWAVES * 64) ((LAS unsigned*)(F.lds + LDSCTL_OFF))[u] = 0u;
    __syncthreads();
    XcdBarrier bar; bar.bar = (unsigned*)(F.ctl + CW_BAR); bar.x = 0; bar.st = nullptr;
    if (N_LAUNCHES != PER_PHASE) bar = xcd_barrier_post((unsigned*)(F.ctl + CW_BAR), F.MISC + 8);
#define GRID_BAR(seam) do { if (N_LAUNCHES == PER_PHASE) { if (F.tid == 0) __hip_atomic_store(F.ctl + CW_TMO, 0xBADBA0u | (unsigned)(seam), RLX_AGENT); } else { xcd_barrier(bar); } } while (0)
    const int lo = args.ph_lo, hi = args.ph_hi;
#define IN(k) (lo <= (k) && (k) < hi)
#define BOTH(k) (IN(k) && IN((k) + 1))
    bf16* HN = (bf16*)(ws + WS_HN); bf16* QKV = (bf16*)(ws + WS_QKV); bf16* GATES = (bf16*)(ws + WS_GATES);
    bf16* OSB = (bf16*)(ws + WS_OSB); bf16* OFX = (bf16*)(ws + WS_OFX); bf16* MIXED = (bf16*)(ws + WS_MIXED);
    float* PART = (float*)(ws + WS_PART); float* X1 = (float*)(ws + WS_X1);
    unsigned char* AS = ws + WS_AS; unsigned char* HB = ws + WS_H; bf16* YB = (bf16*)(ws + WS_Y);

    if (IN(0)) { p0_prologue(F); if (BOTH(0)) GRID_BAR(0); }

    if (IN(1)) {
        { pg8::TileOrder S; S.init(HN, ws + WS_WIN, T, 6 * DH, DM, F.G, (int)blockIdx.x);
          pg8::EpiP1 E{QKV, QKV_STRIDE / 2, (unsigned*)(F.ctl + CW_KM)};
          pg8::gemm_phase<pg8::EpiP1, pg8::TileOrder, true, true>(F.lds + RING_OFF, DM, S, E); }
        { pg8::TileOrder S; S.init(ws + WS_HN8, ws + WS_WIN8, T, 2 * DM, DM, F.G, (int)blockIdx.x, 1);
          pg8::EpiGates E{GATES, F.b_gate};
          pg8::gemm_phase<pg8::EpiGates, pg8::TileOrder, true, true, 1>(F.lds + RING_OFF, DM, S, E); }
        if (BOTH(1)) GRID_BAR(1);
    }

    if (IN(2)) {
        const float* LOGFall = (const float*)(ws + WS_LOGF);
        const int hq = (int)blockIdx.x & 7;
        att::ALAS_char_ptr alds = (att::ALAS_char_ptr)(F.lds + RING_OFF);
        LAS int* qslot = (LAS int*)(F.lds + RING_OFF + att::OFF_FLAG + 64);
        float* PARTF = (float*)(ws + WS_PART);
        const bool conv_first = (((int)blockIdx.x >> 3) & 7) < CONV_FIRST_OF8;
        if (conv_first) p2_convert(F, (unsigned*)(F.ctl + CW_QC), qslot);
#define P2_PULL(cw, limit) do { if (F.wave == 0) { int c_ = (limit); if (F.lane < 8) c_ = (int)__hip_atomic_load((const unsigned*)(F.ctl + (cw) + 64 * F.lane), __ATOMIC_RELAXED, __HIP_MEMORY_SCOPE_AGENT); \
            int bh_ = -1, bc_ = (limit); _Pragma("unroll") for (int j_ = 0; j_ < 8; ++j_) { const int cj_ = __shfl(c_, j_); if (cj_ < bc_) { bc_ = cj_; bh_ = j_; } } \
            { const int own_ = __shfl(c_, hq); if (own_ < (limit)) bh_ = hq; } \
            if (F.lane == 0) { int it_ = (limit); if (bh_ >= 0) it_ = (int)__hip_atomic_fetch_add((unsigned*)(F.ctl + (cw) + 64 * bh_), 1u, __ATOMIC_RELAXED, __HIP_MEMORY_SCOPE_AGENT); qslot[0] = bh_; qslot[1] = it_; } } \
        __syncthreads(); } while (0)
        for (;;) {
            P2_PULL(CW_QF, 48);
            const int h = qslot[0], it = qslot[1]; __syncthreads();
            if (h < 0) break;
            if (it >= 48) continue;
            int qb, mode;
            if (it < 16) { qb = 31 - it; mode = 1; }
            else { const int k = it - 16; if (k < 24) { const int g = k / 3, j = k - 3 * g; qb = j == 0 ? 15 - g : 31 - 2 * g - (j - 1); } else qb = 31 - k; mode = qb >= 16 ? 2 : 0; }
            const int NT = 4 * (qb + 1), t0 = mode == 1 ? NT / 2 : 0, t1 = mode == 2 ? NT / 2 : NT;
            const int slot = h * 16 + (qb & 15);
            att::fox_unit(QKV + 3 * (QKV_STRIDE / 2) + h * HD, QKV + 4 * (QKV_STRIDE / 2) + h * HD, QKV + 5 * (QKV_STRIDE / 2) + h * HD, OFX + h * HD, LOGFall + (size_t)h * T, qb, t0, t1, mode,
                          PARTF + (size_t)slot * (att::QB * att::D + 2 * att::QB), (unsigned*)(F.ctl + CW_FLAG + 64 * slot), (unsigned*)(F.ctl + CW_TMO), (const unsigned*)(F.ctl + CW_KM + 4 * h), alds);
        }
        for (;;) {
            P2_PULL(CW_QS, 32);
            const int h = qslot[0], it = qslot[1]; __syncthreads();
            if (h < 0) break;
            if (it >= 32) continue;
            att::sb_unit(QKV + 0 * (QKV_STRIDE / 2) + h * HD, QKV + 1 * (QKV_STRIDE / 2) + h * HD, QKV + 2 * (QKV_STRIDE / 2) + h * HD, OSB + h * HD, 31 - it, alds);
        }
#undef P2_PULL
        if (!conv_first) p2_convert(F, (unsigned*)(F.ctl + CW_QC), qslot);
        if (BOTH(2)) GRID_BAR(2);
    }

    if (IN(3)) {
        pg8::MixOrder S; S.t.init(OSB, ws + WS_WPA, T, DM, DH, F.G, (int)blockIdx.x); S.A1 = (const char*)OFX; S.B1 = (const char*)(ws + WS_WPB);
        pg8::EpiMix E{GATES, PART, MIXED};
        pg8::gemm_phase<pg8::EpiMix, pg8::MixOrder, false, true>(F.lds + RING_OFF, DH, S, E);
        if (BOTH(3)) GRID_BAR(3);
    }

    if (IN(4)) {
        pg8::TileOrder S; S.init(MIXED, ws + WS_WOUT, T, DM, DM, F.G, (int)blockIdx.x);
        pg8::EpiResid E{F.x, X1};
        pg8::gemm_phase<pg8::EpiResid, pg8::TileOrder, false, true>(F.lds + RING_OFF, DM, S, E);
        if (BOTH(4)) GRID_BAR(4);
    }

    if (IN(5)) { p5_router(F); if (BOTH(5)) GRID_BAR(5); }

    if (IN(6) || IN(7)) {
        LAS int* cntl = (LAS int*)(F.lds + TAB_OFF); LAS int* pref = cntl + 32;
        if (F.tid < 32) { int n = (int)__hip_atomic_load(F.ctl + CW_CNT + 64 * F.tid, RLX_AGENT); cntl[F.tid] = n > CAP ? CAP : n; }
        __syncthreads();
        if (F.tid == 0) { int p = 0; for (int e = 0; e < NE; ++e) { pref[e] = p; p += (cntl[e] + 255) >> 8; } pref[NE] = p; }
        __syncthreads();
        if (IN(6)) {
            pg8::MoeOrder S{(const char*)AS, (const char*)(ws + WS_W1), (const PG8_LAS int*)pref, (size_t)CAP * DM, (size_t)2 * DFF * DM, (size_t)256 * DM, (2 * DFF) / 256, CAP / 256, F.G, F.vcu};
            pg8::EpiSwiglu E{F.b1, HB};
            pg8::gemm_phase<pg8::EpiSwiglu, pg8::MoeOrder, true, true, 1>(F.lds + RING_OFF, DM, S, E);
            if (BOTH(6)) GRID_BAR(6);
        }
        if (IN(7)) {
            pg8::MoeOrder S{(const char*)HB, (const char*)(ws + WS_W2), (const PG8_LAS int*)pref, (size_t)CAP * DFF, (size_t)DM * DFF, (size_t)256 * DFF, DM / 256, CAP / 256, F.G, F.vcu};
            pg8::EpiMoeOut E{F.b2, (const float*)(ws + WS_SW), YB};
            pg8::gemm_phase<pg8::EpiMoeOut, pg8::MoeOrder, true, true, 1>(F.lds + RING_OFF, DFF, S, E);
            if (BOTH(7)) GRID_BAR(7);
        }
    }

    if (IN(8)) p8_final(F);
#undef IN
#undef BOTH
}

extern "C" void kernel_launch(void* const* d_in, const int* in_sizes, int n_in, void* d_out, int out_size, void* d_ws, size_t ws_size, hipStream_t stream) {
    static int grid = 0;
    if (grid == 0) {
        if (n_in != 16 || in_sizes[0] != T * DM || out_size != T * DM || ws_size < WS_END) { fprintf(stderr, "kernel_launch: built for 16 inputs, x/out of %d floats, >= %zu bytes of workspace; got n_in %d, in0 %d, out %d, ws %zu; nothing launched\n", T * DM, (size_t)WS_END, n_in, n_in > 0 ? in_sizes[0] : -1, out_size, ws_size); grid = -1; return; }
        int dev = 0, cus = 0, per_cu = 0;
        if (hipGetDevice(&dev) != hipSuccess || hipDeviceGetAttribute(&cus, hipDeviceAttributeMultiprocessorCount, dev) != hipSuccess) { fprintf(stderr, "kernel_launch: hipGetDevice / hipDeviceGetAttribute failed\n"); grid = -1; return; }
        if (hipFuncSetAttribute((const void*)mk_fwd, hipFuncAttributeMaxDynamicSharedMemorySize, LDS_BYTES) != hipSuccess) { fprintf(stderr, "kernel_launch: hipFuncSetAttribute failed\n"); grid = -1; return; }
        if (hipOccupancyMaxActiveBlocksPerMultiprocessor(&per_cu, (const void*)mk_fwd, NWAVES * 64, LDS_BYTES) != hipSuccess || per_cu < 1)
            fprintf(stderr, "kernel_launch: note: the occupancy query reports %d workgroups per CU\n", per_cu);
        (void)hipGetLastError();
        grid = cus;
    }
    if (grid < 0) return;
    if (hipMemsetAsync((char*)d_ws + WS_CTL, 0, CTL_ZERO_BYTES, stream) != hipSuccess) { fprintf(stderr, "kernel_launch: hipMemsetAsync failed\n"); return; }
    Args a{};
    for (int i = 0; i < 16; ++i) a.in[i] = (const float*)d_in[i];
    a.out = (float*)d_out; a.ws = (unsigned char*)d_ws;
    if (N_LAUNCHES == 1) { a.ph_lo = 0; a.ph_hi = PER_PHASE; hipLaunchKernelGGL(mk_fwd, dim3(grid), dim3(NWAVES * 64), LDS_BYTES, stream, a); }
    else for (int li = 0; li < PER_PHASE; ++li) { a.ph_lo = li; a.ph_hi = li + 1; hipLaunchKernelGGL(mk_fwd, dim3(grid), dim3(NWAVES * 64), LDS_BYTES, stream, a); }
    const hipError_t le = hipPeekAtLastError();
    if (le != hipSuccess) fprintf(stderr, "kernel_launch: launch failed: %s (grid %d)\n", hipGetErrorName(le), grid);
}
```

```cpp
#include <hip/hip_runtime.h>
#include <hip/hip_bf16.h>
#include <cstdio>
#include <cstdint>

#ifndef CONV_FIRST_OF8
#define CONV_FIRST_OF8 5
#endif
#ifndef MK_N_LAUNCHES
#define MK_N_LAUNCHES 1
#endif

namespace pg8 {
#define PG8_LAS __attribute__((address_space(3)))
typedef unsigned short bf16_t;
typedef short bf16x8 __attribute__((ext_vector_type(8)));
typedef float f32x4 __attribute__((ext_vector_type(4)));
typedef unsigned u32x4 __attribute__((ext_vector_type(4)));
typedef unsigned u32x2 __attribute__((ext_vector_type(2)));
constexpr int BM = 256, BK = 64, HALF = 128, HTB = HALF * BK * 2  , STAGE_BYTES = 8 * HTB, NXCD = 8, WGM = 8;

__host__ __device__ __forceinline__ int lds_byte(int r, int c) { const int st = (r >> 4) * 2 + (c >> 5), rr = r & 15, cc = c & 31, ob = rr * 64 + cc * 2; return st * 1024 + (ob ^ (((ob >> 9) & 1) << 5)); }
__host__ __device__ __forceinline__ void stage_rc(int b, int& R, int& C) { const int st = b / 1024, sb = b % 1024, swz = sb ^ (((sb >> 9) & 1) << 5); R = (st >> 1) * 16 + swz / 64; C = (st & 1) * 32 + (swz % 64) / 2; }
__host__ __device__ __forceinline__ int perm32(int rho) { const int n = rho >> 4, i = rho & 15; return 8 * (i >> 2) + 4 * n + (i & 3); }

struct Unit { const char* a; const char* b; int pm, pn, aux; };

typedef float f32x2_c __attribute__((ext_vector_type(2))); typedef __bf16 bf16x2_c __attribute__((ext_vector_type(2)));
__device__ __forceinline__ unsigned cvt_pk_bf16(float lo, float hi) { const f32x2_c v = {lo, hi}; const bf16x2_c b = __builtin_convertvector(v, bf16x2_c); return __builtin_bit_cast(unsigned, b); }
__device__ __forceinline__ unsigned pk4_fp8(float a, float b, float c, float d) { unsigned w = 0u; w = (unsigned)__builtin_amdgcn_cvt_pk_fp8_f32(a, b, (int)w, false); w = (unsigned)__builtin_amdgcn_cvt_pk_fp8_f32(c, d, (int)w, true); return w; }
constexpr float W8_SCALE = 64.0f, W8_INV = 1.0f / 64.0f;
__device__ __forceinline__ float bf_lo(unsigned u) { return __uint_as_float(u << 16); }
__device__ __forceinline__ float bf_hi(unsigned u) { return __uint_as_float(u & 0xffff0000u); }
__device__ __forceinline__ float sigmoidf_fast(float x) { return __builtin_amdgcn_rcpf(1.0f + __builtin_amdgcn_exp2f(-1.4426950408889634f * x)); }

struct TileOrder {
    const char* A; const char* Bt; size_t tstepA, tstepB; int nM, nN, nwg, G, c;
    __device__ __forceinline__ void init(const void* A_, const void* Bt_, int M, int N, int K, int G_, int c_, int esz = 2) { A = (const char*)A_; Bt = (const char*)Bt_; tstepA = (size_t)BM * K * esz; tstepB = tstepA; nM = M / BM; nN = N / BM; nwg = nM * nN; G = G_; c = c_; }
    __device__ __forceinline__ bool map(int L, int& pm, int& pn) const {
        if (L >= nwg) return false;
        int wgid = L; { const int q = nwg / NXCD, r = nwg % NXCD, xcd = wgid % NXCD, off = wgid / NXCD; wgid = (xcd < r ? xcd * (q + 1) : r * (q + 1) + (xcd - r) * q) + off; }
        const int nig = WGM * nN, gid = wgid / nig, fm = gid * WGM, gsz = (nM - fm) < WGM ? (nM - fm) : WGM;
        pm = fm + ((wgid % nig) % gsz); pn = (wgid % nig) / gsz; return true;
    }
    __device__ __forceinline__ bool next(int i, Unit& u) const {
        int pm, pn; if (!map(i * G + c, pm, pn)) return false;
        u.pm = pm; u.pn = pn; u.aux = 0; u.a = A + (size_t)pm * tstepA; u.b = Bt + (size_t)pn * tstepB; return true;
    }
    __device__ __forceinline__ void a_ready(const Unit&) const {}
    __device__ __forceinline__ void done(const Unit&) const {}
};
struct MixOrder {
    TileOrder t; const char* A1; const char* B1;
    __device__ __forceinline__ bool next(int i, Unit& u) const {
        int pm, pn; if (!t.map((i >> 1) * t.G + t.c, pm, pn)) return false;
        u.pm = pm; u.pn = pn; u.aux = i & 1;
        u.a = ((i & 1) ? A1 : t.A) + (size_t)pm * t.tstepA; u.b = ((i & 1) ? B1 : t.Bt) + (size_t)pn * t.tstepB; return true;
    }
    __device__ __forceinline__ void a_ready(const Unit&) const {}
    __device__ __forceinline__ void done(const Unit&) const {}
};
struct MoeOrder {
    const char* A; const char* Bt; const PG8_LAS int* pref;
    size_t a_estride, b_estride, tstep; int NT, cap_tiles, G, c;
    __device__ __forceinline__ bool next(int i, Unit& u) const {
        const int L = i * G + c; const int total = pref[32] * NT; if (L >= total) return false;
        int e = 0;
#pragma unroll 1
        for (int j = 1; j < 32; ++j) if (pref[j] * NT <= L) e = j;
        const int me = pref[e + 1] - pref[e], q = L - pref[e] * NT, nt = q / me, mt = q - nt * me;
        u.aux = e; u.pm = e * cap_tiles + mt; u.pn = nt;
        u.a = A + (size_t)e * a_estride + (size_t)mt * tstep; u.b = Bt + (size_t)e * b_estride + (size_t)nt * tstep; return true;
    }
    __device__ __forceinline__ void a_ready(const Unit&) const {}
    __device__ __forceinline__ void done(const Unit&) const {}
};

struct EpiP1 {
    static constexpr bool PERM = true, AFTER_DRAIN = false;
    bf16_t* qkv; size_t buf_stride; unsigned* km;
    __device__ __forceinline__ void operator()(const f32x4 (&acc)[2][2][4][2], const Unit& u, int wr, int wc, int fr, int fq) const {
        const int row0 = u.pm * BM + wr * 64 + fr;
        {
            bf16_t* base = qkv + (size_t)(u.pn >> 2) * buf_stride; const int col0 = (u.pn & 3) * BM + wc * 32 + 8 * fq;
            const bool kfx = u.pn >= 16 && u.pn < 20;
            float mx[2] = {0.f, 0.f};
#pragma unroll
            for (int ai = 0; ai < 2; ++ai)
#pragma unroll
                for (int m = 0; m < 4; ++m) { bf16_t* rowp = base + (size_t)(row0 + ai * HALF + m * 16) * 1024 + col0;
#pragma unroll
                    for (int bj = 0; bj < 2; ++bj) { const f32x4 v0 = acc[ai][bj][m][0], v1 = acc[ai][bj][m][1];
                        u32x4 w; w.x = cvt_pk_bf16(v0[0], v0[1]); w.y = cvt_pk_bf16(v0[2], v0[3]); w.z = cvt_pk_bf16(v1[0], v1[1]); w.w = cvt_pk_bf16(v1[2], v1[3]);
                        *(u32x4*)(rowp + bj * HALF) = w;
                        if (kfx) { float q = bf_lo(w.x) * bf_lo(w.x) + bf_hi(w.x) * bf_hi(w.x) + bf_lo(w.y) * bf_lo(w.y) + bf_hi(w.y) * bf_hi(w.y)
                                           + bf_lo(w.z) * bf_lo(w.z) + bf_hi(w.z) * bf_hi(w.z) + bf_lo(w.w) * bf_lo(w.w) + bf_hi(w.w) * bf_hi(w.w);
                            q += __shfl_xor(q, 16); q += __shfl_xor(q, 32); mx[bj] = fmaxf(mx[bj], q); } } }
            if (kfx) {
#pragma unroll
                for (int bj = 0; bj < 2; ++bj) { float q = mx[bj];
#pragma unroll
                    for (int o = 1; o < 16; o <<= 1) q = fmaxf(q, __shfl_xor(q, o));
                    if (fr == 0 && fq == 0) __hip_atomic_fetch_max(km + (2 * (u.pn - 16) + bj) * 4 + wc, __float_as_uint(q), __ATOMIC_RELAXED, __HIP_MEMORY_SCOPE_AGENT); } }
        }
    }
};
struct EpiGates {
    static constexpr bool PERM = true, AFTER_DRAIN = false;
    bf16_t* gates; const float* b_gate;
    __device__ __forceinline__ void operator()(const f32x4 (&acc)[2][2][4][2], const Unit& u, int wr, int wc, int fr, int fq) const {
        const int row0 = u.pm * BM + wr * 64 + fr, gc0 = u.pn * BM + wc * 32 + 8 * fq;
        f32x4 bv[2][2];
#pragma unroll
        for (int bj = 0; bj < 2; ++bj)
#pragma unroll
            for (int n = 0; n < 2; ++n) bv[bj][n] = *(const f32x4*)(b_gate + gc0 + bj * HALF + 4 * n);
#pragma unroll
        for (int ai = 0; ai < 2; ++ai)
#pragma unroll
            for (int m = 0; m < 4; ++m) { bf16_t* rowp = gates + (size_t)(row0 + ai * HALF + m * 16) * 4096 + gc0;
#pragma unroll
                for (int bj = 0; bj < 2; ++bj) { f32x4 v0 = acc[ai][bj][m][0] * W8_INV + bv[bj][0], v1 = acc[ai][bj][m][1] * W8_INV + bv[bj][1];
#pragma unroll
                    for (int q = 0; q < 4; ++q) { v0[q] = sigmoidf_fast(v0[q]); v1[q] = sigmoidf_fast(v1[q]); }
                    u32x4 w; w.x = cvt_pk_bf16(v0[0], v0[1]); w.y = cvt_pk_bf16(v0[2], v0[3]); w.z = cvt_pk_bf16(v1[0], v1[1]); w.w = cvt_pk_bf16(v1[2], v1[3]);
                    *(u32x4*)(rowp + bj * HALF) = w; } }
    }
};
struct EpiMix {
    static constexpr bool PERM = true, AFTER_DRAIN = false;
    const bf16_t* gates; float* part; bf16_t* mixed;
    __device__ __forceinline__ void operator()(const f32x4 (&acc)[2][2][4][2], const Unit& u, int wr, int wc, int fr, int fq) const {
        const int row0 = u.pm * BM + wr * 64 + fr, col0 = u.pn * BM + wc * 32 + 8 * fq; const int goff = u.aux ? 2048 : 0;
#pragma unroll
        for (int ai = 0; ai < 2; ++ai) {
            u32x4 g[4][2];
#pragma unroll
            for (int m = 0; m < 4; ++m)
#pragma unroll
                for (int bj = 0; bj < 2; ++bj) g[m][bj] = *(const u32x4*)(gates + (size_t)(row0 + ai * HALF + m * 16) * 4096 + goff + col0 + bj * HALF);
#pragma unroll
            for (int mp = 0; mp < 2; ++mp) {
                f32x4 p0[2][2], p1[2][2];
                if (u.aux) {
#pragma unroll
                    for (int mm = 0; mm < 2; ++mm)
#pragma unroll
                        for (int bj = 0; bj < 2; ++bj) { const float* pp = part + (size_t)(row0 + ai * HALF + (2 * mp + mm) * 16) * 2048 + col0 + bj * HALF;
                            p0[mm][bj] = *(const f32x4*)pp; p1[mm][bj] = *(const f32x4*)(pp + 4); } }
                asm volatile("" ::: "memory");
#pragma unroll
                for (int mm = 0; mm < 2; ++mm)
#pragma unroll
                    for (int bj = 0; bj < 2; ++bj) { const int m = 2 * mp + mm; const size_t row = (size_t)(row0 + ai * HALF + m * 16); const int c = col0 + bj * HALF;
                        const u32x4 gg = g[m][bj]; const f32x4 a0 = acc[ai][bj][m][0], a1 = acc[ai][bj][m][1];
                        f32x4 r0 = {bf_lo(gg.x) * a0[0], bf_hi(gg.x) * a0[1], bf_lo(gg.y) * a0[2], bf_hi(gg.y) * a0[3]};
                        f32x4 r1 = {bf_lo(gg.z) * a1[0], bf_hi(gg.z) * a1[1], bf_lo(gg.w) * a1[2], bf_hi(gg.w) * a1[3]};
                        float* pp = part + row * 2048 + c;
                        if (u.aux == 0) { *(f32x4*)pp = r0; *(f32x4*)(pp + 4) = r1; }
                        else { r0 += p0[mm][bj]; r1 += p1[mm][bj];
                            u32x4 w; w.x = cvt_pk_bf16(r0[0], r0[1]); w.y = cvt_pk_bf16(r0[2], r0[3]); w.z = cvt_pk_bf16(r1[0], r1[1]); w.w = cvt_pk_bf16(r1[2], r1[3]);
                            *(u32x4*)(mixed + row * 2048 + c) = w; } }
                asm volatile("" ::: "memory");
            }
        }
    }
};
struct EpiResid {
    static constexpr bool PERM = false, AFTER_DRAIN = false;
    const float* x; float* x1;
    __device__ __forceinline__ void operator()(const f32x4 (&acc)[2][2][4][2], const Unit& u, int wr, int wc, int fr, int fq) const {
        const int row0 = u.pm * BM + wr * 64 + fr, col0 = u.pn * BM + wc * 32 + 4 * fq;
#pragma unroll
        for (int ai = 0; ai < 2; ++ai) {
            f32x4 xv[4][2][2];
#pragma unroll
            for (int m = 0; m < 4; ++m) { const size_t off = (size_t)(row0 + ai * HALF + m * 16) * 2048 + col0;
#pragma unroll
                for (int bj = 0; bj < 2; ++bj)
#pragma unroll
                    for (int n = 0; n < 2; ++n) xv[m][bj][n] = *(const f32x4*)(x + off + bj * HALF + n * 16); }
            asm volatile("" ::: "memory");
#pragma unroll
            for (int m = 0; m < 4; ++m) { const size_t off = (size_t)(row0 + ai * HALF + m * 16) * 2048 + col0;
#pragma unroll
                for (int bj = 0; bj < 2; ++bj)
#pragma unroll
                    for (int n = 0; n < 2; ++n) *(f32x4*)(x1 + off + bj * HALF + n * 16) = xv[m][bj][n] + acc[ai][bj][m][n]; }
            asm volatile("" ::: "memory");
        }
    }
};
__device__ __forceinline__ float swiglu1(float g, float l) {
    g = fminf(g, 7.0f); l = fminf(fmaxf(l, -7.0f), 7.0f);
    return g * sigmoidf_fast(1.702f * g) * (l + 1.0f);
}
struct EpiSwiglu {
    static constexpr bool PERM = true, AFTER_DRAIN = false;
    const float* b1; unsigned char* H;
    __device__ __forceinline__ void operator()(const f32x4 (&acc)[2][2][4][2], const Unit& u, int wr, int wc, int fr, int fq) const {
        const int row0 = u.pm * BM + wr * 64 + fr, c0 = u.pn * BM + wc * 32 + 8 * fq; const float* be = b1 + (size_t)u.aux * 4096 + c0;
        f32x4 bv[2][2];
#pragma unroll
        for (int bj = 0; bj < 2; ++bj)
#pragma unroll
            for (int n = 0; n < 2; ++n) bv[bj][n] = *(const f32x4*)(be + bj * HALF + 4 * n);
#pragma unroll
        for (int ai = 0; ai < 2; ++ai)
#pragma unroll
            for (int m = 0; m < 4; ++m) { unsigned char* rowp = H + (size_t)(row0 + ai * HALF + m * 16) * 2048 + (c0 >> 1);
#pragma unroll
                for (int bj = 0; bj < 2; ++bj) { const f32x4 v0 = acc[ai][bj][m][0] * W8_INV + bv[bj][0], v1 = acc[ai][bj][m][1] * W8_INV + bv[bj][1];
                    *(unsigned*)(rowp + bj * (HALF / 2)) = pk4_fp8(swiglu1(v0[0], v0[1]), swiglu1(v0[2], v0[3]), swiglu1(v1[0], v1[1]), swiglu1(v1[2], v1[3])); } }
    }
};
struct EpiMoeOut {
    static constexpr bool PERM = true, AFTER_DRAIN = false;
    const float* b2; const float* slot_w; bf16_t* Y;
    __device__ __forceinline__ void operator()(const f32x4 (&acc)[2][2][4][2], const Unit& u, int wr, int wc, int fr, int fq) const {
        const int e = u.aux, row0 = u.pm * BM + wr * 64 + fr, c0 = u.pn * BM + wc * 32 + 8 * fq; const float* be = b2 + (size_t)e * 2048 + c0;
        f32x4 bv[2][2];
#pragma unroll
        for (int bj = 0; bj < 2; ++bj)
#pragma unroll
            for (int n = 0; n < 2; ++n) bv[bj][n] = *(const f32x4*)(be + bj * HALF + 4 * n);
        float wrow[2][4];
#pragma unroll
        for (int ai = 0; ai < 2; ++ai)
#pragma unroll
            for (int m = 0; m < 4; ++m) wrow[ai][m] = slot_w[row0 + ai * HALF + m * 16];
        asm volatile("" ::: "memory");
#pragma unroll
        for (int ai = 0; ai < 2; ++ai)
#pragma unroll
            for (int m = 0; m < 4; ++m) { const int row = row0 + ai * HALF + m * 16;
                const float w8 = wrow[ai][m]; bf16_t* rowp = Y + (size_t)row * 2048 + c0;
#pragma unroll
                for (int bj = 0; bj < 2; ++bj) { const f32x4 v0 = (acc[ai][bj][m][0] * W8_INV + bv[bj][0]) * w8, v1 = (acc[ai][bj][m][1] * W8_INV + bv[bj][1]) * w8;
                    u32x4 w; w.x = cvt_pk_bf16(v0[0], v0[1]); w.y = cvt_pk_bf16(v0[2], v0[3]); w.z = cvt_pk_bf16(v1[0], v1[1]); w.w = cvt_pk_bf16(v1[2], v1[3]);
                    *(u32x4*)(rowp + bj * HALF) = w; } }
    }
};

typedef int i32x4 __attribute__((ext_vector_type(4)));
typedef int i32x8 __attribute__((ext_vector_type(8)));
__device__ __forceinline__ i32x8 cat8(bf16x8 lo, bf16x8 hi) { return __builtin_shufflevector(__builtin_bit_cast(i32x4, lo), __builtin_bit_cast(i32x4, hi), 0, 1, 2, 3, 4, 5, 6, 7); }
template <class Epi, class Sched, bool ALIGN_EPI = false, bool SP2 = false, int ESZ = 2>
__device__ __forceinline__ void gemm_phase(PG8_LAS unsigned char* lds, const int K, const Sched& S, const Epi& E) {
    int tid = threadIdx.x; asm volatile("" : "+v"(tid));
    const int wid = __builtin_amdgcn_readfirstlane(tid >> 6), lane = tid & 63, wr = wid >> 2, wc = wid & 3, fr = lane & 15, fq = lane >> 4;
    const int nt = K / (BK * 2 / ESZ);
    unsigned voffA, voffB;
    { int R, C; stage_rc(tid * 16, R, C); const int Rb = Epi::PERM ? ((R & ~31) + perm32(R & 31)) : R;
        voffA = (unsigned)(R * K * ESZ + C * 2); voffB = (unsigned)(Rb * K * ESZ + C * 2); }
    const size_t pstep = (size_t)64 * K * ESZ;
    const size_t kstep = (size_t)(BK * 2);
    const size_t hstep = (size_t)HALF * K * ESZ;
    const unsigned ldsw = (unsigned)wid * 1024u;
    const int aoff = lds_byte(wr * 64 + fr, fq * 8), boff = lds_byte(wc * 32 + fr, fq * 8);
#define PG8_SA(b, h) (((b) * 2 + (h)) * HTB)
#define PG8_SB(b, h) ((4 + (b) * 2 + (h)) * HTB)
#define PG8_STAGE(bufoff, gbase, voff) do { _Pragma("unroll") for (int _i = 0; _i < 2; ++_i) \
        __builtin_amdgcn_global_load_lds((const unsigned*)((const char*)(gbase) + _i * pstep + (voff)), (PG8_LAS unsigned*)(lds + (bufoff) + ldsw + _i * 8192), 16, 0, 0); } while (0)
#define PG8_LDA(dst, b, h) do { _Pragma("unroll") for (int m = 0; m < 4; ++m) { const PG8_LAS unsigned char* p_ = lds + PG8_SA(b, h) + aoff + m * 2048; if constexpr (ESZ == 1) dst##8[m] = cat8(*(const PG8_LAS bf16x8*)p_, *(const PG8_LAS bf16x8*)(p_ + 1024)); else { dst[m][0] = *(const PG8_LAS bf16x8*)p_; dst[m][1] = *(const PG8_LAS bf16x8*)(p_ + 1024); } } } while (0)
#define PG8_LDB(dst, b, h) do { _Pragma("unroll") for (int n = 0; n < 2; ++n) { const PG8_LAS unsigned char* p_ = lds + PG8_SB(b, h) + boff + n * 2048; if constexpr (ESZ == 1) dst##8[n] = cat8(*(const PG8_LAS bf16x8*)p_, *(const PG8_LAS bf16x8*)(p_ + 1024)); else { dst[n][0] = *(const PG8_LAS bf16x8*)p_; dst[n][1] = *(const PG8_LAS bf16x8*)(p_ + 1024); } } } while (0)
#define PG8_MMA(ai, bj, At, Bt) do { __builtin_amdgcn_s_setprio(1); _Pragma("unroll") for (int m = 0; m < 4; ++m) _Pragma("unroll") for (int n = 0; n < 2; ++n) { \
        if constexpr (ESZ == 1) { asm volatile("v_mfma_scale_f32_16x16x128_f8f6f4 %0, %1, %2, %0, %3, %3 op_sel_hi:[0,0,0]" : "+v"(acc[ai][bj][m][n]) : "v"(Bt##8[n]), "v"(At##8[m]), "v"(sc7f)); } \
        else { _Pragma("unroll") for (int k = 0; k < 2; ++k) acc[ai][bj][m][n] = __builtin_amdgcn_mfma_f32_16x16x32_bf16(Bt[n][k], At[m][k], acc[ai][bj][m][n], 0, 0, 0); } } \
        __builtin_amdgcn_s_setprio(0); } while (0)
#define PG8_WAIT_V(n) asm volatile("s_waitcnt vmcnt(" #n ")" ::: "memory")
#define PG8_WAIT_L(n) asm volatile("s_waitcnt lgkmcnt(" #n ")" ::: "memory")
#define PG8_BAR __builtin_amdgcn_s_barrier()
#define PG8_SCHED __builtin_amdgcn_sched_barrier(0)
    Unit cur, nxt; int ui = 0;
    if (!S.next(0, cur)) return;
    f32x4 acc[2][2][4][2];
#pragma unroll
    for (int a = 0; a < 2; ++a)
#pragma unroll
        for (int b = 0; b < 2; ++b)
#pragma unroll
            for (int m = 0; m < 4; ++m)
#pragma unroll
                for (int n = 0; n < 2; ++n) acc[a][b][m][n] = (f32x4){0.f, 0.f, 0.f, 0.f};
    const int sc7f = 0x7f7f7f7f;
    bf16x8 At[4][2], B0[2][2], B1[2][2]; i32x8 At8[4], B08[2], B18[2];
    const char* cA = cur.a; const char* cB = cur.b;
    S.a_ready(cur);
    if constexpr (SP2) {
        PG8_STAGE(PG8_SB(0, 0), cB, voffB); PG8_STAGE(PG8_SB(0, 1), cB + hstep, voffB); PG8_STAGE(PG8_SA(0, 0), cA, voffA); PG8_STAGE(PG8_SA(0, 1), cA + hstep, voffA);
        if (wr == 1) PG8_BAR;
        PG8_WAIT_V(2); PG8_BAR;
        PG8_STAGE(PG8_SB(1, 0), cB + kstep, voffB); PG8_STAGE(PG8_SA(1, 0), cA + kstep, voffA); PG8_STAGE(PG8_SB(1, 1), cB + hstep + kstep, voffB);
        PG8_WAIT_V(6); PG8_BAR;
    } else {
        PG8_STAGE(PG8_SB(0, 0), cB, voffB); PG8_STAGE(PG8_SA(0, 0), cA, voffA); PG8_STAGE(PG8_SB(0, 1), cB + hstep, voffB); PG8_STAGE(PG8_SA(0, 1), cA + hstep, voffA);
        if (wr == 1) PG8_BAR;
        PG8_WAIT_V(4); PG8_BAR;
        PG8_STAGE(PG8_SB(1, 0), cB + kstep, voffB); PG8_STAGE(PG8_SA(1, 0), cA + kstep, voffA); PG8_STAGE(PG8_SB(1, 1), cB + hstep + kstep, voffB);
        PG8_WAIT_V(6); PG8_BAR;
    }
    for (;;) {
        const bool has_next = S.next(ui + 1, nxt);
        const char* nA = has_next ? nxt.a : cA; const char* nB = has_next ? nxt.b : cB;
        for (int t = 0; t < nt; t += 2) {
            const bool last = (t == nt - 2);
            const char* a1 = cA + (size_t)(t + 1) * kstep;
            const char* a2 = last ? nA : cA + (size_t)(t + 2) * kstep; const char* b2 = last ? nB : cB + (size_t)(t + 2) * kstep;
            const char* a3 = a2 + kstep; const char* b3 = b2 + kstep;
            if (last && has_next) S.a_ready(nxt);
            if constexpr (SP2) {
            PG8_LDB(B0, 0, 0); PG8_LDB(B1, 0, 1); PG8_SCHED; PG8_LDA(At, 0, 0); PG8_STAGE(PG8_SA(1, 1), a1 + hstep, voffA);
            PG8_WAIT_V(8); PG8_WAIT_L(0); PG8_BAR; PG8_MMA(0, 0, At, B0); PG8_MMA(0, 1, At, B1); PG8_BAR; PG8_SCHED;
            PG8_LDA(At, 0, 1); PG8_STAGE(PG8_SB(0, 0), b2, voffB); PG8_STAGE(PG8_SB(0, 1), b2 + hstep, voffB); PG8_STAGE(PG8_SA(0, 0), a2, voffA);
            PG8_WAIT_V(8); PG8_WAIT_L(0); PG8_BAR; PG8_MMA(1, 0, At, B0); PG8_MMA(1, 1, At, B1); PG8_BAR; PG8_SCHED;
            PG8_LDB(B0, 1, 0); PG8_LDB(B1, 1, 1); PG8_SCHED; PG8_LDA(At, 1, 0); PG8_STAGE(PG8_SA(0, 1), a2 + hstep, voffA);
            PG8_WAIT_V(8); PG8_WAIT_L(0); PG8_BAR; PG8_MMA(0, 0, At, B0); PG8_MMA(0, 1, At, B1); PG8_BAR; PG8_SCHED;
            PG8_LDA(At, 1, 1); PG8_STAGE(PG8_SB(1, 0), b3, voffB); PG8_STAGE(PG8_SB(1, 1), b3 + hstep, voffB); PG8_STAGE(PG8_SA(1, 0), a3, voffA);
            PG8_WAIT_V(8); PG8_WAIT_L(0); PG8_BAR; PG8_MMA(1, 0, At, B0); PG8_MMA(1, 1, At, B1); PG8_BAR; PG8_SCHED;
            } else {
            PG8_LDB(B0, 0, 0); PG8_SCHED; PG8_LDA(At, 0, 0); PG8_STAGE(PG8_SA(1, 1), a1 + hstep, voffA);
            PG8_WAIT_L(8); PG8_BAR; PG8_WAIT_L(0); PG8_MMA(0, 0, At, B0); PG8_BAR; PG8_SCHED;
            PG8_LDB(B1, 0, 1); PG8_STAGE(PG8_SB(0, 0), b2, voffB);
            PG8_BAR; PG8_WAIT_L(0); PG8_MMA(0, 1, At, B1); PG8_BAR;
            PG8_LDA(At, 0, 1); PG8_STAGE(PG8_SA(0, 0), a2, voffA);
            PG8_BAR; PG8_WAIT_L(0); PG8_MMA(1, 0, At, B0); PG8_BAR; PG8_SCHED;
            PG8_STAGE(PG8_SB(0, 1), b2 + hstep, voffB);
            PG8_WAIT_V(6); PG8_BAR; PG8_MMA(1, 1, At, B1); PG8_BAR;
            PG8_LDB(B0, 1, 0); PG8_SCHED; PG8_LDA(At, 1, 0); PG8_STAGE(PG8_SA(0, 1), a2 + hstep, voffA);
            PG8_WAIT_L(8); PG8_BAR; PG8_WAIT_L(0); PG8_MMA(0, 0, At, B0); PG8_BAR; PG8_SCHED;
            PG8_LDB(B1, 1, 1); PG8_STAGE(PG8_SB(1, 0), b3, voffB);
            PG8_BAR; PG8_WAIT_L(0); PG8_MMA(0, 1, At, B1); PG8_BAR;
            PG8_LDA(At, 1, 1); PG8_STAGE(PG8_SA(1, 0), a3, voffA);
            PG8_BAR; PG8_WAIT_L(0); PG8_MMA(1, 0, At, B0); PG8_BAR; PG8_SCHED;
            PG8_STAGE(PG8_SB(1, 1), b3 + hstep, voffB);
            PG8_WAIT_V(6); PG8_BAR; PG8_MMA(1, 1, At, B1); PG8_BAR;
            }
        }
        if constexpr (ESZ == 1) asm volatile("s_nop 15\n\ts_nop 15" ::: "memory");
        if constexpr (ALIGN_EPI) { if (wr == 0) PG8_BAR; }
        if constexpr (!Epi::AFTER_DRAIN) { int z_ = 0; asm volatile("" : "+v"(z_)); const int ln_ = (int)__builtin_amdgcn_mbcnt_hi(~0u, __builtin_amdgcn_mbcnt_lo(~0u, (unsigned)z_)); const int fr_ = ln_ & 15, fq_ = ln_ >> 4;
            E(acc, cur, wr, wc, fr_, fq_); S.done(cur); }
        if (!has_next) break;
#pragma unroll
        for (int a = 0; a < 2; ++a)
#pragma unroll
            for (int b = 0; b < 2; ++b)
#pragma unroll
                for (int m = 0; m < 4; ++m)
#pragma unroll
                    for (int n = 0; n < 2; ++n) acc[a][b][m][n] = (f32x4){0.f, 0.f, 0.f, 0.f};
        cur = nxt; cA = nA; cB = nB; ++ui;
        if constexpr (ALIGN_EPI) { if (wr == 1) PG8_BAR; }
    }
    PG8_WAIT_V(0);
    if constexpr (!ALIGN_EPI) { if (wr == 0) PG8_BAR; }
    PG8_BAR;
    if constexpr (Epi::AFTER_DRAIN) { E.fused(acc, cur, wr, wc, fr, fq, lds, wid, lane); S.done(cur); }
#undef PG8_SA
#undef PG8_SB
#undef PG8_STAGE
#undef PG8_LDA
#undef PG8_LDB
#undef PG8_MMA
#undef PG8_WAIT_V
#undef PG8_WAIT_L
#undef PG8_BAR
#undef PG8_SCHED
}
}

namespace att {
#define ALAS __attribute__((address_space(3)))
typedef short bf16x8 __attribute__((ext_vector_type(8)));
typedef short s16x4 __attribute__((ext_vector_type(4)));
typedef float f32x16 __attribute__((ext_vector_type(16)));
typedef float f32x4 __attribute__((ext_vector_type(4)));
typedef unsigned u32x4 __attribute__((ext_vector_type(4)));
typedef unsigned short bf16_t;
typedef ALAS char* ALAS_char_ptr;
constexpr int D = 128, PITCH = 1024, NW = 8, QBLK = 32, KVBLK = 64, QB = NW * QBLK, SEQ = 8192;
constexpr int SHM = KVBLK * D * 2;
constexpr int OFF_V = 0, OFF_K = 2 * SHM, OFF_WS = 4 * SHM, OFF_G = OFF_WS + NW * 64 * 4, OFF_FLAG = OFF_G + SEQ * 4, LDS_BYTES = OFF_FLAG + 256;
constexpr float SCALE = 0.08838834764831845f, LOG2E = 1.4426950408889634f, C2 = SCALE * LOG2E;
constexpr float THR2 = 10.0f;
constexpr float SB_EXIT = 152.0f;

#define KSWZ(row, colB) ((row) * 256 + ((colB) ^ (((row) & 7) << 4)))
#define ASBAR() __builtin_amdgcn_sched_barrier(0)
__device__ __forceinline__ int v_st(int k, int c) { const int kk = (k & ~0xC) | ((k & 4) << 1) | ((k & 8) >> 1); return ((kk >> 3) * 4 + (c >> 5)) * 512 + ((kk & 7) * 32 + (c & 31)) * 2; }
__device__ __forceinline__ int v_rd_base(int lane) { return ((lane & 3) << 3) | (((lane >> 2) & 3) << 6) | (((lane >> 4) & 1) << 5) | (((lane >> 5) & 1) << 8); }
constexpr int v_rd_off(int d0, int ks, int half) { return d0 * 512 + ks * 4096 + half * 2048; }
__device__ __forceinline__ int crow(int r, int hi) { return (r & 3) + 8 * (r >> 2) + 4 * hi; }
__device__ __forceinline__ unsigned cvtpk(float lo, float hi) { return pg8::cvt_pk_bf16(lo, hi); }

struct Stage { bf16x8 k0, k1, v0, v1; };
__device__ __forceinline__ void sload(Stage& S, const bf16_t* Kh, const bf16_t* Vh, int kbase, unsigned loff) {
    const char* Kt = (const char*)Kh + (size_t)kbase * PITCH * 2; const char* Vt = (const char*)Vh + (size_t)kbase * PITCH * 2;
    S.v0 = *(const bf16x8*)(Vt + loff); S.v1 = *(const bf16x8*)(Vt + (loff + 32u * PITCH * 2u));
    S.k0 = *(const bf16x8*)(Kt + loff); S.k1 = *(const bf16x8*)(Kt + (loff + 32u * PITCH * 2u));
}
__device__ __forceinline__ void swrite(const Stage& S, ALAS char* lds, int buf, int kws, int vst0, int vst1) {
    *(ALAS bf16x8*)(lds + OFF_K + buf * SHM + kws) = S.k0; *(ALAS bf16x8*)(lds + OFF_K + buf * SHM + kws + 32 * 256) = S.k1;
    *(ALAS bf16x8*)(lds + OFF_V + buf * SHM + vst0) = S.v0; *(ALAS bf16x8*)(lds + OFF_V + buf * SHM + vst1) = S.v1;
}
__device__ __forceinline__ void qkt(f32x16& p0, f32x16& p1, const ALAS char* Kb, int r32, int hi, const bf16x8* qr) {
    p0 = f32x16{}; p1 = f32x16{};
    const ALAS char* kb[4];
#pragma unroll
    for (int dd = 0; dd < 4; ++dd) kb[dd] = Kb + KSWZ(r32, (dd * 16 + hi * 8) * 2);
#pragma unroll
    for (int d0 = 0; d0 < 8; ++d0) { const ALAS char* a = kb[d0 & 3] + (d0 >> 2) * 128;
        const bf16x8 b0 = *(const ALAS bf16x8*)a;
        const bf16x8 b1 = *(const ALAS bf16x8*)(a + 32 * 256);
        p0 = __builtin_amdgcn_mfma_f32_32x32x16_bf16(b0, qr[d0], p0, 0, 0, 0);
        p1 = __builtin_amdgcn_mfma_f32_32x32x16_bf16(b1, qr[d0], p1, 0, 0, 0); }
}
__device__ __forceinline__ void pv_tile(f32x16* o, int vb, bf16x8 pa0, bf16x8 pa1, bf16x8 pa2, bf16x8 pa3) {
#define TRRD(dst, off) asm volatile("ds_read_b64_tr_b16 %0, %1 offset:%2" : "=&v"(dst) : "v"(vb), "i"(off) : "memory")
#define PV_D0(d0) do { s16x4 l0, l1, l2, l3, h0, h1, h2, h3; constexpr int b_ = v_rd_off(d0, 0, 0); \
        TRRD(l0, b_); TRRD(h0, b_ + 2048); TRRD(l1, b_ + 4096); TRRD(h1, b_ + 6144); TRRD(l2, b_ + 8192); TRRD(h2, b_ + 10240); TRRD(l3, b_ + 12288); TRRD(h3, b_ + 14336); \
        asm volatile("s_waitcnt lgkmcnt(0)" ::: "memory"); ASBAR(); \
        o[d0] = __builtin_amdgcn_mfma_f32_32x32x16_bf16(pa0, (bf16x8){l0[0], l0[1], l0[2], l0[3], h0[0], h0[1], h0[2], h0[3]}, o[d0], 0, 0, 0);   \
        o[d0] = __builtin_amdgcn_mfma_f32_32x32x16_bf16(pa1, (bf16x8){l1[0], l1[1], l1[2], l1[3], h1[0], h1[1], h1[2], h1[3]}, o[d0], 0, 0, 0);   \
        o[d0] = __builtin_amdgcn_mfma_f32_32x32x16_bf16(pa2, (bf16x8){l2[0], l2[1], l2[2], l2[3], h2[0], h2[1], h2[2], h2[3]}, o[d0], 0, 0, 0);   \
        o[d0] = __builtin_amdgcn_mfma_f32_32x32x16_bf16(pa3, (bf16x8){l3[0], l3[1], l3[2], l3[3], h3[0], h3[1], h3[2], h3[3]}, o[d0], 0, 0, 0); } while (0)
    PV_D0(0); PV_D0(1); PV_D0(2); PV_D0(3);
#undef PV_D0
#undef TRRD
}
__device__ __forceinline__ void pack_p(const f32x16& p0, const f32x16& p1, bf16x8& pa0, bf16x8& pa1, bf16x8& pa2, bf16x8& pa3) {
#define PK4(P, B_, OUT) do { unsigned a0 = cvtpk(P[B_+0], P[B_+1]), a1 = cvtpk(P[B_+2], P[B_+3]);                          \
        unsigned b0 = cvtpk(P[B_+4], P[B_+5]), b1 = cvtpk(P[B_+6], P[B_+7]);                                             \
        auto r0 = __builtin_amdgcn_permlane32_swap(a0, b0, false, false); auto r1 = __builtin_amdgcn_permlane32_swap(a1, b1, false, false); \
        u32x4 w = {r0[0], r1[0], r0[1], r1[1]}; OUT = *reinterpret_cast<bf16x8*>(&w); } while (0)
    PK4(p0, 0, pa0); PK4(p0, 8, pa1); PK4(p1, 0, pa2); PK4(p1, 8, pa3);
#undef PK4
}
__device__ __forceinline__ void store_o(const f32x16* o, const float* rs, bf16_t* Ow  , int r32, int hi) {
    const unsigned lo = (unsigned)((4 * hi * PITCH + r32) * 2);
#pragma unroll
    for (int r = 0; r < 16; ++r) { const int orow0 = (r & 3) + 8 * (r >> 2);
#pragma unroll
        for (int d0 = 0; d0 < 4; ++d0) { const float v = o[d0][r] * rs[r]; const float vn = __shfl_xor(v, 1);
            if ((r32 & 1) == 0) *(unsigned*)((char*)Ow + (lo + (unsigned)((orow0 * PITCH + d0 * 32) * 2))) = cvtpk(v, vn); } }
}

__device__ __forceinline__ void fox_unit(const bf16_t* Qh, const bf16_t* Kh, const bf16_t* Vh, bf16_t* Oh, const float* Gh, int qb, int t0, int t1, int mode, float* part, unsigned* flag, unsigned* tmo, const unsigned* km, ALAS char* lds) {
    int tid = threadIdx.x; asm volatile("" : "+v"(tid));
    const int wid = __builtin_amdgcn_readfirstlane(tid >> 6), lane = tid & 63, r32 = lane & 31, hi = lane >> 5;
    const int P0 = qb * QB, NT = 4 * (qb + 1);
    const int sr = tid >> 4, sc = (tid & 15) * 8, vst0 = v_st(sr, sc), vst1 = v_st(32 + sr, sc), kws = KSWZ(sr, sc * 2); const unsigned loff = (unsigned)((sr * PITCH + sc) * 2);
    const int vb0 = (int)(unsigned)(size_t)(lds + OFF_V) + v_rd_base(lane);
    ALAS float* wsf = (ALAS float*)(lds + OFF_WS) + wid * 64; ALAS float* li_l = wsf; ALAS float* al_l = wsf + 32;
    ALAS float* Gl = (ALAS float*)(lds + OFF_G);
    {
        f32x4 a[4]; float run = 0.f;
#pragma unroll
        for (int i = 0; i < 4; ++i) a[i] = *(const f32x4*)((const char*)Gh + (unsigned)((tid * 16 + i * 4) * 4));
#pragma unroll
        for (int i = 0; i < 4; ++i) { a[i].x += run; a[i].y += a[i].x; a[i].z += a[i].y; a[i].w += a[i].z; run = a[i].w; }
        float inc = run;
#pragma unroll
        for (int o = 1; o < 64; o <<= 1) { const float t = __shfl_up(inc, o); if (lane >= o) inc += t; }
        ALAS float* wtot = (ALAS float*)(lds + OFF_FLAG + 96);
        if (lane == 63) wtot[wid] = inc;
        __syncthreads();
        float off = inc - run;
#pragma unroll
        for (int w = 0; w < NW; ++w) off += w < wid ? wtot[w] : 0.f;
#pragma unroll
        for (int i = 0; i < 4; ++i) ((ALAS f32x4*)Gl)[tid * 4 + i] = (a[i] + off) * LOG2E;
    }
    bf16x8 qr[8];
#pragma unroll
    for (int d0 = 0; d0 < 8; ++d0) qr[d0] = *(const bf16x8*)((const char*)Qh + (size_t)P0 * PITCH * 2 + (unsigned)(((wid * QBLK + r32) * PITCH + hi * 8) * 2 + d0 * 32));
    Stage S; sload(S, Kh, Vh, (NT - 1 - t0) * KVBLK, loff);
    asm volatile("s_waitcnt vmcnt(0)" ::: "memory"); swrite(S, lds, 0, kws, vst0, vst1);
    __syncthreads();
    float cq;
    { float k2 = 0.f;
#pragma unroll
      for (int w = 0; w < 4; ++w) k2 += __uint_as_float(__hip_atomic_load(km + w, __ATOMIC_RELAXED, __HIP_MEMORY_SCOPE_AGENT));
      float q2 = 0.f;
#pragma unroll
      for (int d0 = 0; d0 < 8; ++d0) { const u32x4 u = __builtin_bit_cast(u32x4, qr[d0]);
#pragma unroll
          for (int j = 0; j < 4; ++j) { const float a = __uint_as_float(u[j] << 16), b = __uint_as_float(u[j] & 0xffff0000u); q2 += a * a + b * b; } }
      { auto rr = __builtin_amdgcn_permlane32_swap(__float_as_uint(q2), __float_as_uint(q2), false, false); q2 = __uint_as_float(rr[0]) + __uint_as_float(rr[1]); }
      cq = sqrtf(q2) * sqrtf(k2) * (1.01f * C2); }
    ALAS int* flg = (ALAS int*)(lds + OFF_FLAG);
    const float Gref = Gl[P0 + QB - 1];
    float m_reg = -1e30f, l_reg = 0.f; f32x16 o[4] = {};
    const int qlo = P0 + wid * QBLK, qm = qlo + r32 - 4 * hi;
    const float mlb = (Gref - Gl[qlo + r32]) - cq;
    bool skip_all = false;
    { const float gb0 = Gref - Gl[(NT - 1 - t0) * KVBLK + KVBLK - 1];
      const bool done_w = __all(cq + gb0 <= mlb - SB_EXIT);
      if (lane == 0) flg[32 + wid] = done_w ? 1 : 0;
      __syncthreads();
      int all_done = 1;
#pragma unroll
      for (int w = 0; w < NW; ++w) all_done &= flg[32 + w];
      skip_all = all_done != 0; }
    for (int t = t0; t < t1 && !skip_all; ++t) {
        const int buf = (t - t0) & 1, kb = (NT - 1 - t) * KVBLK;
        if (t + 1 < t1) sload(S, Kh, Vh, kb - KVBLK, loff);
        ASBAR();
        if (kb <= qlo + QBLK - 1) {
            f32x16 p0, p1;
            qkt(p0, p1, lds + OFF_K + buf * SHM, r32, hi, qr);
#pragma unroll
            for (int g = 0; g < 4; ++g) { const f32x4 b0 = *(const ALAS f32x4*)(Gl + kb + 8 * g + 4 * hi), b1 = *(const ALAS f32x4*)(Gl + kb + 32 + 8 * g + 4 * hi);
#pragma unroll
                for (int i = 0; i < 4; ++i) { p0[4 * g + i] = fmaf(p0[4 * g + i], C2, Gref - b0[i]); p1[4 * g + i] = fmaf(p1[4 * g + i], C2, Gref - b1[i]); } }
            if (kb + KVBLK - 1 > qlo) {
                const int dq = qm - kb; const float NEG = -__builtin_inff();
#pragma unroll
                for (int r = 0; r < 16; ++r) { const int c = (r & 3) + 8 * (r >> 2); if (dq - c < 0) p0[r] = NEG; if (dq - c - 32 < 0) p1[r] = NEG; }
            }
            float pmax = p0[0];
#pragma unroll
            for (int r = 1; r < 16; ++r) pmax = fmaxf(pmax, p0[r]);
#pragma unroll
            for (int r = 0; r < 16; ++r) pmax = fmaxf(pmax, p1[r]);
            { auto rr = __builtin_amdgcn_permlane32_swap(__float_as_uint(pmax), __float_as_uint(pmax), false, false); pmax = fmaxf(__uint_as_float(rr[0]), __uint_as_float(rr[1])); }
            float mn, alpha;
            if (__all(pmax - m_reg <= THR2)) { mn = m_reg; alpha = 1.f; }
            else { mn = fmaxf(m_reg, pmax); alpha = __builtin_amdgcn_exp2f(m_reg - mn); m_reg = mn; }
            float ps = 0.f;
#pragma unroll
            for (int r = 0; r < 16; ++r) { p0[r] = __builtin_amdgcn_exp2f(p0[r] - mn); ps += p0[r]; }
#pragma unroll
            for (int r = 0; r < 16; ++r) { p1[r] = __builtin_amdgcn_exp2f(p1[r] - mn); ps += p1[r]; }
            { auto rr = __builtin_amdgcn_permlane32_swap(__float_as_uint(ps), __float_as_uint(ps), false, false); ps = __uint_as_float(rr[0]) + __uint_as_float(rr[1]); }
            l_reg = l_reg * alpha + ps;
            bf16x8 pa0, pa1, pa2, pa3; pack_p(p0, p1, pa0, pa1, pa2, pa3);
            if (__any(alpha < 1.f)) { if (hi == 0) al_l[r32] = alpha; asm volatile("s_waitcnt lgkmcnt(0)" ::: "memory");
#pragma unroll
                for (int d_ = 0; d_ < 4; ++d_)
#pragma unroll
                    for (int r = 0; r < 16; ++r) o[d_][r] *= al_l[crow(r, hi)]; }
            ASBAR();
            pv_tile(o, vb0 + buf * SHM, pa0, pa1, pa2, pa3);
        }
        { const float gb = kb > 0 ? Gref - Gl[kb - 1] : 0.f;
          const bool done_w = __all(cq + gb <= fmaxf(m_reg, mlb) - SB_EXIT);
          if (lane == 0) flg[buf * 8 + wid] = done_w ? 1 : 0; }
        if (t + 1 < t1) { asm volatile("s_waitcnt vmcnt(0)" ::: "memory"); swrite(S, lds, buf ^ 1, kws, vst0, vst1); }
        __syncthreads();
        int all_done = 1;
#pragma unroll
        for (int w = 0; w < NW; ++w) all_done &= flg[buf * 8 + w];
        if (all_done) break;
    }
    if (mode == 1) {
        float* Op = part + (size_t)(wid * QBLK) * D;
#pragma unroll
        for (int r = 0; r < 16; ++r)
#pragma unroll
            for (int d0 = 0; d0 < 4; ++d0) *(float*)((char*)Op + (unsigned)((crow(r, hi) * D + d0 * 32 + r32) * 4)) = o[d0][r];
        if (hi == 0) { part[QB * D + wid * QBLK + r32] = m_reg; part[QB * D + QB + wid * QBLK + r32] = l_reg; }
        asm volatile("s_waitcnt vmcnt(0)" ::: "memory");
        __syncthreads();
        if (tid == 0) { __builtin_amdgcn_fence(__ATOMIC_RELEASE, "agent"); asm volatile("s_waitcnt vmcnt(0)" ::: "memory");
            __hip_atomic_store(flag, 1u, __ATOMIC_RELAXED, __HIP_MEMORY_SCOPE_AGENT); }
        __syncthreads();
        return;
    }
    if (mode == 2) {
        if (tid == 0) { unsigned sp = 0u;
            while (__hip_atomic_load(flag, __ATOMIC_RELAXED, __HIP_MEMORY_SCOPE_AGENT) == 0u) { __builtin_amdgcn_s_sleep(4); if (++sp > (1u << 21)) { atomicAdd(tmo, 1u); break; } }
            __builtin_amdgcn_fence(__ATOMIC_ACQUIRE, "agent"); asm volatile("s_waitcnt vmcnt(0)" ::: "memory"); }
        __syncthreads();
        const float mB = part[QB * D + wid * QBLK + r32], lB = part[QB * D + QB + wid * QBLK + r32];
        const float mN = fmaxf(m_reg, mB), fa = __builtin_amdgcn_exp2f(m_reg - mN), fb = __builtin_amdgcn_exp2f(mB - mN);
        l_reg = l_reg * fa + lB * fb;
        if (hi == 0) { al_l[r32] = fa; li_l[r32] = fb; } asm volatile("s_waitcnt lgkmcnt(0)" ::: "memory");
        const float* Op = part + (size_t)(wid * QBLK) * D;
#pragma unroll
        for (int r = 0; r < 16; ++r) { const float ar = al_l[crow(r, hi)], br = li_l[crow(r, hi)];
#pragma unroll
            for (int d0 = 0; d0 < 4; ++d0) o[d0][r] = o[d0][r] * ar + *(const float*)((const char*)Op + (unsigned)((crow(r, hi) * D + d0 * 32 + r32) * 4)) * br; }
        asm volatile("s_waitcnt lgkmcnt(0)" ::: "memory");
    }
    if (hi == 0) li_l[r32] = l_reg; asm volatile("s_waitcnt lgkmcnt(0)" ::: "memory");
    float rli[16];
#pragma unroll
    for (int r = 0; r < 16; ++r) rli[r] = __builtin_amdgcn_rcpf(li_l[crow(r, hi)]);
    store_o(o, rli, Oh + (size_t)(P0 + wid * QBLK) * PITCH, r32, hi);
    __syncthreads();
}

__device__ __forceinline__ float softplus2(float u) { return fmaxf(u, 0.f) + __builtin_amdgcn_logf(1.0f + __builtin_amdgcn_exp2f(-fabsf(u))); }
__device__ __forceinline__ void sb_unit(const bf16_t* Qh, const bf16_t* Kh, const bf16_t* Vh, bf16_t* Oh, int qb, ALAS char* lds) {
    int tid = threadIdx.x; asm volatile("" : "+v"(tid));
    const int wid = __builtin_amdgcn_readfirstlane(tid >> 6), lane = tid & 63, r32 = lane & 31, hi = lane >> 5;
    const int P0 = qb * QB, NT = 4 * (qb + 1);
    const int sr = tid >> 4, sc = (tid & 15) * 8, vst0 = v_st(sr, sc), vst1 = v_st(32 + sr, sc), kws = KSWZ(sr, sc * 2); const unsigned loff = (unsigned)((sr * PITCH + sc) * 2);
    const int vb0 = (int)(unsigned)(size_t)(lds + OFF_V) + v_rd_base(lane);
    ALAS int* flg = (ALAS int*)(lds + OFF_FLAG);
    bf16x8 qr[8];
#pragma unroll
    for (int d0 = 0; d0 < 8; ++d0) qr[d0] = *(const bf16x8*)((const char*)Qh + (size_t)P0 * PITCH * 2 + (unsigned)(((wid * QBLK + r32) * PITCH + hi * 8) * 2 + d0 * 32));
    Stage S; sload(S, Kh, Vh, (NT - 1) * KVBLK, loff);
    asm volatile("s_waitcnt vmcnt(0)" ::: "memory"); swrite(S, lds, 0, kws, vst0, vst1);
    __syncthreads();
    float carry = 0.f; f32x16 o[4] = {};
    const int qlo = P0 + wid * QBLK, qm = qlo + r32 - 4 * hi;
    for (int t = 0; t < NT; ++t) {
        const int buf = t & 1, kb = (NT - 1 - t) * KVBLK;
        if (t + 1 < NT) sload(S, Kh, Vh, kb - KVBLK, loff);
        ASBAR();
        if (kb < qlo + QBLK - 1) {
            f32x16 p0, p1, s0, s1;
            qkt(p0, p1, lds + OFF_K + buf * SHM, r32, hi, qr);
            const int dq = qm - kb - 1;
#pragma unroll
            for (int r = 0; r < 16; ++r) { const int c = (r & 3) + 8 * (r >> 2);
                p0[r] *= C2; p1[r] *= C2;
                s0[r] = (dq - c < 0) ? 0.f : softplus2(p0[r]); s1[r] = (dq - c - 32 < 0) ? 0.f : softplus2(p1[r]); }
#pragma unroll
            for (int g = 0; g < 4; ++g) { s0[4 * g + 2] += s0[4 * g + 3]; s0[4 * g + 1] += s0[4 * g + 2]; s0[4 * g] += s0[4 * g + 1];
                                          s1[4 * g + 2] += s1[4 * g + 3]; s1[4 * g + 1] += s1[4 * g + 2]; s1[4 * g] += s1[4 * g + 1]; }
            float e0[4], e1[4], running = carry;
#pragma unroll
            for (int g = 3; g >= 0; --g) { auto rb = __builtin_amdgcn_permlane32_swap(__float_as_uint(s1[4 * g]), __float_as_uint(s1[4 * g]), false, false);
                const float eh = running; running += __uint_as_float(rb[1]); const float el = running; running += __uint_as_float(rb[0]); e1[g] = hi ? eh : el; }
#pragma unroll
            for (int g = 3; g >= 0; --g) { auto ra = __builtin_amdgcn_permlane32_swap(__float_as_uint(s0[4 * g]), __float_as_uint(s0[4 * g]), false, false);
                const float eh = running; running += __uint_as_float(ra[1]); const float el = running; running += __uint_as_float(ra[0]); e0[g] = hi ? eh : el; }
            carry = running;
#pragma unroll
            for (int g = 0; g < 4; ++g) {
#pragma unroll
                for (int i = 0; i < 4; ++i) { const int r = 4 * g + i, c = (r & 3) + 8 * (r >> 2);
                    p0[r] = (dq - c < 0) ? 0.f : __builtin_amdgcn_exp2f(p0[r] - (e0[g] + s0[r]));
                    p1[r] = (dq - c - 32 < 0) ? 0.f : __builtin_amdgcn_exp2f(p1[r] - (e1[g] + s1[r])); } }
            bf16x8 pa0, pa1, pa2, pa3; pack_p(p0, p1, pa0, pa1, pa2, pa3);
            ASBAR();
            pv_tile(o, vb0 + buf * SHM, pa0, pa1, pa2, pa3);
        }
        const bool done_w = __all(carry > SB_EXIT);
        if (lane == 0) flg[buf * 8 + wid] = done_w ? 1 : 0;
        if (t + 1 < NT) { asm volatile("s_waitcnt vmcnt(0)" ::: "memory"); swrite(S, lds, buf ^ 1, kws, vst0, vst1); }
        __syncthreads();
        int all_done = 1;
#pragma unroll
        for (int w = 0; w < NW; ++w) all_done &= flg[buf * 8 + w];
        if (all_done) break;
    }
    float one[16];
#pragma unroll
    for (int r = 0; r < 16; ++r) one[r] = 1.f;
    store_o(o, one, Oh + (size_t)(P0 + wid * QBLK) * PITCH, r32, hi);
    __syncthreads();
}
#undef KSWZ
#undef ASBAR
}

constexpr int NWAVES = 8;
constexpr int N_LAUNCHES = MK_N_LAUNCHES;
constexpr int PER_PHASE = 9;

constexpr int T = 8192, DM = 2048, NH = 8, HD = 128, DH = NH * HD  ;
constexpr int NIN = 3 * DH + 3 * DH + NH + 2 * DM;
constexpr int NIN_G = 6 * DH + 2 * DM;
constexpr int NE = 32, TOPK = 4, DFF = DM, CAP = T;
constexpr float RMS_EPS = 1e-5f;

constexpr size_t MiB = 1u << 20;
constexpr size_t WS_CTL = 0, CTL_ZERO_BYTES = 128 * 1024;
constexpr size_t WS_WIN = 1 * MiB;
constexpr size_t WS_WPA = 41 * MiB, WS_WPB = 45 * MiB;
constexpr size_t WS_WOUT = 49 * MiB;
constexpr size_t WS_W1 = 57 * MiB;
constexpr size_t WS_W2 = 569 * MiB;
constexpr size_t WS_HN = 825 * MiB;
constexpr size_t WS_QKV = 857 * MiB, QKV_STRIDE = 16 * MiB;
constexpr size_t WS_GATES = 1050 * MiB;
constexpr size_t WS_LOGF = 1017 * MiB, WS_G = WS_LOGF + 512 * 1024;
constexpr size_t WS_OSB = 1018 * MiB, WS_OFX = 1034 * MiB;
constexpr size_t WS_PART = 953 * MiB;
constexpr size_t WS_MIXED = 1114 * MiB;
constexpr size_t WS_X1 = 1146 * MiB;
constexpr size_t WS_STOK = 1210 * MiB, WS_SW = 1211 * MiB;
constexpr size_t WS_Y = 2365 * MiB;
constexpr size_t WS_AS = 1341 * MiB;
constexpr size_t WS_H = 1853 * MiB;
constexpr size_t WS_HN8 = 3389 * MiB;
constexpr size_t WS_WIN8 = 3405 * MiB;
constexpr size_t WS_END = 3413 * MiB;
constexpr int CW_TMO = 0, CW_CODE = 1;
constexpr int CW_BAR = 4096;
constexpr int CW_CNT = 8192;
constexpr int CW_QF = 12288, CW_QS = CW_QF + 64 * 8;
constexpr int CW_QC = CW_QS + 64 * 8;
constexpr int CW_KM = CW_QC + 64;
constexpr int CW_FLAG = 16384;
static_assert((CW_FLAG + 64 * 128) * 4 <= (int)CTL_ZERO_BYTES && (CW_CNT + 64 * NE) <= CW_QF, "CTL words inside the memset region");

constexpr int RING_OFF = 0, RING_BYTES = 131072;
constexpr int LDSCTL_OFF = RING_BYTES, MISC_OFF = LDSCTL_OFF + 320;
constexpr int TAB_OFF = LDSCTL_OFF + 1024;
constexpr int LDS_BYTES = 147456;
static_assert(att::LDS_BYTES <= RING_BYTES, "attention scratch fits the ring region");

#define GAS __attribute__((address_space(1)))
#define LAS __attribute__((address_space(3)))
typedef unsigned short bf16;
typedef unsigned v4u __attribute__((ext_vector_type(4)));
typedef unsigned v2u __attribute__((ext_vector_type(2)));
typedef float f32x4 __attribute__((ext_vector_type(4)));
typedef float f32x16 __attribute__((ext_vector_type(16)));
typedef short bf16x8 __attribute__((ext_vector_type(8)));
typedef GAS unsigned gu32;
typedef GAS unsigned long long gu64;
#define RLX_AGENT __ATOMIC_RELAXED, __HIP_MEMORY_SCOPE_AGENT
#define LDS_WAIT() asm volatile("s_waitcnt lgkmcnt(0)" ::: "memory")
#define VM_WAIT() asm volatile("s_waitcnt vmcnt(0)" ::: "memory")
__device__ __forceinline__ unsigned long long rt() { return __builtin_amdgcn_s_memrealtime(); }
__device__ __forceinline__ unsigned f2bf(float f) { unsigned u = __builtin_bit_cast(unsigned, f); return (u + 0x7fffu + ((u >> 16) & 1u)) >> 16; }
__device__ __forceinline__ unsigned pk2(float lo, float hi) { return f2bf(lo) | (f2bf(hi) << 16); }

#define XB_TMO      128
#define XB_XCNT(j)  (256  + 64 * (j))
#define XB_XSUB(j)  (1280 + 64 * (j))
#define XB_XGEN(j)  (2304 + 64 * (j))
#define XB_TOP      3328
#define XB_TOPGEN   3392
#define XCD_BAR_WORDS 3456
#define XB_SPIN_CAP (1u << 18)

__device__ __forceinline__ unsigned xb_ld(unsigned* p)              { return __hip_atomic_load(p, __ATOMIC_RELAXED, __HIP_MEMORY_SCOPE_AGENT); }
__device__ __forceinline__ unsigned xb_add(unsigned* p, unsigned v) { return __hip_atomic_fetch_add(p, v, __ATOMIC_RELAXED, __HIP_MEMORY_SCOPE_AGENT); }
__device__ __forceinline__ unsigned xb_xcc_id() { return (unsigned)__builtin_amdgcn_s_getreg((3 << 11) | 20) & 0xFu; }
#define XB_SPIN(cond, bar) do { unsigned _sp = 0; while (cond) { __builtin_amdgcn_s_sleep(1); \
    if ((++_sp & 255u) == 0u) { if (xb_ld(&(bar)[XB_TMO])) break; if (_sp > XB_SPIN_CAP) { atomicAdd(&(bar)[XB_TMO], 1u); break; } } } } while (0)

struct XcdBarrier {
    unsigned* bar; unsigned x;
    volatile LAS unsigned* st;
};

__device__ __forceinline__ XcdBarrier xcd_barrier_post(unsigned* bar, volatile LAS unsigned* st) {
    XcdBarrier b; b.bar = bar; b.x = xb_xcc_id(); b.st = st;
    if (threadIdx.x == 0) (void)xb_add(&bar[XB_XCNT(b.x)], 1u);
    return b;
}
__device__ __forceinline__ void xcd_barrier_complete(unsigned* bar, unsigned x, unsigned& nloc, unsigned& nx) {
    const unsigned G = gridDim.x * gridDim.y * gridDim.z;
    unsigned sum, cnt, mine, sp = 0u;
    for (;;) {
        sum = 0u; cnt = 0u; mine = 0u;
#pragma unroll
        for (unsigned j = 0; j < 16; ++j) { const unsigned c = xb_ld(&bar[XB_XCNT(j)]); sum += c; cnt += (c > 0u) ? 1u : 0u; mine = (j == x) ? c : mine; }
        if (sum == G) break;
        __builtin_amdgcn_s_sleep(1);
        if ((++sp & 255u) == 0u) { if (xb_ld(&bar[XB_TMO])) break; if (sp > XB_SPIN_CAP) { atomicAdd(&bar[XB_TMO], 1u); break; } }
    }
    nloc = mine > 0u ? mine : 1u; nx = cnt > 0u ? cnt : 1u;
}

__device__ __forceinline__ void xcd_barrier(const XcdBarrier& b) {
    asm volatile("s_waitcnt vmcnt(0)" ::: "memory");
    __syncthreads();
    if (threadIdx.x == 0) {
        unsigned* bar = b.bar;
        __builtin_amdgcn_s_waitcnt(0);
        unsigned nloc = b.st[0], nx = b.st[1];
        if (nloc == 0u) { xcd_barrier_complete(bar, b.x, nloc, nx); b.st[0] = nloc; b.st[1] = nx; }
        const unsigned old = xb_add(&bar[XB_XSUB(b.x)], 1u);
        const unsigned gen = old / nloc;
        if (old + 1u == (gen + 1u) * nloc) {
            __builtin_amdgcn_fence(__ATOMIC_RELEASE, "agent");
            asm volatile("s_waitcnt vmcnt(0)" ::: "memory");
            const unsigned og = xb_add(&bar[XB_TOP], 1u);
            const unsigned tg = og / nx;
            if (og + 1u == (tg + 1u) * nx) xb_add(&bar[XB_TOPGEN], 1u);
            else XB_SPIN(xb_ld(&bar[XB_TOPGEN]) == tg, bar);
            __builtin_amdgcn_fence(__ATOMIC_ACQUIRE, "agent");
            xb_add(&bar[XB_XGEN(b.x)], 1u);
            asm volatile("s_waitcnt vmcnt(0)" ::: "memory");
        } else {
            XB_SPIN(xb_ld(&bar[XB_XGEN(b.x)]) == gen, bar);
            __builtin_amdgcn_fence(__ATOMIC_ACQUIRE, "agent");
            asm volatile("s_waitcnt vmcnt(0)" ::: "memory");
        }
    }
    __syncthreads();
}

struct Frame {
    LAS unsigned char* lds;
    volatile LAS unsigned* MISC;
    gu32* ctl;
    int tid, lane, wave;
    int vcu, G;
    const float *x, *g_mix, *w_in, *b_forget, *b_gate, *w_psb, *w_pfx, *w_out, *g_ffn, *w_router, *b_router, *w1, *b1, *w2, *b2, *g_final;
    float* out; unsigned char* ws;
};
__device__ __forceinline__ float wave_sum(float v) {
#pragma unroll
    for (int o = 1; o < 64; o <<= 1) v += __shfl_xor(v, o);
    return v;
}
__device__ __forceinline__ unsigned pkbf(float lo, float hi) { return pg8::cvt_pk_bf16(lo, hi); }

__device__ __forceinline__ void transpose_item(const float* src  , int ldw, bf16* dst  , int K, LAS unsigned char* scr, int tid) {
    const int kb = tid & 7, ng = tid >> 3;
    const float* s = src + (size_t)(kb * 8) * ldw + ng * 4;
    f32x4 v[8];
#pragma unroll
    for (int r = 0; r < 8; ++r) v[r] = *(const f32x4*)(s + (size_t)r * ldw);
#pragma unroll
    for (int j = 0; j < 4; ++j) { v4u o; o.x = pkbf(v[0][j], v[1][j]); o.y = pkbf(v[2][j], v[3][j]); o.z = pkbf(v[4][j], v[5][j]); o.w = pkbf(v[6][j], v[7][j]);
        *(LAS v4u*)(scr + (ng * 4 + j) * 144 + kb * 16) = o; }
    __syncthreads();
    const int c = tid & 7, n = tid >> 3;
#pragma unroll
    for (int i = 0; i < 4; ++i) { const int nn = n + 64 * i; const v4u o = *(const LAS v4u*)(scr + nn * 144 + c * 16); *(v4u*)(dst + (size_t)nn * K + c * 8) = o; }
    __syncthreads();
}
__device__ __forceinline__ void transpose_item_fp8(const float* src  , int ldw, unsigned char* dst  , int K, LAS unsigned char* scr, int tid) {
    const int kb = tid & 7, ng = tid >> 3;
#pragma unroll
    for (int p = 0; p < 2; ++p) {
        const float* s = src + (size_t)(p * 64 + kb * 8) * ldw + ng * 4;
        f32x4 v[8];
#pragma unroll
        for (int r = 0; r < 8; ++r) v[r] = *(const f32x4*)(s + (size_t)r * ldw) * pg8::W8_SCALE;
#pragma unroll
        for (int j = 0; j < 4; ++j) { v2u o; o.x = pg8::pk4_fp8(v[0][j], v[1][j], v[2][j], v[3][j]); o.y = pg8::pk4_fp8(v[4][j], v[5][j], v[6][j], v[7][j]);
            *(LAS v2u*)(scr + (ng * 4 + j) * 144 + p * 64 + kb * 8) = o; }
    }
    __syncthreads();
    const int c = tid & 7, n = tid >> 3;
#pragma unroll
    for (int i = 0; i < 4; ++i) { const int nn = n + 64 * i; const v4u o = *(const LAS v4u*)(scr + nn * 144 + c * 16); *(v4u*)(dst + (size_t)nn * K + c * 16) = o; }
    __syncthreads();
}
__device__ __forceinline__ void conv_load(f32x4 (&v)[8], const float* src, int ldw, int p, int kg, int cg) {
    const float* s = src + (size_t)(p * 64 + kg * 8) * ldw + cg * 4;
#pragma unroll
    for (int r = 0; r < 8; ++r) v[r] = __builtin_nontemporal_load((const f32x4*)(s + (size_t)r * ldw));
}
__device__ __forceinline__ void conv_to_lds(const f32x4 (&v)[8], LAS unsigned char* wscr, int p, int kg, int cg) {
#pragma unroll
    for (int j = 0; j < 4; ++j) { v2u o; o.x = pg8::pk4_fp8(v[0][j] * pg8::W8_SCALE, v[1][j] * pg8::W8_SCALE, v[2][j] * pg8::W8_SCALE, v[3][j] * pg8::W8_SCALE);
        o.y = pg8::pk4_fp8(v[4][j] * pg8::W8_SCALE, v[5][j] * pg8::W8_SCALE, v[6][j] * pg8::W8_SCALE, v[7][j] * pg8::W8_SCALE);
        *(LAS v2u*)(wscr + (cg * 4 + j) * 144 + p * 64 + kg * 8) = o; }
}
__device__ __forceinline__ void p0_prologue(Frame& F) {
    LAS unsigned char* scr = F.lds + RING_OFF;
    bf16* WIN = (bf16*)(F.ws + WS_WIN); bf16* WPA = (bf16*)(F.ws + WS_WPA); bf16* WPB = (bf16*)(F.ws + WS_WPB); bf16* WOUT = (bf16*)(F.ws + WS_WOUT);
    constexpr int I_WIN = 32 * 24, I_WP = 16 * 8, I_WOUT = 32 * 8;
    constexpr int NITEMS = I_WIN + 2 * I_WP + I_WOUT;
    {
        LAS unsigned char* wscr = scr + F.wave * (32 * 144);
        const int kg = F.lane >> 3, cg = F.lane & 7, c = F.lane & 7, n = F.lane >> 3;
        auto item = [&](int it, const float*& src, bf16*& dst, int& ldw, int& K) {
            int r = it;
            if (r < I_WIN) { const int nb = r % 24, kk = r / 24; src = F.w_in + (size_t)(kk * 64) * NIN + nb * 256; ldw = NIN; dst = WIN + (size_t)(nb * 256) * DM + kk * 64; K = DM; return; } r -= I_WIN;
            if (r < I_WP) { const int nb = r % 8, kk = r / 8; src = F.w_psb + (size_t)(kk * 64) * DM + nb * 256; ldw = DM; dst = WPA + (size_t)(nb * 256) * DH + kk * 64; K = DH; return; } r -= I_WP;
            if (r < I_WP) { const int nb = r % 8, kk = r / 8; src = F.w_pfx + (size_t)(kk * 64) * DM + nb * 256; ldw = DM; dst = WPB + (size_t)(nb * 256) * DH + kk * 64; K = DH; return; } r -= I_WP;
            { const int nb = r % 8, kk = r / 8; src = F.w_out + (size_t)(kk * 64) * DM + nb * 256; ldw = DM; dst = WOUT + (size_t)(nb * 256) * DM + kk * 64; K = DM; }
        };
        auto load8 = [&](f32x4 (&v)[8], const float* src, int ldw) { const float* p = src + (size_t)(kg * 8) * ldw + F.wave * 32 + cg * 4;
#pragma unroll
            for (int r = 0; r < 8; ++r) v[r] = __builtin_nontemporal_load((const f32x4*)(p + (size_t)r * ldw)); };
        f32x4 va[8], vb[8]; const float* src; bf16* dst; int ldw, K;
        int it = F.vcu;
        if (it < NITEMS) { item(it, src, dst, ldw, K); load8(va, src, ldw); }
        for (; it < NITEMS; it += 2 * F.G) {
#define P0_FLUSH(V, DST, KK) do { _Pragma("unroll") for (int j = 0; j < 4; ++j) { v4u o; o.x = pkbf(V[0][j], V[1][j]); o.y = pkbf(V[2][j], V[3][j]); o.z = pkbf(V[4][j], V[5][j]); o.w = pkbf(V[6][j], V[7][j]); \
                *(LAS v4u*)(wscr + (cg * 4 + j) * 144 + kg * 16) = o; } \
            asm volatile("s_waitcnt lgkmcnt(0)" ::: "memory"); \
            _Pragma("unroll") for (int i = 0; i < 4; ++i) { const int nn = n + 8 * i; const v4u o = *(const LAS v4u*)(wscr + nn * 144 + c * 16); *(v4u*)((DST) + (size_t)(F.wave * 32 + nn) * (KK) + c * 8) = o; } \
            asm volatile("s_waitcnt lgkmcnt(0)" ::: "memory"); } while (0)
            bf16* dA = dst; const int KA = K; const int itb = it + F.G;
            const float* sB = src; bf16* dB = dst; int lB = ldw, KB = K;
            if (itb < NITEMS) { item(itb, sB, dB, lB, KB); load8(vb, sB, lB); }
            P0_FLUSH(va, dA, KA);
            if (itb + F.G < NITEMS) { item(itb + F.G, src, dst, ldw, K); load8(va, src, ldw); }
            if (itb < NITEMS) P0_FLUSH(vb, dB, KB);
#undef P0_FLUSH
        }
    }
    {
        LAS unsigned char* wscr = scr + F.wave * (32 * 144); unsigned char* WIN8 = F.ws + WS_WIN8;
        const int kg = F.lane >> 3, cg = F.lane & 7, c = F.lane & 7, n = F.lane >> 3;
        for (int it = F.vcu; it < 256; it += F.G) { const int nb = it & 15, kk = it >> 4;
            const float* src = F.w_in + (size_t)(kk * 128) * NIN + 6 * DH + NH + nb * 256 + F.wave * 32; unsigned char* dst = WIN8 + (size_t)(nb * 256 + F.wave * 32) * DM + kk * 128;
            f32x4 va[8], vb[8]; conv_load(va, src, NIN, 0, kg, cg); conv_load(vb, src, NIN, 1, kg, cg);
            conv_to_lds(va, wscr, 0, kg, cg); conv_to_lds(vb, wscr, 1, kg, cg);
            asm volatile("s_waitcnt lgkmcnt(0)" ::: "memory");
#pragma unroll
            for (int i = 0; i < 4; ++i) { const int nn = n + 8 * i; const v4u o = *(const LAS v4u*)(wscr + nn * 144 + c * 16); *(v4u*)(dst + (size_t)nn * DM + c * 16) = o; }
            asm volatile("s_waitcnt lgkmcnt(0)" ::: "memory");
        }
    }
    __syncthreads();
    bf16* HN = (bf16*)(F.ws + WS_HN); float* LOGF = (float*)(F.ws + WS_LOGF);
    LAS f32x4* wf4 = (LAS f32x4*)scr;
    for (int i = F.tid; i < DM * 2; i += NWAVES * 64) wf4[i] = *(const f32x4*)(F.w_in + (size_t)(i >> 1) * NIN + 6 * DH + (i & 1) * 4);
    __syncthreads();
    for (int tb = F.vcu; tb < T / 32; tb += F.G) {
        for (int j4 = 0; j4 < 4; ++j4) {
            const int row = tb * 32 + F.wave * 4 + j4;
            LAS f32x4* wfl = wf4; asm volatile("" : "+v"(wfl));
            const f32x4* xr = (const f32x4*)(F.x + (size_t)row * DM) + F.lane; const f32x4* gm = (const f32x4*)F.g_mix + F.lane;
            f32x4 v[8]; float ss = 0.f;
#pragma unroll
            for (int j = 0; j < 8; ++j) { v[j] = xr[64 * j]; ss += (v[j].x * v[j].x + v[j].y * v[j].y) + (v[j].z * v[j].z + v[j].w * v[j].w); }
            const float rstd = 1.0f / sqrtf(wave_sum(ss) * (1.0f / DM) + RMS_EPS);
            float f[8] = {0.f, 0.f, 0.f, 0.f, 0.f, 0.f, 0.f, 0.f};
            v2u* o8 = (v2u*)(HN + (size_t)row * DM) + F.lane; unsigned* o4 = (unsigned*)(F.ws + WS_HN8 + (size_t)row * DM) + F.lane;
#pragma unroll
            for (int j = 0; j < 8; ++j) { const f32x4 h = v[j] * rstd * gm[64 * j];
                v2u w; w.x = pkbf(h.x, h.y); w.y = pkbf(h.z, h.w); o8[64 * j] = w; o4[64 * j] = pg8::pk4_fp8(h.x, h.y, h.z, h.w);
#pragma unroll
                for (int q = 0; q < 4; ++q) { const int k = (F.lane + 64 * j) * 4 + q; const f32x4 w0 = wfl[2 * k], w1 = wfl[2 * k + 1]; const float hq = h[q];
                    f[0] += hq * w0.x; f[1] += hq * w0.y; f[2] += hq * w0.z; f[3] += hq * w0.w; f[4] += hq * w1.x; f[5] += hq * w1.y; f[6] += hq * w1.z; f[7] += hq * w1.w; } }
#pragma unroll
            for (int q = 0; q < 8; ++q) f[q] = wave_sum(f[q]);
            if (F.lane < 8) { float z = F.lane == 0 ? f[0] : F.lane == 1 ? f[1] : F.lane == 2 ? f[2] : F.lane == 3 ? f[3] : F.lane == 4 ? f[4] : F.lane == 5 ? f[5] : F.lane == 6 ? f[6] : f[7];
                z += F.b_forget[F.lane];
                LOGF[(size_t)F.lane * T + row] = fminf(z, 0.f) - log1pf(expf(-fabsf(z))); }
        }
    }
    __syncthreads();
}
constexpr int CONV_SPLIT = 4, CONV_ITEMS = 16 / CONV_SPLIT;
constexpr int CONV_BATCHES = NE * 24 * CONV_SPLIT;
__device__ __forceinline__ void conv_ptrs(const Frame& F, int e, int rb, int j, const float*& src, unsigned char*& dst, int& ldw) {
    if (rb < 16) { const int kk = j, nb = rb; ldw = 2 * DFF;
        src = F.w1 + (size_t)e * DM * 2 * DFF + (size_t)(kk * 128) * (2 * DFF) + nb * 256; dst = F.ws + WS_W1 + (size_t)e * 2 * DFF * DM + (size_t)(nb * 256) * DM + kk * 128; }
    else { const int nb = rb - 16, kk = j; ldw = DM;
        src = F.w2 + (size_t)e * DFF * DM + (size_t)(kk * 128) * DM + nb * 256; dst = F.ws + WS_W2 + (size_t)e * DM * DFF + (size_t)(nb * 256) * DFF + kk * 128; }
}
__device__ __forceinline__ void p2_convert(Frame& F, unsigned* qhead, LAS int* qslot) {
    LAS unsigned char* wscr = F.lds + RING_OFF + F.wave * (32 * 144);
    const int kg = F.lane >> 3, cg = F.lane & 7, c = F.lane & 7, n = F.lane >> 3;
    for (;;) {
        if (F.tid == 0) *qslot = (int)__hip_atomic_fetch_add(qhead, 1u, __ATOMIC_RELAXED, __HIP_MEMORY_SCOPE_AGENT);
        __syncthreads(); const int b = *qslot; __syncthreads();
        if (b >= CONV_BATCHES) break;
        const int eq = b / 24, rb = b - eq * 24, e = eq / CONV_SPLIT, j0 = (eq - e * CONV_SPLIT) * CONV_ITEMS;
        f32x4 va[8], vb[8]; const float* src; unsigned char* dst; int ldw; const int K = rb < 16 ? DM : DFF;
        conv_ptrs(F, e, rb, j0, src, dst, ldw); src += F.wave * 32; conv_load(va, src, ldw, 0, kg, cg);
        for (int j = j0; j < j0 + CONV_ITEMS; ++j) {
            conv_load(vb, src, ldw, 1, kg, cg);
            conv_to_lds(va, wscr, 0, kg, cg);
            unsigned char* dcur = dst + (size_t)(F.wave * 32) * K;
            if (j + 1 < j0 + CONV_ITEMS) { conv_ptrs(F, e, rb, j + 1, src, dst, ldw); src += F.wave * 32; conv_load(va, src, ldw, 0, kg, cg); }
            conv_to_lds(vb, wscr, 1, kg, cg);
            asm volatile("s_waitcnt lgkmcnt(0)" ::: "memory");
#pragma unroll
            for (int i = 0; i < 4; ++i) { const int nn = n + 8 * i; const v4u o = *(const LAS v4u*)(wscr + nn * 144 + c * 16); __builtin_nontemporal_store(o, (v4u*)(dcur + (size_t)nn * K + c * 16)); }
            asm volatile("s_waitcnt lgkmcnt(0)" ::: "memory");
        }
    }
}
__device__ __forceinline__ void p5_router(Frame& F) {
    const float* X1 = (const float*)(F.ws + WS_X1); unsigned char* AS = F.ws + WS_AS; int* STOK = (int*)(F.ws + WS_STOK); float* SW = (float*)(F.ws + WS_SW);
    LAS float* red = (LAS float*)(F.lds + RING_OFF);
    LAS float* ssqs = red + 8 * 1024;
    LAS float* lg = ssqs + 8 * 32;
    LAS float* rstdl = lg + 32 * 33;
    LAS float* selw = rstdl + 32;
    LAS int* sele = (LAS int*)(selw + 128);
    LAS int* sellp = sele + 128;
    LAS int* dest = sellp + 128;
    LAS int* lcnt = dest + 128;
    LAS int* gbase = lcnt + 32;
    const int i32 = F.lane & 31, kk = F.lane >> 5;
    for (int tb = F.vcu; tb < T / 32; tb += F.G) {
        const int tok0 = tb * 32;
        {
            f32x16 C = {}; float ssq = 0.f; const int k0 = 256 * F.wave;
            const float* xr = X1 + (size_t)(tok0 + i32) * DM + k0 + 4 * kk;
#pragma unroll 4
            for (int u = 0; u < 32; ++u) { const f32x4 a = *(const f32x4*)(xr + 8 * u); ssq += (a.x * a.x + a.y * a.y) + (a.z * a.z + a.w * a.w);
#pragma unroll
                for (int v = 0; v < 4; ++v) { const int k = k0 + 8 * u + 4 * kk + v; const float b = F.w_router[(size_t)k * NE + i32] * F.g_ffn[k];
                    C = __builtin_amdgcn_mfma_f32_32x32x2f32(a[v], b, C, 0, 0, 0); } }
#pragma unroll
            for (int r = 0; r < 16; ++r) red[F.wave * 1024 + ((r & 3) + 8 * (r >> 2) + 4 * kk) * 32 + i32] = C[r];
            ssq += __shfl_xor(ssq, 32);
            if (kk == 0) ssqs[F.wave * 32 + i32] = ssq;
        }
        __syncthreads();
        for (int idx = F.tid; idx < 1024; idx += NWAVES * 64) { const int tk = idx >> 5, e = idx & 31; float s = 0.f, q = 0.f;
#pragma unroll
            for (int w = 0; w < 8; ++w) { s += red[w * 1024 + idx]; q += ssqs[w * 32 + tk]; }
            const float rstd = 1.0f / sqrtf(q * (1.0f / DM) + RMS_EPS);
            lg[tk * 33 + e] = s * rstd + F.b_router[e]; if (e == 0) rstdl[tk] = rstd; }
        if (F.tid < 32) lcnt[F.tid] = 0;
        __syncthreads();
        if (F.tid < 32) {
            float tv[4]; int te[4];
#pragma unroll
            for (int k = 0; k < 4; ++k) { float best = -__builtin_inff(); int bi = 0;
                for (int e = 0; e < NE; ++e) { const float v = lg[F.tid * 33 + e]; if (v > best) { best = v; bi = e; } }
                tv[k] = best; te[k] = bi; lg[F.tid * 33 + bi] = -__builtin_inff(); }
            float ew[4], sum = 0.f;
#pragma unroll
            for (int k = 0; k < 4; ++k) { ew[k] = expf(tv[k] - tv[0]); sum += ew[k]; }
            const float inv = 1.0f / sum;
#pragma unroll
            for (int k = 0; k < 4; ++k) { sele[F.tid * 4 + k] = te[k]; selw[F.tid * 4 + k] = ew[k] * inv; sellp[F.tid * 4 + k] = atomicAdd((int*)(lcnt + te[k]), 1); }
        }
        __syncthreads();
        if (F.tid < 32) { const int n = lcnt[F.tid]; gbase[F.tid] = n > 0 ? (int)__hip_atomic_fetch_add((unsigned*)(F.ctl + CW_CNT + 64 * F.tid), (unsigned)n, __ATOMIC_RELAXED, __HIP_MEMORY_SCOPE_AGENT) : 0; }
        __syncthreads();
        if (F.tid < 128) { const int e = sele[F.tid]; int pos = gbase[e] + sellp[F.tid]; if (pos >= CAP) pos = CAP - 1; const int row = e * CAP + pos;
            STOK[(tok0 + (F.tid >> 2)) * 4 + (F.tid & 3)] = row; SW[row] = selw[F.tid]; dest[F.tid] = row; }
        __syncthreads();
        for (int j4 = 0; j4 < 4; ++j4) {
            const int ti = F.wave * 4 + j4; const float rstd = rstdl[ti];
            const f32x4* xr = (const f32x4*)(X1 + (size_t)(tok0 + ti) * DM) + F.lane; const f32x4* gm = (const f32x4*)F.g_ffn + F.lane;
            unsigned w[8];
#pragma unroll
            for (int j = 0; j < 8; ++j) { const f32x4 h = xr[64 * j] * rstd * gm[64 * j]; w[j] = pg8::pk4_fp8(h.x, h.y, h.z, h.w); }
#pragma unroll
            for (int k = 0; k < 4; ++k) { unsigned* o4 = (unsigned*)(AS + (size_t)dest[ti * 4 + k] * DM) + F.lane;
#pragma unroll
                for (int j = 0; j < 8; ++j) o4[64 * j] = w[j]; }
        }
        __syncthreads();
    }
}
__device__ __forceinline__ void p8_final(Frame& F) {
    const float* X1 = (const float*)(F.ws + WS_X1); const bf16* Y = (const bf16*)(F.ws + WS_Y); const int* TSLOT = (const int*)(F.ws + WS_STOK);
    const int gw = F.vcu * NWAVES + F.wave, NGW = F.G * NWAVES;
    for (int row = gw; row < T; row += NGW) {
        const f32x4* xr = (const f32x4*)(X1 + (size_t)row * DM) + F.lane; const f32x4* gf = (const f32x4*)F.g_final + F.lane;
        const int sl = (int)__hip_atomic_load((const unsigned*)TSLOT + row * 4 + (F.lane & 3), __ATOMIC_RELAXED, __HIP_MEMORY_SCOPE_AGENT);
        int slot[4];
#pragma unroll
        for (int k = 0; k < 4; ++k) slot[k] = __shfl(sl, k);
        f32x4 v[8]; float ss = 0.f;
#pragma unroll
        for (int j = 0; j < 8; ++j) { v[j] = xr[64 * j];
#pragma unroll
            for (int k = 0; k < 4; ++k) { const v2u y = ((const v2u*)(Y + (size_t)slot[k] * DM) + F.lane)[64 * j];
                v[j].x += pg8::bf_lo(y.x); v[j].y += pg8::bf_hi(y.x); v[j].z += pg8::bf_lo(y.y); v[j].w += pg8::bf_hi(y.y); }
            ss += (v[j].x * v[j].x + v[j].y * v[j].y) + (v[j].z * v[j].z + v[j].w * v[j].w); }
        const float rstd = 1.0f / sqrtf(wave_sum(ss) * (1.0f / DM) + RMS_EPS);
        f32x4* o = (f32x4*)(F.out + (size_t)row * DM) + F.lane;
#pragma unroll
        for (int j = 0; j < 8; ++j) o[64 * j] = v[j] * rstd * gf[64 * j];
    }
}

struct Args { const float* in[16]; float* out; unsigned char* ws; int ph_lo, ph_hi; };
__global__ void __launch_bounds__(NWAVES * 64, 2) mk_fwd(Args args) {
    extern __shared__ __attribute__((aligned(16))) unsigned char lds[];
    Frame F;
    F.lds = (LAS unsigned char*)lds;
    F.MISC = (volatile LAS unsigned*)(F.lds + MISC_OFF);
    F.tid = threadIdx.x; F.lane = F.tid & 63; F.wave = __builtin_amdgcn_readfirstlane(F.tid >> 6);
    F.G = gridDim.x; { const int bx = blockIdx.x; F.vcu = (F.G % 8 == 0) ? (bx % 8) * (F.G / 8) + bx / 8 : bx; }
    unsigned char* ws = args.ws; F.ws = ws; F.out = args.out;
    F.ctl = (gu32*)(ws + WS_CTL);
    F.x = args.in[0]; F.g_mix = args.in[1]; F.w_in = args.in[2]; F.b_forget = args.in[3]; F.b_gate = args.in[4]; F.w_psb = args.in[5]; F.w_pfx = args.in[6]; F.w_out = args.in[7];
    F.g_ffn = args.in[8]; F.w_router = args.in[9]; F.b_router = args.in[10]; F.w1 = args.in[11]; F.b1 = args.in[12]; F.w2 = args.in[13]; F.b2 = args.in[14]; F.g_final = args.in[15];
    for (int u = F.tid; u < (LDS_BYTES - LDSCTL_OFF) / 4; u += NWAVES * 64) ((LAS unsigned*)(F.lds + LDSCTL_OFF))[u] = 0u;
    __syncthreads();
    XcdBarrier bar; bar.bar = (unsigned*)(F.ctl + CW_BAR); bar.x = 0; bar.st = nullptr;
    if (N_LAUNCHES != PER_PHASE) bar = xcd_barrier_post((unsigned*)(F.ctl + CW_BAR), F.MISC + 8);
#define GRID_BAR(seam) do { if (N_LAUNCHES == PER_PHASE) { if (F.tid == 0) __hip_atomic_store(F.ctl + CW_TMO, 0xBADBA0u | (unsigned)(seam), RLX_AGENT); } else { xcd_barrier(bar); } } while (0)
    const int lo = args.ph_lo, hi = args.ph_hi;
#define IN(k) (lo <= (k) && (k) < hi)
#define BOTH(k) (IN(k) && IN((k) + 1))
    bf16* HN = (bf16*)(ws + WS_HN); bf16* QKV = (bf16*)(ws + WS_QKV); bf16* GATES = (bf16*)(ws + WS_GATES);
    bf16* OSB = (bf16*)(ws + WS_OSB); bf16* OFX = (bf16*)(ws + WS_OFX); bf16* MIXED = (bf16*)(ws + WS_MIXED);
    float* PART = (float*)(ws + WS_PART); float* X1 = (float*)(ws + WS_X1);
    unsigned char* AS = ws + WS_AS; unsigned char* HB = ws + WS_H; bf16* YB = (bf16*)(ws + WS_Y);

    if (IN(0)) { p0_prologue(F); if (BOTH(0)) GRID_BAR(0); }

    if (IN(1)) {
        { pg8::TileOrder S; S.init(HN, ws + WS_WIN, T, 6 * DH, DM, F.G, (int)blockIdx.x);
          pg8::EpiP1 E{QKV, QKV_STRIDE / 2, (unsigned*)(F.ctl + CW_KM)};
          pg8::gemm_phase<pg8::EpiP1, pg8::TileOrder, true, true>(F.lds + RING_OFF, DM, S, E); }
        { pg8::TileOrder S; S.init(ws + WS_HN8, ws + WS_WIN8, T, 2 * DM, DM, F.G, (int)blockIdx.x, 1);
          pg8::EpiGates E{GATES, F.b_gate};
          pg8::gemm_phase<pg8::EpiGates, pg8::TileOrder, true, true, 1>(F.lds + RING_OFF, DM, S, E); }
        if (BOTH(1)) GRID_BAR(1);
    }

    if (IN(2)) {
        const float* LOGFall = (const float*)(ws + WS_LOGF);
        const int hq = (int)blockIdx.x & 7;
        att::ALAS_char_ptr alds = (att::ALAS_char_ptr)(F.lds + RING_OFF);
        LAS int* qslot = (LAS int*)(F.lds + RING_OFF + att::OFF_FLAG + 64);
        float* PARTF = (float*)(ws + WS_PART);
        const bool conv_first = (((int)blockIdx.x >> 3) & 7) < CONV_FIRST_OF8;
        if (conv_first) p2_convert(F, (unsigned*)(F.ctl + CW_QC), qslot);
#define P2_PULL(cw, limit) do { if (F.wave == 0) { int c_ = (limit); if (F.lane < 8) c_ = (int)__hip_atomic_load((const unsigned*)(F.ctl + (cw) + 64 * F.lane), __ATOMIC_RELAXED, __HIP_MEMORY_SCOPE_AGENT); \
            int bh_ = -1, bc_ = (limit); _Pragma("unroll") for (int j_ = 0; j_ < 8; ++j_) { const int cj_ = __shfl(c_, j_); if (cj_ < bc_) { bc_ = cj_; bh_ = j_; } } \
            { const int own_ = __shfl(c_, hq); if (own_ < (limit)) bh_ = hq; } \
            if (F.lane == 0) { int it_ = (limit); if (bh_ >= 0) it_ = (int)__hip_atomic_fetch_add((unsigned*)(F.ctl + (cw) + 64 * bh_), 1u, __ATOMIC_RELAXED, __HIP_MEMORY_SCOPE_AGENT); qslot[0] = bh_; qslot[1] = it_; } } \
        __syncthreads(); } while (0)
        for (;;) {
            P2_PULL(CW_QF, 48);
            const int h = qslot[0], it = qslot[1]; __syncthreads();
            if (h < 0) break;
            if (it >= 48) continue;
            int qb, mode;
            if (it < 16) { qb = 31 - it; mode = 1; }
            else { const int k = it - 16; if (k < 24) { const int g = k / 3, j = k - 3 * g; qb = j == 0 ? 15 - g : 31 - 2 * g - (j - 1); } else qb = 31 - k; mode = qb >= 16 ? 2 : 0; }
            const int NT = 4 * (qb + 1), t0 = mode == 1 ? NT / 2 : 0, t1 = mode == 2 ? NT / 2 : NT;
            const int slot = h * 16 + (qb & 15);
            att::fox_unit(QKV + 3 * (QKV_STRIDE / 2) + h * HD, QKV + 4 * (QKV_STRIDE / 2) + h * HD, QKV + 5 * (QKV_STRIDE / 2) + h * HD, OFX + h * HD, LOGFall + (size_t)h * T, qb, t0, t1, mode,
                          PARTF + (size_t)slot * (att::QB * att::D + 2 * att::QB), (unsigned*)(F.ctl + CW_FLAG + 64 * slot), (unsigned*)(F.ctl + CW_TMO), (const unsigned*)(F.ctl + CW_KM + 4 * h), alds);
        }
        for (;;) {
            P2_PULL(CW_QS, 32);
            const int h = qslot[0], it = qslot[1]; __syncthreads();
            if (h < 0) break;
            if (it >= 32) continue;
            att::sb_unit(QKV + 0 * (QKV_STRIDE / 2) + h * HD, QKV + 1 * (QKV_STRIDE / 2) + h * HD, QKV + 2 * (QKV_STRIDE / 2) + h * HD, OSB + h * HD, 31 - it, alds);
        }
#undef P2_PULL
        if (!conv_first) p2_convert(F, (unsigned*)(F.ctl + CW_QC), qslot);
        if (BOTH(2)) GRID_BAR(2);
    }

    if (IN(3)) {
        pg8::MixOrder S; S.t.init(OSB, ws + WS_WPA, T, DM, DH, F.G, (int)blockIdx.x); S.A1 = (const char*)OFX; S.B1 = (const char*)(ws + WS_WPB);
        pg8::EpiMix E{GATES, PART, MIXED};
        pg8::gemm_phase<pg8::EpiMix, pg8::MixOrder, false, true>(F.lds + RING_OFF, DH, S, E);
        if (BOTH(3)) GRID_BAR(3);
    }

    if (IN(4)) {
        pg8::TileOrder S; S.init(MIXED, ws + WS_WOUT, T, DM, DM, F.G, (int)blockIdx.x);
        pg8::EpiResid E{F.x, X1};
        pg8::gemm_phase<pg8::EpiResid, pg8::TileOrder, false, true>(F.lds + RING_OFF, DM, S, E);
        if (BOTH(4)) GRID_BAR(4);
    }

    if (IN(5)) { p5_router(F); if (BOTH(5)) GRID_BAR(5); }

    if (IN(6) || IN(7)) {
        LAS int* cntl = (LAS int*)(F.lds + TAB_OFF); LAS int* pref = cntl + 32;
        if (F.tid < 32) { int n = (int)__hip_atomic_load(F.ctl + CW_CNT + 64 * F.tid, RLX_AGENT); cntl[F.tid] = n > CAP ? CAP : n; }
        __syncthreads();
        if (F.tid == 0) { int p = 0; for (int e = 0; e < NE; ++e) { pref[e] = p; p += (cntl[e] + 255) >> 8; } pref[NE] = p; }
        __syncthreads();
        if (IN(6)) {
            pg8::MoeOrder S{(const char*)AS, (const char*)(ws + WS_W1), (const PG8_LAS int*)pref, (size_t)CAP * DM, (size_t)2 * DFF * DM, (size_t)256 * DM, (2 * DFF) / 256, CAP / 256, F.G, F.vcu};
            pg8::EpiSwiglu E{F.b1, HB};
            pg8::gemm_phase<pg8::EpiSwiglu, pg8::MoeOrder, true, true, 1>(F.lds + RING_OFF, DM, S, E);
            if (BOTH(6)) GRID_BAR(6);
        }
        if (IN(7)) {
            pg8::MoeOrder S{(const char*)HB, (const char*)(ws + WS_W2), (const PG8_LAS int*)pref, (size_t)CAP * DFF, (size_t)DM * DFF, (size_t)256 * DFF, DM / 256, CAP / 256, F.G, F.vcu};
            pg8::EpiMoeOut E{F.b2, (const float*)(ws + WS_SW), YB};
            pg8::gemm_phase<pg8::EpiMoeOut, pg8::MoeOrder, true, true, 1>(F.lds + RING_OFF, DFF, S, E);
            if (BOTH(7)) GRID_BAR(7);
        }
    }

    if (IN(8)) p8_final(F);
#undef IN
#undef BOTH
}

extern "C" void kernel_launch(void* const* d_in, const int* in_sizes, int n_in, void* d_out, int out_size, void* d_ws, size_t ws_size, hipStream_t stream) {
    static int grid = 0;
    if (grid == 0) {
        if (n_in != 16 || in_sizes[0] != T * DM || out_size != T * DM || ws_size < WS_END) { fprintf(stderr, "kernel_launch: built for 16 inputs, x/out of %d floats, >= %zu bytes of workspace; got n_in %d, in0 %d, out %d, ws %zu; nothing launched\n", T * DM, (size_t)WS_END, n_in, n_in > 0 ? in_sizes[0] : -1, out_size, ws_size); grid = -1; return; }
        int dev = 0, cus = 0, per_cu = 0;
        if (hipGetDevice(&dev) != hipSuccess || hipDeviceGetAttribute(&cus, hipDeviceAttributeMultiprocessorCount, dev) != hipSuccess) { fprintf(stderr, "kernel_launch: hipGetDevice / hipDeviceGetAttribute failed\n"); grid = -1; return; }
        if (hipFuncSetAttribute((const void*)mk_fwd, hipFuncAttributeMaxDynamicSharedMemorySize, LDS_BYTES) != hipSuccess) { fprintf(stderr, "kernel_launch: hipFuncSetAttribute failed\n"); grid = -1; return; }
        if (hipOccupancyMaxActiveBlocksPerMultiprocessor(&per_cu, (const void*)mk_fwd, NWAVES * 64, LDS_BYTES) != hipSuccess || per_cu < 1)
            fprintf(stderr, "kernel_launch: note: the occupancy query reports %d workgroups per CU\n", per_cu);
        (void)hipGetLastError();
        grid = cus;
    }
    if (grid < 0) return;
    if (hipMemsetAsync((char*)d_ws + WS_CTL, 0, CTL_ZERO_BYTES, stream) != hipSuccess) { fprintf(stderr, "kernel_launch: hipMemsetAsync failed\n"); return; }
    Args a{};
    for (int i = 0; i < 16; ++i) a.in[i] = (const float*)d_in[i];
    a.out = (float*)d_out; a.ws = (unsigned char*)d_ws;
    if (N_LAUNCHES == 1) { a.ph_lo = 0; a.ph_hi = PER_PHASE; hipLaunchKernelGGL(mk_fwd, dim3(grid), dim3(NWAVES * 64), LDS_BYTES, stream, a); }
    else for (int li = 0; li < PER_PHASE; ++li) { a.ph_lo = li; a.ph_hi = li + 1; hipLaunchKernelGGL(mk_fwd, dim3(grid), dim3(NWAVES * 64), LDS_BYTES, stream, a); }
    const hipError_t le = hipPeekAtLastError();
    if (le != hipSuccess) fprintf(stderr, "kernel_launch: launch failed: %s (grid %d)\n", hipGetErrorName(le), grid);
}
```

```cpp
#include <hip/hip_runtime.h>
#include <hip/hip_bf16.h>
#include <cstdio>
#include <cstdint>

#ifndef CONV_FIRST_OF8
#define CONV_FIRST_OF8 5
#endif
#ifndef MK_N_LAUNCHES
#define MK_N_LAUNCHES 1
#endif

namespace pg8 {
#define PG8_LAS __attribute__((address_space(3)))
typedef unsigned short bf16_t;
typedef short bf16x8 __attribute__((ext_vector_type(8)));
typedef float f32x4 __attribute__((ext_vector_type(4)));
typedef unsigned u32x4 __attribute__((ext_vector_type(4)));
typedef unsigned u32x2 __attribute__((ext_vector_type(2)));
constexpr int BM = 256, BK = 64, HALF = 128, HTB = HALF * BK * 2  , STAGE_BYTES = 8 * HTB, NXCD = 8, WGM = 8;

__host__ __device__ __forceinline__ int lds_byte(int r, int c) { const int st = (r >> 4) * 2 + (c >> 5), rr = r & 15, cc = c & 31, ob = rr * 64 + cc * 2; return st * 1024 + (ob ^ (((ob >> 9) & 1) << 5)); }
__host__ __device__ __forceinline__ void stage_rc(int b, int& R, int& C) { const int st = b / 1024, sb = b % 1024, swz = sb ^ (((sb >> 9) & 1) << 5); R = (st >> 1) * 16 + swz / 64; C = (st & 1) * 32 + (swz % 64) / 2; }
__host__ __device__ __forceinline__ int perm32(int rho) { const int n = rho >> 4, i = rho & 15; return 8 * (i >> 2) + 4 * n + (i & 3); }

struct Unit { const char* a; const char* b; int pm, pn, aux; };

typedef float f32x2_c __attribute__((ext_vector_type(2))); typedef __bf16 bf16x2_c __attribute__((ext_vector_type(2)));
__device__ __forceinline__ unsigned cvt_pk_bf16(float lo, float hi) { const f32x2_c v = {lo, hi}; const bf16x2_c b = __builtin_convertvector(v, bf16x2_c); return __builtin_bit_cast(unsigned, b); }
__device__ __forceinline__ unsigned pk4_fp8(float a, float b, float c, float d) { unsigned w = 0u; w = (unsigned)__builtin_amdgcn_cvt_pk_fp8_f32(a, b, (int)w, false); w = (unsigned)__builtin_amdgcn_cvt_pk_fp8_f32(c, d, (int)w, true); return w; }
constexpr float Y8_SCALE = 16.0f, Y8_INV = 1.0f / 16.0f;
constexpr float W8_SCALE = 64.0f, W8_INV = 1.0f / 64.0f;
__device__ __forceinline__ float bf_lo(unsigned u) { return __uint_as_float(u << 16); }
__device__ __forceinline__ float bf_hi(unsigned u) { return __uint_as_float(u & 0xffff0000u); }
__device__ __forceinline__ float sigmoidf_fast(float x) { return __builtin_amdgcn_rcpf(1.0f + __builtin_amdgcn_exp2f(-1.4426950408889634f * x)); }

struct TileOrder {
    const char* A; const char* Bt; size_t tstepA, tstepB; int nM, nN, nwg, G, c;
    __device__ __forceinline__ void init(const void* A_, const void* Bt_, int M, int N, int K, int G_, int c_, int esz = 2) { A = (const char*)A_; Bt = (const char*)Bt_; tstepA = (size_t)BM * K * esz; tstepB = tstepA; nM = M / BM; nN = N / BM; nwg = nM * nN; G = G_; c = c_; }
    __device__ __forceinline__ bool map(int L, int& pm, int& pn) const {
        if (L >= nwg) return false;
        int wgid = L; { const int q = nwg / NXCD, r = nwg % NXCD, xcd = wgid % NXCD, off = wgid / NXCD; wgid = (xcd < r ? xcd * (q + 1) : r * (q + 1) + (xcd - r) * q) + off; }
        const int nig = WGM * nN, gid = wgid / nig, fm = gid * WGM, gsz = (nM - fm) < WGM ? (nM - fm) : WGM;
        pm = fm + ((wgid % nig) % gsz); pn = (wgid % nig) / gsz; return true;
    }
    __device__ __forceinline__ bool next(int i, Unit& u) const {
        int pm, pn; if (!map(i * G + c, pm, pn)) return false;
        u.pm = pm; u.pn = pn; u.aux = 0; u.a = A + (size_t)pm * tstepA; u.b = Bt + (size_t)pn * tstepB; return true;
    }
    __device__ __forceinline__ void a_ready(const Unit&) const {}
    __device__ __forceinline__ void done(const Unit&) const {}
};
struct MixOrder {
    TileOrder t; const char* A1; const char* B1;
    __device__ __forceinline__ bool next(int i, Unit& u) const {
        int pm, pn; if (!t.map((i >> 1) * t.G + t.c, pm, pn)) return false;
        u.pm = pm; u.pn = pn; u.aux = i & 1;
        u.a = ((i & 1) ? A1 : t.A) + (size_t)pm * t.tstepA; u.b = ((i & 1) ? B1 : t.Bt) + (size_t)pn * t.tstepB; return true;
    }
    __device__ __forceinline__ void a_ready(const Unit&) const {}
    __device__ __forceinline__ void done(const Unit&) const {}
};
struct MoeOrder {
    const char* A; const char* Bt; const PG8_LAS int* pref;
    size_t a_estride, b_estride, tstep; int NT, cap_tiles, G, c;
    __device__ __forceinline__ bool next(int i, Unit& u) const {
        const int L = i * G + c; const int total = pref[32] * NT; if (L >= total) return false;
        int e = 0;
#pragma unroll 1
        for (int j = 1; j < 32; ++j) if (pref[j] * NT <= L) e = j;
        const int me = pref[e + 1] - pref[e], q = L - pref[e] * NT, nt = q / me, mt = q - nt * me;
        u.aux = e; u.pm = e * cap_tiles + mt; u.pn = nt;
        u.a = A + (size_t)e * a_estride + (size_t)mt * tstep; u.b = Bt + (size_t)e * b_estride + (size_t)nt * tstep; return true;
    }
    __device__ __forceinline__ void a_ready(const Unit&) const {}
    __device__ __forceinline__ void done(const Unit&) const {}
};

struct EpiP1 {
    static constexpr bool PERM = true, AFTER_DRAIN = false;
    bf16_t* qkv; size_t buf_stride; unsigned* km;
    __device__ __forceinline__ void operator()(const f32x4 (&acc)[2][2][4][2], const Unit& u, int wr, int wc, int fr, int fq) const {
        const int row0 = u.pm * BM + wr * 64 + fr;
        {
            bf16_t* base = qkv + (size_t)(u.pn >> 2) * buf_stride; const int col0 = (u.pn & 3) * BM + wc * 32 + 8 * fq;
            const bool kfx = u.pn >= 16 && u.pn < 20;
            float mx[2] = {0.f, 0.f};
#pragma unroll
            for (int ai = 0; ai < 2; ++ai)
#pragma unroll
                for (int m = 0; m < 4; ++m) { bf16_t* rowp = base + (size_t)(row0 + ai * HALF + m * 16) * 1024 + col0;
#pragma unroll
                    for (int bj = 0; bj < 2; ++bj) { const f32x4 v0 = acc[ai][bj][m][0], v1 = acc[ai][bj][m][1];
                        u32x4 w; w.x = cvt_pk_bf16(v0[0], v0[1]); w.y = cvt_pk_bf16(v0[2], v0[3]); w.z = cvt_pk_bf16(v1[0], v1[1]); w.w = cvt_pk_bf16(v1[2], v1[3]);
                        *(u32x4*)(rowp + bj * HALF) = w;
                        if (kfx) { float q = bf_lo(w.x) * bf_lo(w.x) + bf_hi(w.x) * bf_hi(w.x) + bf_lo(w.y) * bf_lo(w.y) + bf_hi(w.y) * bf_hi(w.y)
                                           + bf_lo(w.z) * bf_lo(w.z) + bf_hi(w.z) * bf_hi(w.z) + bf_lo(w.w) * bf_lo(w.w) + bf_hi(w.w) * bf_hi(w.w);
                            q += __shfl_xor(q, 16); q += __shfl_xor(q, 32); mx[bj] = fmaxf(mx[bj], q); } } }
            if (kfx) {
#pragma unroll
                for (int bj = 0; bj < 2; ++bj) { float q = mx[bj];
#pragma unroll
                    for (int o = 1; o < 16; o <<= 1) q = fmaxf(q, __shfl_xor(q, o));
                    if (fr == 0 && fq == 0) __hip_atomic_fetch_max(km + (2 * (u.pn - 16) + bj) * 4 + wc, __float_as_uint(q), __ATOMIC_RELAXED, __HIP_MEMORY_SCOPE_AGENT); } }
        }
    }
};
struct EpiGates {
    static constexpr bool PERM = true, AFTER_DRAIN = false;
    bf16_t* gates; const float* b_gate;
    __device__ __forceinline__ void operator()(const f32x4 (&acc)[2][2][4][2], const Unit& u, int wr, int wc, int fr, int fq) const {
        const int row0 = u.pm * BM + wr * 64 + fr, gc0 = u.pn * BM + wc * 32 + 8 * fq;
        f32x4 bv[2][2];
#pragma unroll
        for (int bj = 0; bj < 2; ++bj)
#pragma unroll
            for (int n = 0; n < 2; ++n) bv[bj][n] = *(const f32x4*)(b_gate + gc0 + bj * HALF + 4 * n);
#pragma unroll
        for (int ai = 0; ai < 2; ++ai)
#pragma unroll
            for (int m = 0; m < 4; ++m) { bf16_t* rowp = gates + (size_t)(row0 + ai * HALF + m * 16) * 4096 + gc0;
#pragma unroll
                for (int bj = 0; bj < 2; ++bj) { f32x4 v0 = acc[ai][bj][m][0] * W8_INV + bv[bj][0], v1 = acc[ai][bj][m][1] * W8_INV + bv[bj][1];
#pragma unroll
                    for (int q = 0; q < 4; ++q) { v0[q] = sigmoidf_fast(v0[q]); v1[q] = sigmoidf_fast(v1[q]); }
                    u32x4 w; w.x = cvt_pk_bf16(v0[0], v0[1]); w.y = cvt_pk_bf16(v0[2], v0[3]); w.z = cvt_pk_bf16(v1[0], v1[1]); w.w = cvt_pk_bf16(v1[2], v1[3]);
                    *(u32x4*)(rowp + bj * HALF) = w; } }
    }
};
struct EpiMix {
    static constexpr bool PERM = true, AFTER_DRAIN = false;
    const bf16_t* gates; float* part; bf16_t* mixed;
    __device__ __forceinline__ void operator()(const f32x4 (&acc)[2][2][4][2], const Unit& u, int wr, int wc, int fr, int fq) const {
        const int row0 = u.pm * BM + wr * 64 + fr, col0 = u.pn * BM + wc * 32 + 8 * fq; const int goff = u.aux ? 2048 : 0;
#pragma unroll
        for (int ai = 0; ai < 2; ++ai) {
            u32x4 g[4][2];
#pragma unroll
            for (int m = 0; m < 4; ++m)
#pragma unroll
                for (int bj = 0; bj < 2; ++bj) g[m][bj] = *(const u32x4*)(gates + (size_t)(row0 + ai * HALF + m * 16) * 4096 + goff + col0 + bj * HALF);
            u32x4 pq[4][2];
            if (u.aux) {
#pragma unroll
                for (int m = 0; m < 4; ++m)
#pragma unroll
                    for (int bj = 0; bj < 2; ++bj) pq[m][bj] = *(const u32x4*)((const bf16_t*)part + (size_t)(row0 + ai * HALF + m * 16) * 2048 + col0 + bj * HALF); }
            asm volatile("" ::: "memory");
#pragma unroll
            for (int mp = 0; mp < 2; ++mp) {
#pragma unroll
                for (int mm = 0; mm < 2; ++mm)
#pragma unroll
                    for (int bj = 0; bj < 2; ++bj) { const int m = 2 * mp + mm; const size_t row = (size_t)(row0 + ai * HALF + m * 16); const int c = col0 + bj * HALF;
                        const u32x4 gg = g[m][bj]; const f32x4 a0 = acc[ai][bj][m][0], a1 = acc[ai][bj][m][1];
                        f32x4 r0 = {bf_lo(gg.x) * a0[0], bf_hi(gg.x) * a0[1], bf_lo(gg.y) * a0[2], bf_hi(gg.y) * a0[3]};
                        f32x4 r1 = {bf_lo(gg.z) * a1[0], bf_hi(gg.z) * a1[1], bf_lo(gg.w) * a1[2], bf_hi(gg.w) * a1[3]};
                        bf16_t* pp = (bf16_t*)part + row * 2048 + c;
                        if (u.aux == 0) { u32x4 w; w.x = cvt_pk_bf16(r0[0], r0[1]); w.y = cvt_pk_bf16(r0[2], r0[3]); w.z = cvt_pk_bf16(r1[0], r1[1]); w.w = cvt_pk_bf16(r1[2], r1[3]); *(u32x4*)pp = w; }
                        else { const u32x4 q = pq[m][bj]; r0 += (f32x4){bf_lo(q.x), bf_hi(q.x), bf_lo(q.y), bf_hi(q.y)}; r1 += (f32x4){bf_lo(q.z), bf_hi(q.z), bf_lo(q.w), bf_hi(q.w)};
                            u32x4 w; w.x = cvt_pk_bf16(r0[0], r0[1]); w.y = cvt_pk_bf16(r0[2], r0[3]); w.z = cvt_pk_bf16(r1[0], r1[1]); w.w = cvt_pk_bf16(r1[2], r1[3]);
                            *(u32x4*)(mixed + row * 2048 + c) = w; } }
                asm volatile("" ::: "memory");
            }
        }
    }
};
struct EpiResid {
    static constexpr bool PERM = false, AFTER_DRAIN = false;
    const float* x; bf16_t* x1;
    __device__ __forceinline__ void operator()(const f32x4 (&acc)[2][2][4][2], const Unit& u, int wr, int wc, int fr, int fq) const {
        const int row0 = u.pm * BM + wr * 64 + fr, col0 = u.pn * BM + wc * 32 + 4 * fq;
#pragma unroll
        for (int ai = 0; ai < 2; ++ai) {
            f32x4 xv[4][2][2];
#pragma unroll
            for (int m = 0; m < 4; ++m) { const size_t off = (size_t)(row0 + ai * HALF + m * 16) * 2048 + col0;
#pragma unroll
                for (int bj = 0; bj < 2; ++bj)
#pragma unroll
                    for (int n = 0; n < 2; ++n) xv[m][bj][n] = *(const f32x4*)(x + off + bj * HALF + n * 16); }
            asm volatile("" ::: "memory");
#pragma unroll
            for (int m = 0; m < 4; ++m) { const size_t off = (size_t)(row0 + ai * HALF + m * 16) * 2048 + col0;
#pragma unroll
                for (int bj = 0; bj < 2; ++bj)
#pragma unroll
                    for (int n = 0; n < 2; ++n) { const f32x4 r = xv[m][bj][n] + acc[ai][bj][m][n]; u32x2 w; w.x = cvt_pk_bf16(r[0], r[1]); w.y = cvt_pk_bf16(r[2], r[3]); *(u32x2*)(x1 + off + bj * HALF + n * 16) = w; } }
            asm volatile("" ::: "memory");
        }
    }
};
__device__ __forceinline__ float swiglu1(float g, float l) {
    g = fminf(g, 7.0f); l = fminf(fmaxf(l, -7.0f), 7.0f);
    return g * sigmoidf_fast(1.702f * g) * (l + 1.0f);
}
struct EpiSwiglu {
    static constexpr bool PERM = true, AFTER_DRAIN = false;
    const float* b1; unsigned char* H;
    __device__ __forceinline__ void operator()(const f32x4 (&acc)[2][2][4][2], const Unit& u, int wr, int wc, int fr, int fq) const {
        const int row0 = u.pm * BM + wr * 64 + fr, c0 = u.pn * BM + wc * 32 + 8 * fq; const float* be = b1 + (size_t)u.aux * 4096 + c0;
        f32x4 bv[2][2];
#pragma unroll
        for (int bj = 0; bj < 2; ++bj)
#pragma unroll
            for (int n = 0; n < 2; ++n) bv[bj][n] = *(const f32x4*)(be + bj * HALF + 4 * n);
#pragma unroll
        for (int ai = 0; ai < 2; ++ai)
#pragma unroll
            for (int m = 0; m < 4; ++m) { unsigned char* rowp = H + (size_t)(row0 + ai * HALF + m * 16) * 2048 + (c0 >> 1);
#pragma unroll
                for (int bj = 0; bj < 2; ++bj) { const f32x4 v0 = acc[ai][bj][m][0] * W8_INV + bv[bj][0], v1 = acc[ai][bj][m][1] * W8_INV + bv[bj][1];
                    *(unsigned*)(rowp + bj * (HALF / 2)) = pk4_fp8(swiglu1(v0[0], v0[1]), swiglu1(v0[2], v0[3]), swiglu1(v1[0], v1[1]), swiglu1(v1[2], v1[3])); } }
    }
};
struct EpiMoeOut {
    static constexpr bool PERM = true, AFTER_DRAIN = false;
    const float* b2; const float* slot_w; unsigned char* Y;
    __device__ __forceinline__ void operator()(const f32x4 (&acc)[2][2][4][2], const Unit& u, int wr, int wc, int fr, int fq) const {
        const int e = u.aux, row0 = u.pm * BM + wr * 64 + fr, c0 = u.pn * BM + wc * 32 + 8 * fq; const float* be = b2 + (size_t)e * 2048 + c0;
        f32x4 bv[2][2];
#pragma unroll
        for (int bj = 0; bj < 2; ++bj)
#pragma unroll
            for (int n = 0; n < 2; ++n) bv[bj][n] = *(const f32x4*)(be + bj * HALF + 4 * n);
        float wrow[2][4];
#pragma unroll
        for (int ai = 0; ai < 2; ++ai)
#pragma unroll
            for (int m = 0; m < 4; ++m) wrow[ai][m] = slot_w[row0 + ai * HALF + m * 16] * Y8_SCALE;
        asm volatile("" ::: "memory");
#pragma unroll
        for (int ai = 0; ai < 2; ++ai)
#pragma unroll
            for (int m = 0; m < 4; ++m) { const int row = row0 + ai * HALF + m * 16;
                const float w8 = wrow[ai][m]; unsigned char* rowp = Y + (size_t)row * 2048 + c0;
#pragma unroll
                for (int bj = 0; bj < 2; ++bj) { const f32x4 v0 = (acc[ai][bj][m][0] * W8_INV + bv[bj][0]) * w8, v1 = (acc[ai][bj][m][1] * W8_INV + bv[bj][1]) * w8;
                    u32x2 w; w.x = pk4_fp8(v0[0], v0[1], v0[2], v0[3]); w.y = pk4_fp8(v1[0], v1[1], v1[2], v1[3]);
                    *(u32x2*)(rowp + bj * HALF) = w; } }
    }
};

typedef int i32x4 __attribute__((ext_vector_type(4)));
typedef int i32x8 __attribute__((ext_vector_type(8)));
__device__ __forceinline__ i32x8 cat8(bf16x8 lo, bf16x8 hi) { return __builtin_shufflevector(__builtin_bit_cast(i32x4, lo), __builtin_bit_cast(i32x4, hi), 0, 1, 2, 3, 4, 5, 6, 7); }
template <class Epi, class Sched, bool ALIGN_EPI = false, bool SP2 = false, int ESZ = 2>
__device__ __forceinline__ void gemm_phase(PG8_LAS unsigned char* lds, const int K, const Sched& S, const Epi& E) {
    int tid = threadIdx.x; asm volatile("" : "+v"(tid));
    const int wid = __builtin_amdgcn_readfirstlane(tid >> 6), lane = tid & 63, wr = wid >> 2, wc = wid & 3, fr = lane & 15, fq = lane >> 4;
    const int nt = K / (BK * 2 / ESZ);
    unsigned voffA, voffB;
    { int R, C; stage_rc(tid * 16, R, C); const int Rb = Epi::PERM ? ((R & ~31) + perm32(R & 31)) : R;
        voffA = (unsigned)(R * K * ESZ + C * 2); voffB = (unsigned)(Rb * K * ESZ + C * 2); }
    const size_t pstep = (size_t)64 * K * ESZ;
    const size_t kstep = (size_t)(BK * 2);
    const size_t hstep = (size_t)HALF * K * ESZ;
    const unsigned ldsw = (unsigned)wid * 1024u;
    const int aoff = lds_byte(wr * 64 + fr, fq * 8), boff = lds_byte(wc * 32 + fr, fq * 8);
#define PG8_SA(b, h) (((b) * 2 + (h)) * HTB)
#define PG8_SB(b, h) ((4 + (b) * 2 + (h)) * HTB)
#define PG8_STAGE(bufoff, gbase, voff) do { _Pragma("unroll") for (int _i = 0; _i < 2; ++_i) \
        __builtin_amdgcn_global_load_lds((const unsigned*)((const char*)(gbase) + _i * pstep + (voff)), (PG8_LAS unsigned*)(lds + (bufoff) + ldsw + _i * 8192), 16, 0, 0); } while (0)
#define PG8_LDA(dst, b, h) do { _Pragma("unroll") for (int m = 0; m < 4; ++m) { const PG8_LAS unsigned char* p_ = lds + PG8_SA(b, h) + aoff + m * 2048; if constexpr (ESZ == 1) dst##8[m] = cat8(*(const PG8_LAS bf16x8*)p_, *(const PG8_LAS bf16x8*)(p_ + 1024)); else { dst[m][0] = *(const PG8_LAS bf16x8*)p_; dst[m][1] = *(const PG8_LAS bf16x8*)(p_ + 1024); } } } while (0)
#define PG8_LDB(dst, b, h) do { _Pragma("unroll") for (int n = 0; n < 2; ++n) { const PG8_LAS unsigned char* p_ = lds + PG8_SB(b, h) + boff + n * 2048; if constexpr (ESZ == 1) dst##8[n] = cat8(*(const PG8_LAS bf16x8*)p_, *(const PG8_LAS bf16x8*)(p_ + 1024)); else { dst[n][0] = *(const PG8_LAS bf16x8*)p_; dst[n][1] = *(const PG8_LAS bf16x8*)(p_ + 1024); } } } while (0)
#define PG8_MMA(ai, bj, At, Bt) do { __builtin_amdgcn_s_setprio(1); _Pragma("unroll") for (int m = 0; m < 4; ++m) _Pragma("unroll") for (int n = 0; n < 2; ++n) { \
        if constexpr (ESZ == 1) { asm volatile("v_mfma_scale_f32_16x16x128_f8f6f4 %0, %1, %2, %0, %3, %3 op_sel_hi:[0,0,0]" : "+v"(acc[ai][bj][m][n]) : "v"(Bt##8[n]), "v"(At##8[m]), "v"(sc7f)); } \
        else { _Pragma("unroll") for (int k = 0; k < 2; ++k) acc[ai][bj][m][n] = __builtin_amdgcn_mfma_f32_16x16x32_bf16(Bt[n][k], At[m][k], acc[ai][bj][m][n], 0, 0, 0); } } \
        __builtin_amdgcn_s_setprio(0); } while (0)
#define PG8_WAIT_V(n) asm volatile("s_waitcnt vmcnt(" #n ")" ::: "memory")
#define PG8_WAIT_L(n) asm volatile("s_waitcnt lgkmcnt(" #n ")" ::: "memory")
#define PG8_BAR __builtin_amdgcn_s_barrier()
#define PG8_SCHED __builtin_amdgcn_sched_barrier(0)
    Unit cur, nxt; int ui = 0;
    if (!S.next(0, cur)) return;
    f32x4 acc[2][2][4][2];
#pragma unroll
    for (int a = 0; a < 2; ++a)
#pragma unroll
        for (int b = 0; b < 2; ++b)
#pragma unroll
            for (int m = 0; m < 4; ++m)
#pragma unroll
                for (int n = 0; n < 2; ++n) acc[a][b][m][n] = (f32x4){0.f, 0.f, 0.f, 0.f};
    const int sc7f = 0x7f7f7f7f;
    bf16x8 At[4][2], B0[2][2], B1[2][2]; i32x8 At8[4], B08[2], B18[2];
    const char* cA = cur.a; const char* cB = cur.b;
    S.a_ready(cur);
    if constexpr (SP2) {
        PG8_STAGE(PG8_SB(0, 0), cB, voffB); PG8_STAGE(PG8_SB(0, 1), cB + hstep, voffB); PG8_STAGE(PG8_SA(0, 0), cA, voffA); PG8_STAGE(PG8_SA(0, 1), cA + hstep, voffA);
        if (wr == 1) PG8_BAR;
        PG8_WAIT_V(2); PG8_BAR;
        PG8_STAGE(PG8_SB(1, 0), cB + kstep, voffB); PG8_STAGE(PG8_SA(1, 0), cA + kstep, voffA); PG8_STAGE(PG8_SB(1, 1), cB + hstep + kstep, voffB);
        PG8_WAIT_V(6); PG8_BAR;
    } else {
        PG8_STAGE(PG8_SB(0, 0), cB, voffB); PG8_STAGE(PG8_SA(0, 0), cA, voffA); PG8_STAGE(PG8_SB(0, 1), cB + hstep, voffB); PG8_STAGE(PG8_SA(0, 1), cA + hstep, voffA);
        if (wr == 1) PG8_BAR;
        PG8_WAIT_V(4); PG8_BAR;
        PG8_STAGE(PG8_SB(1, 0), cB + kstep, voffB); PG8_STAGE(PG8_SA(1, 0), cA + kstep, voffA); PG8_STAGE(PG8_SB(1, 1), cB + hstep + kstep, voffB);
        PG8_WAIT_V(6); PG8_BAR;
    }
    for (;;) {
        const bool has_next = S.next(ui + 1, nxt);
        const char* nA = has_next ? nxt.a : cA; const char* nB = has_next ? nxt.b : cB;
        for (int t = 0; t < nt; t += 2) {
            const bool last = (t == nt - 2);
            const char* a1 = cA + (size_t)(t + 1) * kstep;
            const char* a2 = last ? nA : cA + (size_t)(t + 2) * kstep; const char* b2 = last ? nB : cB + (size_t)(t + 2) * kstep;
            const char* a3 = a2 + kstep; const char* b3 = b2 + kstep;
            if (last && has_next) S.a_ready(nxt);
            if constexpr (SP2) {
            PG8_LDB(B0, 0, 0); PG8_LDB(B1, 0, 1); PG8_SCHED; PG8_LDA(At, 0, 0); PG8_STAGE(PG8_SA(1, 1), a1 + hstep, voffA);
            PG8_WAIT_V(8); PG8_WAIT_L(0); PG8_BAR; PG8_MMA(0, 0, At, B0); PG8_MMA(0, 1, At, B1); PG8_BAR; PG8_SCHED;
            PG8_LDA(At, 0, 1); PG8_STAGE(PG8_SB(0, 0), b2, voffB); PG8_STAGE(PG8_SB(0, 1), b2 + hstep, voffB); PG8_STAGE(PG8_SA(0, 0), a2, voffA);
            PG8_WAIT_V(8); PG8_WAIT_L(0); PG8_BAR; PG8_MMA(1, 0, At, B0); PG8_MMA(1, 1, At, B1); PG8_BAR; PG8_SCHED;
            PG8_LDB(B0, 1, 0); PG8_LDB(B1, 1, 1); PG8_SCHED; PG8_LDA(At, 1, 0); PG8_STAGE(PG8_SA(0, 1), a2 + hstep, voffA);
            PG8_WAIT_V(8); PG8_WAIT_L(0); PG8_BAR; PG8_MMA(0, 0, At, B0); PG8_MMA(0, 1, At, B1); PG8_BAR; PG8_SCHED;
            PG8_LDA(At, 1, 1); PG8_STAGE(PG8_SB(1, 0), b3, voffB); PG8_STAGE(PG8_SB(1, 1), b3 + hstep, voffB); PG8_STAGE(PG8_SA(1, 0), a3, voffA);
            PG8_WAIT_V(8); PG8_WAIT_L(0); PG8_BAR; PG8_MMA(1, 0, At, B0); PG8_MMA(1, 1, At, B1); PG8_BAR; PG8_SCHED;
            } else {
            PG8_LDB(B0, 0, 0); PG8_SCHED; PG8_LDA(At, 0, 0); PG8_STAGE(PG8_SA(1, 1), a1 + hstep, voffA);
            PG8_WAIT_L(8); PG8_BAR; PG8_WAIT_L(0); PG8_MMA(0, 0, At, B0); PG8_BAR; PG8_SCHED;
            PG8_LDB(B1, 0, 1); PG8_STAGE(PG8_SB(0, 0), b2, voffB);
            PG8_BAR; PG8_WAIT_L(0); PG8_MMA(0, 1, At, B1); PG8_BAR;
            PG8_LDA(At, 0, 1); PG8_STAGE(PG8_SA(0, 0), a2, voffA);
            PG8_BAR; PG8_WAIT_L(0); PG8_MMA(1, 0, At, B0); PG8_BAR; PG8_SCHED;
            PG8_STAGE(PG8_SB(0, 1), b2 + hstep, voffB);
            PG8_WAIT_V(6); PG8_BAR; PG8_MMA(1, 1, At, B1); PG8_BAR;
            PG8_LDB(B0, 1, 0); PG8_SCHED; PG8_LDA(At, 1, 0); PG8_STAGE(PG8_SA(0, 1), a2 + hstep, voffA);
            PG8_WAIT_L(8); PG8_BAR; PG8_WAIT_L(0); PG8_MMA(0, 0, At, B0); PG8_BAR; PG8_SCHED;
            PG8_LDB(B1, 1, 1); PG8_STAGE(PG8_SB(1, 0), b3, voffB);
            PG8_BAR; PG8_WAIT_L(0); PG8_MMA(0, 1, At, B1); PG8_BAR;
            PG8_LDA(At, 1, 1); PG8_STAGE(PG8_SA(1, 0), a3, voffA);
            PG8_BAR; PG8_WAIT_L(0); PG8_MMA(1, 0, At, B0); PG8_BAR; PG8_SCHED;
            PG8_STAGE(PG8_SB(1, 1), b3 + hstep, voffB);
            PG8_WAIT_V(6); PG8_BAR; PG8_MMA(1, 1, At, B1); PG8_BAR;
            }
        }
        if constexpr (ESZ == 1) asm volatile("s_nop 15\n\ts_nop 15" ::: "memory");
        if constexpr (ALIGN_EPI) { if (wr == 0) PG8_BAR; }
        if constexpr (!Epi::AFTER_DRAIN) { int z_ = 0; asm volatile("" : "+v"(z_)); const int ln_ = (int)__builtin_amdgcn_mbcnt_hi(~0u, __builtin_amdgcn_mbcnt_lo(~0u, (unsigned)z_)); const int fr_ = ln_ & 15, fq_ = ln_ >> 4;
            E(acc, cur, wr, wc, fr_, fq_); S.done(cur); }
        if (!has_next) break;
#pragma unroll
        for (int a = 0; a < 2; ++a)
#pragma unroll
            for (int b = 0; b < 2; ++b)
#pragma unroll
                for (int m = 0; m < 4; ++m)
#pragma unroll
                    for (int n = 0; n < 2; ++n) acc[a][b][m][n] = (f32x4){0.f, 0.f, 0.f, 0.f};
        cur = nxt; cA = nA; cB = nB; ++ui;
        if constexpr (ALIGN_EPI) { if (wr == 1) PG8_BAR; }
    }
    PG8_WAIT_V(0);
    if constexpr (!ALIGN_EPI) { if (wr == 0) PG8_BAR; }
    PG8_BAR;
    if constexpr (Epi::AFTER_DRAIN) { E.fused(acc, cur, wr, wc, fr, fq, lds, wid, lane); S.done(cur); }
#undef PG8_SA
#undef PG8_SB
#undef PG8_STAGE
#undef PG8_LDA
#undef PG8_LDB
#undef PG8_MMA
#undef PG8_WAIT_V
#undef PG8_WAIT_L
#undef PG8_BAR
#undef PG8_SCHED
}
}

namespace att {
#define ALAS __attribute__((address_space(3)))
typedef short bf16x8 __attribute__((ext_vector_type(8)));
typedef short s16x4 __attribute__((ext_vector_type(4)));
typedef float f32x16 __attribute__((ext_vector_type(16)));
typedef float f32x4 __attribute__((ext_vector_type(4)));
typedef unsigned u32x4 __attribute__((ext_vector_type(4)));
typedef unsigned short bf16_t;
typedef ALAS char* ALAS_char_ptr;
constexpr int D = 128, PITCH = 1024, NW = 8, QBLK = 32, KVBLK = 64, QB = NW * QBLK, SEQ = 8192;
constexpr int SHM = KVBLK * D * 2;
constexpr int OFF_V = 0, OFF_K = 2 * SHM, OFF_WS = 4 * SHM, OFF_G = OFF_WS + NW * 64 * 4, OFF_FLAG = OFF_G + SEQ * 4, LDS_BYTES = OFF_FLAG + 256;
constexpr float SCALE = 0.08838834764831845f, LOG2E = 1.4426950408889634f, C2 = SCALE * LOG2E;
constexpr float THR2 = 10.0f;
constexpr float SB_EXIT = 152.0f;

#define KSWZ(row, colB) ((row) * 256 + ((colB) ^ (((row) & 7) << 4)))
#define ASBAR() __builtin_amdgcn_sched_barrier(0)
__device__ __forceinline__ int v_st(int k, int c) { const int kk = (k & ~0xC) | ((k & 4) << 1) | ((k & 8) >> 1); return ((kk >> 3) * 4 + (c >> 5)) * 512 + ((kk & 7) * 32 + (c & 31)) * 2; }
__device__ __forceinline__ int v_rd_base(int lane) { return ((lane & 3) << 3) | (((lane >> 2) & 3) << 6) | (((lane >> 4) & 1) << 5) | (((lane >> 5) & 1) << 8); }
constexpr int v_rd_off(int d0, int ks, int half) { return d0 * 512 + ks * 4096 + half * 2048; }
__device__ __forceinline__ int crow(int r, int hi) { return (r & 3) + 8 * (r >> 2) + 4 * hi; }
__device__ __forceinline__ unsigned cvtpk(float lo, float hi) { return pg8::cvt_pk_bf16(lo, hi); }

struct Stage { bf16x8 k0, k1, v0, v1; };
__device__ __forceinline__ void sload(Stage& S, const bf16_t* Kh, const bf16_t* Vh, int kbase, unsigned loff) {
    const char* Kt = (const char*)Kh + (size_t)kbase * PITCH * 2; const char* Vt = (const char*)Vh + (size_t)kbase * PITCH * 2;
    S.v0 = *(const bf16x8*)(Vt + loff); S.v1 = *(const bf16x8*)(Vt + (loff + 32u * PITCH * 2u));
    S.k0 = *(const bf16x8*)(Kt + loff); S.k1 = *(const bf16x8*)(Kt + (loff + 32u * PITCH * 2u));
}
__device__ __forceinline__ void swrite(const Stage& S, ALAS char* lds, int buf, int kws, int vst0, int vst1) {
    *(ALAS bf16x8*)(lds + OFF_K + buf * SHM + kws) = S.k0; *(ALAS bf16x8*)(lds + OFF_K + buf * SHM + kws + 32 * 256) = S.k1;
    *(ALAS bf16x8*)(lds + OFF_V + buf * SHM + vst0) = S.v0; *(ALAS bf16x8*)(lds + OFF_V + buf * SHM + vst1) = S.v1;
}
__device__ __forceinline__ void qkt(f32x16& p0, f32x16& p1, const ALAS char* Kb, int r32, int hi, const bf16x8* qr) {
    p0 = f32x16{}; p1 = f32x16{};
    const ALAS char* kb[4];
#pragma unroll
    for (int dd = 0; dd < 4; ++dd) kb[dd] = Kb + KSWZ(r32, (dd * 16 + hi * 8) * 2);
#pragma unroll
    for (int d0 = 0; d0 < 8; ++d0) { const ALAS char* a = kb[d0 & 3] + (d0 >> 2) * 128;
        const bf16x8 b0 = *(const ALAS bf16x8*)a;
        const bf16x8 b1 = *(const ALAS bf16x8*)(a + 32 * 256);
        p0 = __builtin_amdgcn_mfma_f32_32x32x16_bf16(b0, qr[d0], p0, 0, 0, 0);
        p1 = __builtin_amdgcn_mfma_f32_32x32x16_bf16(b1, qr[d0], p1, 0, 0, 0); }
}
__device__ __forceinline__ void pv_tile(f32x16* o, int vb, bf16x8 pa0, bf16x8 pa1, bf16x8 pa2, bf16x8 pa3) {
#define TRRD(dst, off) asm volatile("ds_read_b64_tr_b16 %0, %1 offset:%2" : "=&v"(dst) : "v"(vb), "i"(off) : "memory")
#define PV_D0(d0) do { s16x4 l0, l1, l2, l3, h0, h1, h2, h3; constexpr int b_ = v_rd_off(d0, 0, 0); \
        TRRD(l0, b_); TRRD(h0, b_ + 2048); TRRD(l1, b_ + 4096); TRRD(h1, b_ + 6144); TRRD(l2, b_ + 8192); TRRD(h2, b_ + 10240); TRRD(l3, b_ + 12288); TRRD(h3, b_ + 14336); \
        asm volatile("s_waitcnt lgkmcnt(0)" ::: "memory"); ASBAR(); \
        o[d0] = __builtin_amdgcn_mfma_f32_32x32x16_bf16(pa0, (bf16x8){l0[0], l0[1], l0[2], l0[3], h0[0], h0[1], h0[2], h0[3]}, o[d0], 0, 0, 0);   \
        o[d0] = __builtin_amdgcn_mfma_f32_32x32x16_bf16(pa1, (bf16x8){l1[0], l1[1], l1[2], l1[3], h1[0], h1[1], h1[2], h1[3]}, o[d0], 0, 0, 0);   \
        o[d0] = __builtin_amdgcn_mfma_f32_32x32x16_bf16(pa2, (bf16x8){l2[0], l2[1], l2[2], l2[3], h2[0], h2[1], h2[2], h2[3]}, o[d0], 0, 0, 0);   \
        o[d0] = __builtin_amdgcn_mfma_f32_32x32x16_bf16(pa3, (bf16x8){l3[0], l3[1], l3[2], l3[3], h3[0], h3[1], h3[2], h3[3]}, o[d0], 0, 0, 0); } while (0)
    PV_D0(0); PV_D0(1); PV_D0(2); PV_D0(3);
#undef PV_D0
#undef TRRD
}
__device__ __forceinline__ void pack_p(const f32x16& p0, const f32x16& p1, bf16x8& pa0, bf16x8& pa1, bf16x8& pa2, bf16x8& pa3) {
#define PK4(P, B_, OUT) do { unsigned a0 = cvtpk(P[B_+0], P[B_+1]), a1 = cvtpk(P[B_+2], P[B_+3]);                          \
        unsigned b0 = cvtpk(P[B_+4], P[B_+5]), b1 = cvtpk(P[B_+6], P[B_+7]);                                             \
        auto r0 = __builtin_amdgcn_permlane32_swap(a0, b0, false, false); auto r1 = __builtin_amdgcn_permlane32_swap(a1, b1, false, false); \
        u32x4 w = {r0[0], r1[0], r0[1], r1[1]}; OUT = *reinterpret_cast<bf16x8*>(&w); } while (0)
    PK4(p0, 0, pa0); PK4(p0, 8, pa1); PK4(p1, 0, pa2); PK4(p1, 8, pa3);
#undef PK4
}
__device__ __forceinline__ void store_o(const f32x16* o, const float* rs, bf16_t* Ow  , int r32, int hi) {
    const unsigned lo = (unsigned)((4 * hi * PITCH + r32) * 2);
#pragma unroll
    for (int r = 0; r < 16; ++r) { const int orow0 = (r & 3) + 8 * (r >> 2);
#pragma unroll
        for (int d0 = 0; d0 < 4; ++d0) { const float v = o[d0][r] * rs[r]; const float vn = __shfl_xor(v, 1);
            if ((r32 & 1) == 0) *(unsigned*)((char*)Ow + (lo + (unsigned)((orow0 * PITCH + d0 * 32) * 2))) = cvtpk(v, vn); } }
}

__device__ __forceinline__ void fox_unit(const bf16_t* Qh, const bf16_t* Kh, const bf16_t* Vh, bf16_t* Oh, const float* Gh, int qb, int t0, int t1, int mode, float* part, unsigned* flag, unsigned* tmo, const unsigned* km, ALAS char* lds) {
    int tid = threadIdx.x; asm volatile("" : "+v"(tid));
    const int wid = __builtin_amdgcn_readfirstlane(tid >> 6), lane = tid & 63, r32 = lane & 31, hi = lane >> 5;
    const int P0 = qb * QB, NT = 4 * (qb + 1);
    const int sr = tid >> 4, sc = (tid & 15) * 8, vst0 = v_st(sr, sc), vst1 = v_st(32 + sr, sc), kws = KSWZ(sr, sc * 2); const unsigned loff = (unsigned)((sr * PITCH + sc) * 2);
    const int vb0 = (int)(unsigned)(size_t)(lds + OFF_V) + v_rd_base(lane);
    ALAS float* wsf = (ALAS float*)(lds + OFF_WS) + wid * 64; ALAS float* li_l = wsf; ALAS float* al_l = wsf + 32;
    ALAS float* Gl = (ALAS float*)(lds + OFF_G);
    {
        f32x4 a[4]; float run = 0.f;
#pragma unroll
        for (int i = 0; i < 4; ++i) a[i] = *(const f32x4*)((const char*)Gh + (unsigned)((tid * 16 + i * 4) * 4));
#pragma unroll
        for (int i = 0; i < 4; ++i) { a[i].x += run; a[i].y += a[i].x; a[i].z += a[i].y; a[i].w += a[i].z; run = a[i].w; }
        float inc = run;
#pragma unroll
        for (int o = 1; o < 64; o <<= 1) { const float t = __shfl_up(inc, o); if (lane >= o) inc += t; }
        ALAS float* wtot = (ALAS float*)(lds + OFF_FLAG + 96);
        if (lane == 63) wtot[wid] = inc;
        __syncthreads();
        float off = inc - run;
#pragma unroll
        for (int w = 0; w < NW; ++w) off += w < wid ? wtot[w] : 0.f;
#pragma unroll
        for (int i = 0; i < 4; ++i) ((ALAS f32x4*)Gl)[tid * 4 + i] = (a[i] + off) * LOG2E;
    }
    bf16x8 qr[8];
#pragma unroll
    for (int d0 = 0; d0 < 8; ++d0) qr[d0] = *(const bf16x8*)((const char*)Qh + (size_t)P0 * PITCH * 2 + (unsigned)(((wid * QBLK + r32) * PITCH + hi * 8) * 2 + d0 * 32));
    Stage S; sload(S, Kh, Vh, (NT - 1 - t0) * KVBLK, loff);
    asm volatile("s_waitcnt vmcnt(0)" ::: "memory"); swrite(S, lds, 0, kws, vst0, vst1);
    __syncthreads();
    float cq;
    { float k2 = 0.f;
#pragma unroll
      for (int w = 0; w < 4; ++w) k2 += __uint_as_float(__hip_atomic_load(km + w, __ATOMIC_RELAXED, __HIP_MEMORY_SCOPE_AGENT));
      float q2 = 0.f;
#pragma unroll
      for (int d0 = 0; d0 < 8; ++d0) { const u32x4 u = __builtin_bit_cast(u32x4, qr[d0]);
#pragma unroll
          for (int j = 0; j < 4; ++j) { const float a = __uint_as_float(u[j] << 16), b = __uint_as_float(u[j] & 0xffff0000u); q2 += a * a + b * b; } }
      { auto rr = __builtin_amdgcn_permlane32_swap(__float_as_uint(q2), __float_as_uint(q2), false, false); q2 = __uint_as_float(rr[0]) + __uint_as_float(rr[1]); }
      cq = sqrtf(q2) * sqrtf(k2) * (1.01f * C2); }
    ALAS int* flg = (ALAS int*)(lds + OFF_FLAG);
    const float Gref = Gl[P0 + QB - 1];
    float m_reg = -1e30f, l_reg = 0.f; f32x16 o[4] = {};
    const int qlo = P0 + wid * QBLK, qm = qlo + r32 - 4 * hi;
    const float mlb = (Gref - Gl[qlo + r32]) - cq;
    bool skip_all = false;
    { const float gb0 = Gref - Gl[(NT - 1 - t0) * KVBLK + KVBLK - 1];
      const bool done_w = __all(cq + gb0 <= mlb - SB_EXIT);
      if (lane == 0) flg[32 + wid] = done_w ? 1 : 0;
      __syncthreads();
      int all_done = 1;
#pragma unroll
      for (int w = 0; w < NW; ++w) all_done &= flg[32 + w];
      skip_all = all_done != 0; }
    for (int t = t0; t < t1 && !skip_all; ++t) {
        const int buf = (t - t0) & 1, kb = (NT - 1 - t) * KVBLK;
        if (t + 1 < t1) sload(S, Kh, Vh, kb - KVBLK, loff);
        ASBAR();
        if (kb <= qlo + QBLK - 1) {
            f32x16 p0, p1;
            qkt(p0, p1, lds + OFF_K + buf * SHM, r32, hi, qr);
#pragma unroll
            for (int g = 0; g < 4; ++g) { const f32x4 b0 = *(const ALAS f32x4*)(Gl + kb + 8 * g + 4 * hi), b1 = *(const ALAS f32x4*)(Gl + kb + 32 + 8 * g + 4 * hi);
#pragma unroll
                for (int i = 0; i < 4; ++i) { p0[4 * g + i] = fmaf(p0[4 * g + i], C2, Gref - b0[i]); p1[4 * g + i] = fmaf(p1[4 * g + i], C2, Gref - b1[i]); } }
            if (kb + KVBLK - 1 > qlo) {
                const int dq = qm - kb; const float NEG = -__builtin_inff();
#pragma unroll
                for (int r = 0; r < 16; ++r) { const int c = (r & 3) + 8 * (r >> 2); if (dq - c < 0) p0[r] = NEG; if (dq - c - 32 < 0) p1[r] = NEG; }
            }
            float pmax = p0[0];
#pragma unroll
            for (int r = 1; r < 16; ++r) pmax = fmaxf(pmax, p0[r]);
#pragma unroll
            for (int r = 0; r < 16; ++r) pmax = fmaxf(pmax, p1[r]);
            { auto rr = __builtin_amdgcn_permlane32_swap(__float_as_uint(pmax), __float_as_uint(pmax), false, false); pmax = fmaxf(__uint_as_float(rr[0]), __uint_as_float(rr[1])); }
            float mn, alpha;
            if (__all(pmax - m_reg <= THR2)) { mn = m_reg; alpha = 1.f; }
            else { mn = fmaxf(m_reg, pmax); alpha = __builtin_amdgcn_exp2f(m_reg - mn); m_reg = mn; }
            float ps = 0.f;
#pragma unroll
            for (int r = 0; r < 16; ++r) { p0[r] = __builtin_amdgcn_exp2f(p0[r] - mn); ps += p0[r]; }
#pragma unroll
            for (int r = 0; r < 16; ++r) { p1[r] = __builtin_amdgcn_exp2f(p1[r] - mn); ps += p1[r]; }
            { auto rr = __builtin_amdgcn_permlane32_swap(__float_as_uint(ps), __float_as_uint(ps), false, false); ps = __uint_as_float(rr[0]) + __uint_as_float(rr[1]); }
            l_reg = l_reg * alpha + ps;
            bf16x8 pa0, pa1, pa2, pa3; pack_p(p0, p1, pa0, pa1, pa2, pa3);
            if (__any(alpha < 1.f)) { if (hi == 0) al_l[r32] = alpha; asm volatile("s_waitcnt lgkmcnt(0)" ::: "memory");
#pragma unroll
                for (int d_ = 0; d_ < 4; ++d_)
#pragma unroll
                    for (int r = 0; r < 16; ++r) o[d_][r] *= al_l[crow(r, hi)]; }
            ASBAR();
            pv_tile(o, vb0 + buf * SHM, pa0, pa1, pa2, pa3);
        }
        { const float gb = kb > 0 ? Gref - Gl[kb - 1] : 0.f;
          const bool done_w = __all(cq + gb <= fmaxf(m_reg, mlb) - SB_EXIT);
          if (lane == 0) flg[buf * 8 + wid] = done_w ? 1 : 0; }
        if (t + 1 < t1) { asm volatile("s_waitcnt vmcnt(0)" ::: "memory"); swrite(S, lds, buf ^ 1, kws, vst0, vst1); }
        __syncthreads();
        int all_done = 1;
#pragma unroll
        for (int w = 0; w < NW; ++w) all_done &= flg[buf * 8 + w];
        if (all_done) break;
    }
    if (mode == 1) {
        float* Op = part + (size_t)(wid * QBLK) * D;
#pragma unroll
        for (int r = 0; r < 16; ++r)
#pragma unroll
            for (int d0 = 0; d0 < 4; ++d0) *(float*)((char*)Op + (unsigned)((crow(r, hi) * D + d0 * 32 + r32) * 4)) = o[d0][r];
        if (hi == 0) { part[QB * D + wid * QBLK + r32] = m_reg; part[QB * D + QB + wid * QBLK + r32] = l_reg; }
        asm volatile("s_waitcnt vmcnt(0)" ::: "memory");
        __syncthreads();
        if (tid == 0) { __builtin_amdgcn_fence(__ATOMIC_RELEASE, "agent"); asm volatile("s_waitcnt vmcnt(0)" ::: "memory");
            __hip_atomic_store(flag, 1u, __ATOMIC_RELAXED, __HIP_MEMORY_SCOPE_AGENT); }
        __syncthreads();
        return;
    }
    if (mode == 2) {
        if (tid == 0) { unsigned sp = 0u;
            while (__hip_atomic_load(flag, __ATOMIC_RELAXED, __HIP_MEMORY_SCOPE_AGENT) == 0u) { __builtin_amdgcn_s_sleep(4); if (++sp > (1u << 21)) { atomicAdd(tmo, 1u); break; } }
            __builtin_amdgcn_fence(__ATOMIC_ACQUIRE, "agent"); asm volatile("s_waitcnt vmcnt(0)" ::: "memory"); }
        __syncthreads();
        const float mB = part[QB * D + wid * QBLK + r32], lB = part[QB * D + QB + wid * QBLK + r32];
        const float mN = fmaxf(m_reg, mB), fa = __builtin_amdgcn_exp2f(m_reg - mN), fb = __builtin_amdgcn_exp2f(mB - mN);
        l_reg = l_reg * fa + lB * fb;
        if (hi == 0) { al_l[r32] = fa; li_l[r32] = fb; } asm volatile("s_waitcnt lgkmcnt(0)" ::: "memory");
        const float* Op = part + (size_t)(wid * QBLK) * D;
#pragma unroll
        for (int r = 0; r < 16; ++r) { const float ar = al_l[crow(r, hi)], br = li_l[crow(r, hi)];
#pragma unroll
            for (int d0 = 0; d0 < 4; ++d0) o[d0][r] = o[d0][r] * ar + *(const float*)((const char*)Op + (unsigned)((crow(r, hi) * D + d0 * 32 + r32) * 4)) * br; }
        asm volatile("s_waitcnt lgkmcnt(0)" ::: "memory");
    }
    if (hi == 0) li_l[r32] = l_reg; asm volatile("s_waitcnt lgkmcnt(0)" ::: "memory");
    float rli[16];
#pragma unroll
    for (int r = 0; r < 16; ++r) rli[r] = __builtin_amdgcn_rcpf(li_l[crow(r, hi)]);
    store_o(o, rli, Oh + (size_t)(P0 + wid * QBLK) * PITCH, r32, hi);
    __syncthreads();
}

__device__ __forceinline__ float softplus2(float u) { return fmaxf(u, 0.f) + __builtin_amdgcn_logf(1.0f + __builtin_amdgcn_exp2f(-fabsf(u))); }
__device__ __forceinline__ void sb_unit(const bf16_t* Qh, const bf16_t* Kh, const bf16_t* Vh, bf16_t* Oh, int qb, ALAS char* lds) {
    int tid = threadIdx.x; asm volatile("" : "+v"(tid));
    const int wid = __builtin_amdgcn_readfirstlane(tid >> 6), lane = tid & 63, r32 = lane & 31, hi = lane >> 5;
    const int P0 = qb * QB, NT = 4 * (qb + 1);
    const int sr = tid >> 4, sc = (tid & 15) * 8, vst0 = v_st(sr, sc), vst1 = v_st(32 + sr, sc), kws = KSWZ(sr, sc * 2); const unsigned loff = (unsigned)((sr * PITCH + sc) * 2);
    const int vb0 = (int)(unsigned)(size_t)(lds + OFF_V) + v_rd_base(lane);
    ALAS int* flg = (ALAS int*)(lds + OFF_FLAG);
    bf16x8 qr[8];
#pragma unroll
    for (int d0 = 0; d0 < 8; ++d0) qr[d0] = *(const bf16x8*)((const char*)Qh + (size_t)P0 * PITCH * 2 + (unsigned)(((wid * QBLK + r32) * PITCH + hi * 8) * 2 + d0 * 32));
    Stage S; sload(S, Kh, Vh, (NT - 1) * KVBLK, loff);
    asm volatile("s_waitcnt vmcnt(0)" ::: "memory"); swrite(S, lds, 0, kws, vst0, vst1);
    __syncthreads();
    float carry = 0.f; f32x16 o[4] = {};
    const int qlo = P0 + wid * QBLK, qm = qlo + r32 - 4 * hi;
    for (int t = 0; t < NT; ++t) {
        const int buf = t & 1, kb = (NT - 1 - t) * KVBLK;
        if (t + 1 < NT) sload(S, Kh, Vh, kb - KVBLK, loff);
        ASBAR();
        if (kb < qlo + QBLK - 1) {
            f32x16 p0, p1, s0, s1;
            qkt(p0, p1, lds + OFF_K + buf * SHM, r32, hi, qr);
            const int dq = qm - kb - 1;
#pragma unroll
            for (int r = 0; r < 16; ++r) { const int c = (r & 3) + 8 * (r >> 2);
                p0[r] *= C2; p1[r] *= C2;
                s0[r] = (dq - c < 0) ? 0.f : softplus2(p0[r]); s1[r] = (dq - c - 32 < 0) ? 0.f : softplus2(p1[r]); }
#pragma unroll
            for (int g = 0; g < 4; ++g) { s0[4 * g + 2] += s0[4 * g + 3]; s0[4 * g + 1] += s0[4 * g + 2]; s0[4 * g] += s0[4 * g + 1];
                                          s1[4 * g + 2] += s1[4 * g + 3]; s1[4 * g + 1] += s1[4 * g + 2]; s1[4 * g] += s1[4 * g + 1]; }
            float e0[4], e1[4], running = carry;
#pragma unroll
            for (int g = 3; g >= 0; --g) { auto rb = __builtin_amdgcn_permlane32_swap(__float_as_uint(s1[4 * g]), __float_as_uint(s1[4 * g]), false, false);
                const float eh = running; running += __uint_as_float(rb[1]); const float el = running; running += __uint_as_float(rb[0]); e1[g] = hi ? eh : el; }
#pragma unroll
            for (int g = 3; g >= 0; --g) { auto ra = __builtin_amdgcn_permlane32_swap(__float_as_uint(s0[4 * g]), __float_as_uint(s0[4 * g]), false, false);
                const float eh = running; running += __uint_as_float(ra[1]); const float el = running; running += __uint_as_float(ra[0]); e0[g] = hi ? eh : el; }
            carry = running;
#pragma unroll
            for (int g = 0; g < 4; ++g) {
#pragma unroll
                for (int i = 0; i < 4; ++i) { const int r = 4 * g + i, c = (r & 3) + 8 * (r >> 2);
                    p0[r] = (dq - c < 0) ? 0.f : __builtin_amdgcn_exp2f(p0[r] - (e0[g] + s0[r]));
                    p1[r] = (dq - c - 32 < 0) ? 0.f : __builtin_amdgcn_exp2f(p1[r] - (e1[g] + s1[r])); } }
            bf16x8 pa0, pa1, pa2, pa3; pack_p(p0, p1, pa0, pa1, pa2, pa3);
            ASBAR();
            pv_tile(o, vb0 + buf * SHM, pa0, pa1, pa2, pa3);
        }
        const bool done_w = __all(carry > SB_EXIT);
        if (lane == 0) flg[buf * 8 + wid] = done_w ? 1 : 0;
        if (t + 1 < NT) { asm volatile("s_waitcnt vmcnt(0)" ::: "memory"); swrite(S, lds, buf ^ 1, kws, vst0, vst1); }
        __syncthreads();
        int all_done = 1;
#pragma unroll
        for (int w = 0; w < NW; ++w) all_done &= flg[buf * 8 + w];
        if (all_done) break;
    }
    float one[16];
#pragma unroll
    for (int r = 0; r < 16; ++r) one[r] = 1.f;
    store_o(o, one, Oh + (size_t)(P0 + wid * QBLK) * PITCH, r32, hi);
    __syncthreads();
}
#undef KSWZ
#undef ASBAR
}

constexpr int NWAVES = 8;
constexpr int N_LAUNCHES = MK_N_LAUNCHES;
constexpr int PER_PHASE = 9;

constexpr int T = 8192, DM = 2048, NH = 8, HD = 128, DH = NH * HD  ;
constexpr int NIN = 3 * DH + 3 * DH + NH + 2 * DM;
constexpr int NIN_G = 6 * DH + 2 * DM;
constexpr int NE = 32, TOPK = 4, DFF = DM, CAP = T;
constexpr float RMS_EPS = 1e-5f;

constexpr size_t MiB = 1u << 20;
constexpr size_t WS_CTL = 0, CTL_ZERO_BYTES = 128 * 1024;
constexpr size_t WS_WIN = 1 * MiB;
constexpr size_t WS_WPA = 41 * MiB, WS_WPB = 45 * MiB;
constexpr size_t WS_WOUT = 49 * MiB;
constexpr size_t WS_W1 = 57 * MiB;
constexpr size_t WS_W2 = 569 * MiB;
constexpr size_t WS_HN = 825 * MiB;
constexpr size_t WS_QKV = 857 * MiB, QKV_STRIDE = 16 * MiB;
constexpr size_t WS_GATES = 1050 * MiB;
constexpr size_t WS_LOGF = 1017 * MiB, WS_WRS = WS_LOGF + 512 * 1024;
constexpr size_t WS_OSB = 1018 * MiB, WS_OFX = 1034 * MiB;
constexpr size_t WS_PART = 953 * MiB;
constexpr size_t WS_MIXED = 1114 * MiB;
constexpr size_t WS_X1 = 1146 * MiB;
constexpr size_t WS_STOK = 1210 * MiB, WS_SW = 1211 * MiB;
constexpr size_t WS_Y = 2365 * MiB;
constexpr size_t WS_AS = 1341 * MiB;
constexpr size_t WS_H = 1853 * MiB;
constexpr size_t WS_HN8 = 3389 * MiB;
constexpr size_t WS_WIN8 = 3405 * MiB;
constexpr size_t WS_END = 3413 * MiB;
constexpr int CW_TMO = 0, CW_CODE = 1;
constexpr int CW_BAR = 4096;
constexpr int CW_CNT = 8192;
constexpr int CW_QF = 12288, CW_QS = CW_QF + 64 * 8;
constexpr int CW_QC = CW_QS + 64 * 8;
constexpr int CW_KM = CW_QC + 64;
constexpr int CW_FLAG = 16384;
static_assert((CW_FLAG + 64 * 128) * 4 <= (int)CTL_ZERO_BYTES && (CW_CNT + 64 * NE) <= CW_QF, "CTL words inside the memset region");

constexpr int RING_OFF = 0, RING_BYTES = 131072;
constexpr int LDSCTL_OFF = RING_BYTES, MISC_OFF = LDSCTL_OFF + 320;
constexpr int TAB_OFF = LDSCTL_OFF + 1024;
constexpr int LDS_BYTES = 147456;
static_assert(att::LDS_BYTES <= RING_BYTES, "attention scratch fits the ring region");

#define GAS __attribute__((address_space(1)))
#define LAS __attribute__((address_space(3)))
typedef unsigned short bf16;
typedef unsigned v4u __attribute__((ext_vector_type(4)));
typedef unsigned v2u __attribute__((ext_vector_type(2)));
typedef float f32x4 __attribute__((ext_vector_type(4)));
typedef float f32x16 __attribute__((ext_vector_type(16)));
typedef short bf16x8 __attribute__((ext_vector_type(8)));
typedef GAS unsigned gu32;
typedef GAS unsigned long long gu64;
#define RLX_AGENT __ATOMIC_RELAXED, __HIP_MEMORY_SCOPE_AGENT
#define LDS_WAIT() asm volatile("s_waitcnt lgkmcnt(0)" ::: "memory")
#define VM_WAIT() asm volatile("s_waitcnt vmcnt(0)" ::: "memory")
__device__ __forceinline__ unsigned long long rt() { return __builtin_amdgcn_s_memrealtime(); }
__device__ __forceinline__ unsigned f2bf(float f) { unsigned u = __builtin_bit_cast(unsigned, f); return (u + 0x7fffu + ((u >> 16) & 1u)) >> 16; }
__device__ __forceinline__ unsigned pk2(float lo, float hi) { return f2bf(lo) | (f2bf(hi) << 16); }

#define XB_TMO      128
#define XB_XCNT(j)  (256  + 64 * (j))
#define XB_XSUB(j)  (1280 + 64 * (j))
#define XB_XGEN(j)  (2304 + 64 * (j))
#define XB_TOP      3328
#define XB_TOPGEN   3392
#define XCD_BAR_WORDS 3456
#define XB_SPIN_CAP (1u << 18)

__device__ __forceinline__ unsigned xb_ld(unsigned* p)              { return __hip_atomic_load(p, __ATOMIC_RELAXED, __HIP_MEMORY_SCOPE_AGENT); }
__device__ __forceinline__ unsigned xb_add(unsigned* p, unsigned v) { return __hip_atomic_fetch_add(p, v, __ATOMIC_RELAXED, __HIP_MEMORY_SCOPE_AGENT); }
__device__ __forceinline__ unsigned xb_xcc_id() { return (unsigned)__builtin_amdgcn_s_getreg((3 << 11) | 20) & 0xFu; }
#define XB_SPIN(cond, bar) do { unsigned _sp = 0; while (cond) { __builtin_amdgcn_s_sleep(1); \
    if ((++_sp & 255u) == 0u) { if (xb_ld(&(bar)[XB_TMO])) break; if (_sp > XB_SPIN_CAP) { atomicAdd(&(bar)[XB_TMO], 1u); break; } } } } while (0)

struct XcdBarrier {
    unsigned* bar; unsigned x;
    volatile LAS unsigned* st;
};

__device__ __forceinline__ XcdBarrier xcd_barrier_post(unsigned* bar, volatile LAS unsigned* st) {
    XcdBarrier b; b.bar = bar; b.x = xb_xcc_id(); b.st = st;
    if (threadIdx.x == 0) (void)xb_add(&bar[XB_XCNT(b.x)], 1u);
    return b;
}
__device__ __forceinline__ void xcd_barrier_complete(unsigned* bar, unsigned x, unsigned& nloc, unsigned& nx) {
    const unsigned G = gridDim.x * gridDim.y * gridDim.z;
    unsigned sum, cnt, mine, sp = 0u;
    for (;;) {
        sum = 0u; cnt = 0u; mine = 0u;
#pragma unroll
        for (unsigned j = 0; j < 16; ++j) { const unsigned c = xb_ld(&bar[XB_XCNT(j)]); sum += c; cnt += (c > 0u) ? 1u : 0u; mine = (j == x) ? c : mine; }
        if (sum == G) break;
        __builtin_amdgcn_s_sleep(1);
        if ((++sp & 255u) == 0u) { if (xb_ld(&bar[XB_TMO])) break; if (sp > XB_SPIN_CAP) { atomicAdd(&bar[XB_TMO], 1u); break; } }
    }
    nloc = mine > 0u ? mine : 1u; nx = cnt > 0u ? cnt : 1u;
}

__device__ __forceinline__ void xcd_barrier(const XcdBarrier& b) {
    asm volatile("s_waitcnt vmcnt(0)" ::: "memory");
    __syncthreads();
    if (threadIdx.x == 0) {
        unsigned* bar = b.bar;
        __builtin_amdgcn_s_waitcnt(0);
        unsigned nloc = b.st[0], nx = b.st[1];
        if (nloc == 0u) { xcd_barrier_complete(bar, b.x, nloc, nx); b.st[0] = nloc; b.st[1] = nx; }
        const unsigned old = xb_add(&bar[XB_XSUB(b.x)], 1u);
        const unsigned gen = old / nloc;
        if (old + 1u == (gen + 1u) * nloc) {
            __builtin_amdgcn_fence(__ATOMIC_RELEASE, "agent");
            asm volatile("s_waitcnt vmcnt(0)" ::: "memory");
            const unsigned og = xb_add(&bar[XB_TOP], 1u);
            const unsigned tg = og / nx;
            if (og + 1u == (tg + 1u) * nx) xb_add(&bar[XB_TOPGEN], 1u);
            else XB_SPIN(xb_ld(&bar[XB_TOPGEN]) == tg, bar);
            __builtin_amdgcn_fence(__ATOMIC_ACQUIRE, "agent");
            xb_add(&bar[XB_XGEN(b.x)], 1u);
            asm volatile("s_waitcnt vmcnt(0)" ::: "memory");
        } else {
            XB_SPIN(xb_ld(&bar[XB_XGEN(b.x)]) == gen, bar);
            __builtin_amdgcn_fence(__ATOMIC_ACQUIRE, "agent");
            asm volatile("s_waitcnt vmcnt(0)" ::: "memory");
        }
    }
    __syncthreads();
}

struct Frame {
    LAS unsigned char* lds;
    volatile LAS unsigned* MISC;
    gu32* ctl;
    int tid, lane, wave;
    int vcu, G;
    const float *x, *g_mix, *w_in, *b_forget, *b_gate, *w_psb, *w_pfx, *w_out, *g_ffn, *w_router, *b_router, *w1, *b1, *w2, *b2, *g_final;
    float* out; unsigned char* ws;
};
__device__ __forceinline__ float wave_sum(float v) {
#pragma unroll
    for (int o = 1; o < 64; o <<= 1) v += __shfl_xor(v, o);
    return v;
}
__device__ __forceinline__ unsigned pkbf(float lo, float hi) { return pg8::cvt_pk_bf16(lo, hi); }

__device__ __forceinline__ void transpose_item(const float* src  , int ldw, bf16* dst  , int K, LAS unsigned char* scr, int tid) {
    const int kb = tid & 7, ng = tid >> 3;
    const float* s = src + (size_t)(kb * 8) * ldw + ng * 4;
    f32x4 v[8];
#pragma unroll
    for (int r = 0; r < 8; ++r) v[r] = *(const f32x4*)(s + (size_t)r * ldw);
#pragma unroll
    for (int j = 0; j < 4; ++j) { v4u o; o.x = pkbf(v[0][j], v[1][j]); o.y = pkbf(v[2][j], v[3][j]); o.z = pkbf(v[4][j], v[5][j]); o.w = pkbf(v[6][j], v[7][j]);
        *(LAS v4u*)(scr + (ng * 4 + j) * 144 + kb * 16) = o; }
    __syncthreads();
    const int c = tid & 7, n = tid >> 3;
#pragma unroll
    for (int i = 0; i < 4; ++i) { const int nn = n + 64 * i; const v4u o = *(const LAS v4u*)(scr + nn * 144 + c * 16); *(v4u*)(dst + (size_t)nn * K + c * 8) = o; }
    __syncthreads();
}
__device__ __forceinline__ void transpose_item_fp8(const float* src  , int ldw, unsigned char* dst  , int K, LAS unsigned char* scr, int tid) {
    const int kb = tid & 7, ng = tid >> 3;
#pragma unroll
    for (int p = 0; p < 2; ++p) {
        const float* s = src + (size_t)(p * 64 + kb * 8) * ldw + ng * 4;
        f32x4 v[8];
#pragma unroll
        for (int r = 0; r < 8; ++r) v[r] = *(const f32x4*)(s + (size_t)r * ldw) * pg8::W8_SCALE;
#pragma unroll
        for (int j = 0; j < 4; ++j) { v2u o; o.x = pg8::pk4_fp8(v[0][j], v[1][j], v[2][j], v[3][j]); o.y = pg8::pk4_fp8(v[4][j], v[5][j], v[6][j], v[7][j]);
            *(LAS v2u*)(scr + (ng * 4 + j) * 144 + p * 64 + kb * 8) = o; }
    }
    __syncthreads();
    const int c = tid & 7, n = tid >> 3;
#pragma unroll
    for (int i = 0; i < 4; ++i) { const int nn = n + 64 * i; const v4u o = *(const LAS v4u*)(scr + nn * 144 + c * 16); *(v4u*)(dst + (size_t)nn * K + c * 16) = o; }
    __syncthreads();
}
__device__ __forceinline__ void conv_load(f32x4 (&v)[8], const float* src, int ldw, int p, int kg, int cg) {
    const float* s = src + (size_t)(p * 64 + kg * 8) * ldw + cg * 4;
#pragma unroll
    for (int r = 0; r < 8; ++r) v[r] = __builtin_nontemporal_load((const f32x4*)(s + (size_t)r * ldw));
}
__device__ __forceinline__ void conv_to_lds(const f32x4 (&v)[8], LAS unsigned char* wscr, int p, int kg, int cg) {
#pragma unroll
    for (int j = 0; j < 4; ++j) { v2u o; o.x = pg8::pk4_fp8(v[0][j] * pg8::W8_SCALE, v[1][j] * pg8::W8_SCALE, v[2][j] * pg8::W8_SCALE, v[3][j] * pg8::W8_SCALE);
        o.y = pg8::pk4_fp8(v[4][j] * pg8::W8_SCALE, v[5][j] * pg8::W8_SCALE, v[6][j] * pg8::W8_SCALE, v[7][j] * pg8::W8_SCALE);
        *(LAS v2u*)(wscr + (cg * 4 + j) * 144 + p * 64 + kg * 8) = o; }
}
__device__ __forceinline__ void p0_prologue(Frame& F) {
    LAS unsigned char* scr = F.lds + RING_OFF;
    bf16* WIN = (bf16*)(F.ws + WS_WIN); bf16* WPA = (bf16*)(F.ws + WS_WPA); bf16* WPB = (bf16*)(F.ws + WS_WPB); bf16* WOUT = (bf16*)(F.ws + WS_WOUT);
    constexpr int I_WIN = 32 * 24, I_WP = 16 * 8, I_WOUT = 32 * 8;
    for (int i = F.vcu * (NWAVES * 64) + F.tid; i < DM * NE; i += F.G * (NWAVES * 64)) { const int v = i & 3, ln = (i >> 2) & 63, u = (i >> 8) & 31, w = i >> 13; const int k = 256 * w + 8 * u + 4 * (ln >> 5) + v;
        ((float*)(F.ws + WS_WRS))[i] = F.w_router[(size_t)k * NE + (ln & 31)] * F.g_ffn[k]; }
    constexpr int NITEMS = I_WIN + 2 * I_WP + I_WOUT;
    {
        LAS unsigned char* wscr = scr + F.wave * (32 * 144);
        const int kg = F.lane >> 3, cg = F.lane & 7, c = F.lane & 7, n = F.lane >> 3;
        auto item = [&](int it, const float*& src, bf16*& dst, int& ldw, int& K) {
            int r = it;
            if (r < I_WIN) { const int nb = r % 24, kk = r / 24; src = F.w_in + (size_t)(kk * 64) * NIN + nb * 256; ldw = NIN; dst = WIN + (size_t)(nb * 256) * DM + kk * 64; K = DM; return; } r -= I_WIN;
            if (r < I_WP) { const int nb = r % 8, kk = r / 8; src = F.w_psb + (size_t)(kk * 64) * DM + nb * 256; ldw = DM; dst = WPA + (size_t)(nb * 256) * DH + kk * 64; K = DH; return; } r -= I_WP;
            if (r < I_WP) { const int nb = r % 8, kk = r / 8; src = F.w_pfx + (size_t)(kk * 64) * DM + nb * 256; ldw = DM; dst = WPB + (size_t)(nb * 256) * DH + kk * 64; K = DH; return; } r -= I_WP;
            { const int nb = r % 8, kk = r / 8; src = F.w_out + (size_t)(kk * 64) * DM + nb * 256; ldw = DM; dst = WOUT + (size_t)(nb * 256) * DM + kk * 64; K = DM; }
        };
        auto load8 = [&](f32x4 (&v)[8], const float* src, int ldw) { const float* p = src + (size_t)(kg * 8) * ldw + F.wave * 32 + cg * 4;
#pragma unroll
            for (int r = 0; r < 8; ++r) v[r] = __builtin_nontemporal_load((const f32x4*)(p + (size_t)r * ldw)); };
        f32x4 va[8], vb[8]; const float* src; bf16* dst; int ldw, K;
        int it = F.vcu;
        if (it < NITEMS) { item(it, src, dst, ldw, K); load8(va, src, ldw); }
        for (; it < NITEMS; it += 2 * F.G) {
#define P0_FLUSH(V, DST, KK) do { _Pragma("unroll") for (int j = 0; j < 4; ++j) { v4u o; o.x = pkbf(V[0][j], V[1][j]); o.y = pkbf(V[2][j], V[3][j]); o.z = pkbf(V[4][j], V[5][j]); o.w = pkbf(V[6][j], V[7][j]); \
                *(LAS v4u*)(wscr + (cg * 4 + j) * 144 + kg * 16) = o; } \
            asm volatile("s_waitcnt lgkmcnt(0)" ::: "memory"); \
            _Pragma("unroll") for (int i = 0; i < 4; ++i) { const int nn = n + 8 * i; const v4u o = *(const LAS v4u*)(wscr + nn * 144 + c * 16); *(v4u*)((DST) + (size_t)(F.wave * 32 + nn) * (KK) + c * 8) = o; } \
            asm volatile("s_waitcnt lgkmcnt(0)" ::: "memory"); } while (0)
            bf16* dA = dst; const int KA = K; const int itb = it + F.G;
            const float* sB = src; bf16* dB = dst; int lB = ldw, KB = K;
            if (itb < NITEMS) { item(itb, sB, dB, lB, KB); load8(vb, sB, lB); }
            P0_FLUSH(va, dA, KA);
            if (itb + F.G < NITEMS) { item(itb + F.G, src, dst, ldw, K); load8(va, src, ldw); }
            if (itb < NITEMS) P0_FLUSH(vb, dB, KB);
#undef P0_FLUSH
        }
    }
    {
        LAS unsigned char* wscr = scr + F.wave * (32 * 144); unsigned char* WIN8 = F.ws + WS_WIN8;
        const int kg = F.lane >> 3, cg = F.lane & 7, c = F.lane & 7, n = F.lane >> 3;
        for (int it = F.vcu; it < 256; it += F.G) { const int nb = it & 15, kk = it >> 4;
            const float* src = F.w_in + (size_t)(kk * 128) * NIN + 6 * DH + NH + nb * 256 + F.wave * 32; unsigned char* dst = WIN8 + (size_t)(nb * 256 + F.wave * 32) * DM + kk * 128;
            f32x4 va[8], vb[8]; conv_load(va, src, NIN, 0, kg, cg); conv_load(vb, src, NIN, 1, kg, cg);
            conv_to_lds(va, wscr, 0, kg, cg); conv_to_lds(vb, wscr, 1, kg, cg);
            asm volatile("s_waitcnt lgkmcnt(0)" ::: "memory");
#pragma unroll
            for (int i = 0; i < 4; ++i) { const int nn = n + 8 * i; const v4u o = *(const LAS v4u*)(wscr + nn * 144 + c * 16); *(v4u*)(dst + (size_t)nn * DM + c * 16) = o; }
            asm volatile("s_waitcnt lgkmcnt(0)" ::: "memory");
        }
    }
    __syncthreads();
    bf16* HN = (bf16*)(F.ws + WS_HN); float* LOGF = (float*)(F.ws + WS_LOGF); unsigned char* HN8 = F.ws + WS_HN8;
    LAS float* wfs = (LAS float*)scr;
    for (int i = F.tid; i < DM * 2; i += NWAVES * 64) { const int k = i >> 1, hf = i & 1; const f32x4 wv = *(const f32x4*)(F.w_in + (size_t)k * NIN + 6 * DH + hf * 4) * F.g_mix[k];
        LAS float* d = wfs + ((((k >> 6) * 2 + hf) * 64 + ((k >> 2) & 15) * 4) * 4) + (k & 3);
        d[0] = wv.x; d[4] = wv.y; d[8] = wv.z; d[12] = wv.w; }
    __syncthreads();
    for (int tb = F.vcu; tb < T / 32; tb += F.G) {
        const int ri = F.lane & 3, bb = F.lane >> 2; const size_t row = (size_t)(tb * 32 + F.wave * 4 + ri);
        const f32x4* xp = (const f32x4*)(F.x + row * DM + 4 * bb);
        f32x4 xv[32];
#pragma unroll
        for (int sidx = 0; sidx < 32; ++sidx) xv[sidx] = xp[16 * sidx];
        f32x4 D0 = {0.f, 0.f, 0.f, 0.f}, D1 = {0.f, 0.f, 0.f, 0.f}; float ssq = 0.f;
        const LAS f32x4* wl = (const LAS f32x4*)wfs + F.lane;
#pragma unroll
        for (int sidx = 0; sidx < 32; ++sidx) { if ((sidx & 3) == 0) asm volatile("" : "+v"(wl));
            const f32x4 b0 = wl[(sidx * 2) * 64], b1 = wl[(sidx * 2 + 1) * 64]; const f32x4 a = xv[sidx];
            ssq += (a.x * a.x + a.y * a.y) + (a.z * a.z + a.w * a.w);
#pragma unroll
            for (int v = 0; v < 4; ++v) { D0 = __builtin_amdgcn_mfma_f32_4x4x1f32(a[v], b0[v], D0, 0, 0, 0); D1 = __builtin_amdgcn_mfma_f32_4x4x1f32(a[v], b1[v], D1, 0, 0, 0); } }
#pragma unroll
        for (int m = 4; m < 64; m <<= 1) { ssq += __shfl_xor(ssq, m);
#pragma unroll
            for (int r = 0; r < 4; ++r) { D0[r] += __shfl_xor(D0[r], m); D1[r] += __shfl_xor(D1[r], m); } }
        const float rstd = 1.0f / sqrtf(ssq * (1.0f / DM) + RMS_EPS);
        float rs[4];
#pragma unroll
        for (int r = 0; r < 4; ++r) rs[r] = __shfl(rstd, r);
        if (F.lane < 4) {
#pragma unroll
            for (int r = 0; r < 4; ++r) { const size_t t = (size_t)(tb * 32 + F.wave * 4 + r);
                const float z0 = D0[r] * rs[r] + F.b_forget[F.lane], z1 = D1[r] * rs[r] + F.b_forget[4 + F.lane];
                LOGF[(size_t)F.lane * T + t] = fminf(z0, 0.f) - log1pf(expf(-fabsf(z0)));
                LOGF[(size_t)(4 + F.lane) * T + t] = fminf(z1, 0.f) - log1pf(expf(-fabsf(z1))); } }
        const f32x4* gp = (const f32x4*)(F.g_mix + 4 * bb);
        v2u* hb = (v2u*)(HN + row * DM + 4 * bb); unsigned* h8 = (unsigned*)(HN8 + row * DM + 4 * bb);
        int gz = 0;
#pragma unroll
        for (int sidx = 0; sidx < 32; ++sidx) { if ((sidx & 3) == 0) asm volatile("" : "+v"(gz));
            const f32x4 hh = xv[sidx] * rstd * gp[16 * sidx + gz];
            v2u w; w.x = pkbf(hh.x, hh.y); w.y = pkbf(hh.z, hh.w); hb[16 * sidx] = w; h8[16 * sidx] = pg8::pk4_fp8(hh.x, hh.y, hh.z, hh.w); }
    }
    __syncthreads();
}
constexpr int CONV_SPLIT = 4, CONV_ITEMS = 16 / CONV_SPLIT;
constexpr int CONV_BATCHES = NE * 24 * CONV_SPLIT;
__device__ __forceinline__ void conv_ptrs(const Frame& F, int e, int rb, int j, const float*& src, unsigned char*& dst, int& ldw) {
    if (rb < 16) { const int kk = j, nb = rb; ldw = 2 * DFF;
        src = F.w1 + (size_t)e * DM * 2 * DFF + (size_t)(kk * 128) * (2 * DFF) + nb * 256; dst = F.ws + WS_W1 + (size_t)e * 2 * DFF * DM + (size_t)(nb * 256) * DM + kk * 128; }
    else { const int nb = rb - 16, kk = j; ldw = DM;
        src = F.w2 + (size_t)e * DFF * DM + (size_t)(kk * 128) * DM + nb * 256; dst = F.ws + WS_W2 + (size_t)e * DM * DFF + (size_t)(nb * 256) * DFF + kk * 128; }
}
__device__ __forceinline__ void p2_convert(Frame& F, unsigned* qhead, LAS int* qslot) {
    LAS unsigned char* wscr = F.lds + RING_OFF + F.wave * (32 * 144);
    const int kg = F.lane >> 3, cg = F.lane & 7, c = F.lane & 7, n = F.lane >> 3;
    for (;;) {
        if (F.tid == 0) *qslot = (int)__hip_atomic_fetch_add(qhead, 1u, __ATOMIC_RELAXED, __HIP_MEMORY_SCOPE_AGENT);
        __syncthreads(); const int b = *qslot; __syncthreads();
        if (b >= CONV_BATCHES) break;
        const int eq = b / 24, rb = b - eq * 24, e = eq / CONV_SPLIT, j0 = (eq - e * CONV_SPLIT) * CONV_ITEMS;
        f32x4 va[8], vb[8]; const float* src; unsigned char* dst; int ldw; const int K = rb < 16 ? DM : DFF;
        conv_ptrs(F, e, rb, j0, src, dst, ldw); src += F.wave * 32; conv_load(va, src, ldw, 0, kg, cg);
        for (int j = j0; j < j0 + CONV_ITEMS; ++j) {
            conv_load(vb, src, ldw, 1, kg, cg);
            conv_to_lds(va, wscr, 0, kg, cg);
            unsigned char* dcur = dst + (size_t)(F.wave * 32) * K;
            if (j + 1 < j0 + CONV_ITEMS) { conv_ptrs(F, e, rb, j + 1, src, dst, ldw); src += F.wave * 32; conv_load(va, src, ldw, 0, kg, cg); }
            conv_to_lds(vb, wscr, 1, kg, cg);
            asm volatile("s_waitcnt lgkmcnt(0)" ::: "memory");
#pragma unroll
            for (int i = 0; i < 4; ++i) { const int nn = n + 8 * i; const v4u o = *(const LAS v4u*)(wscr + nn * 144 + c * 16); __builtin_nontemporal_store(o, (v4u*)(dcur + (size_t)nn * K + c * 16)); }
            asm volatile("s_waitcnt lgkmcnt(0)" ::: "memory");
        }
    }
}
__device__ __forceinline__ void p5_router(Frame& F) {
    const bf16* X1 = (const bf16*)(F.ws + WS_X1); unsigned char* AS = F.ws + WS_AS; int* STOK = (int*)(F.ws + WS_STOK); float* SW = (float*)(F.ws + WS_SW);
    LAS float* red = (LAS float*)(F.lds + RING_OFF);
    LAS float* ssqs = red + 8 * 1024;
    LAS float* lg = ssqs + 8 * 32;
    LAS float* rstdl = lg + 32 * 33;
    LAS float* selw = rstdl + 32;
    LAS int* sele = (LAS int*)(selw + 128);
    LAS int* sellp = sele + 128;
    LAS int* dest = sellp + 128;
    LAS int* lcnt = dest + 128;
    LAS int* gbase = lcnt + 32;
    const int i32 = F.lane & 31, kk = F.lane >> 5;
    for (int tb = F.vcu; tb < T / 32; tb += F.G) {
        const int tok0 = tb * 32;
        {
            f32x16 C = {}; float ssq = 0.f; const int k0 = 256 * F.wave;
            const bf16* xr = X1 + (size_t)(tok0 + i32) * DM + k0 + 4 * kk;
            const f32x4* wr = (const f32x4*)(F.ws + WS_WRS) + (size_t)(F.wave * 32) * 64 + F.lane;
#pragma unroll
            for (int ub = 0; ub < 32; ub += 8) {
                f32x4 a[8], b[8]; v2u ar[8];
#pragma unroll
                for (int u = 0; u < 8; ++u) { ar[u] = *(const v2u*)(xr + 8 * (ub + u)); b[u] = wr[(ub + u) * 64]; }
#pragma unroll
                for (int u = 0; u < 8; ++u) { a[u] = (f32x4){pg8::bf_lo(ar[u].x), pg8::bf_hi(ar[u].x), pg8::bf_lo(ar[u].y), pg8::bf_hi(ar[u].y)}; ssq += (a[u].x * a[u].x + a[u].y * a[u].y) + (a[u].z * a[u].z + a[u].w * a[u].w);
#pragma unroll
                    for (int v = 0; v < 4; ++v) C = __builtin_amdgcn_mfma_f32_32x32x2f32(a[u][v], b[u][v], C, 0, 0, 0); }
            }
#pragma unroll
            for (int r = 0; r < 16; ++r) red[F.wave * 1024 + ((r & 3) + 8 * (r >> 2) + 4 * kk) * 32 + i32] = C[r];
            ssq += __shfl_xor(ssq, 32);
            if (kk == 0) ssqs[F.wave * 32 + i32] = ssq;
        }
        __syncthreads();
        for (int idx = F.tid; idx < 1024; idx += NWAVES * 64) { const int tk = idx >> 5, e = idx & 31; float s = 0.f, q = 0.f;
#pragma unroll
            for (int w = 0; w < 8; ++w) { s += red[w * 1024 + idx]; q += ssqs[w * 32 + tk]; }
            const float rstd = 1.0f / sqrtf(q * (1.0f / DM) + RMS_EPS);
            lg[tk * 33 + e] = s * rstd + F.b_router[e]; if (e == 0) rstdl[tk] = rstd; }
        if (F.tid < 32) lcnt[F.tid] = 0;
        __syncthreads();
        if (F.tid < 32) {
            float tv[4]; int te[4];
#pragma unroll
            for (int k = 0; k < 4; ++k) { float best = -__builtin_inff(); int bi = 0;
                for (int e = 0; e < NE; ++e) { const float v = lg[F.tid * 33 + e]; if (v > best) { best = v; bi = e; } }
                tv[k] = best; te[k] = bi; lg[F.tid * 33 + bi] = -__builtin_inff(); }
            float ew[4], sum = 0.f;
#pragma unroll
            for (int k = 0; k < 4; ++k) { ew[k] = expf(tv[k] - tv[0]); sum += ew[k]; }
            const float inv = 1.0f / sum;
#pragma unroll
            for (int k = 0; k < 4; ++k) { sele[F.tid * 4 + k] = te[k]; selw[F.tid * 4 + k] = ew[k] * inv; sellp[F.tid * 4 + k] = atomicAdd((int*)(lcnt + te[k]), 1); }
        }
        __syncthreads();
        if (F.tid < 32) { const int n = lcnt[F.tid]; gbase[F.tid] = n > 0 ? (int)__hip_atomic_fetch_add((unsigned*)(F.ctl + CW_CNT + 64 * F.tid), (unsigned)n, __ATOMIC_RELAXED, __HIP_MEMORY_SCOPE_AGENT) : 0; }
        __syncthreads();
        if (F.tid < 128) { const int e = sele[F.tid]; int pos = gbase[e] + sellp[F.tid]; if (pos >= CAP) pos = CAP - 1; const int row = e * CAP + pos;
            STOK[(tok0 + (F.tid >> 2)) * 4 + (F.tid & 3)] = row; SW[row] = selw[F.tid]; dest[F.tid] = row; }
        __syncthreads();
        {
            f32x4 gv[2][4];
#pragma unroll
            for (int h = 0; h < 2; ++h)
#pragma unroll
                for (int q = 0; q < 4; ++q) gv[h][q] = ((const f32x4*)(F.g_ffn + h * 1024 + F.lane * 16))[q];
#pragma unroll 1
            for (int jp = 0; jp < 4; jp += 4) {
                v4u xw[4][2][2];
#pragma unroll
                for (int jj = 0; jj < 4; ++jj)
#pragma unroll
                    for (int h = 0; h < 2; ++h) { const v4u* xr = (const v4u*)(X1 + (size_t)(tok0 + F.wave * 4 + jp + jj) * DM + h * 1024 + F.lane * 16);
                        xw[jj][h][0] = xr[0]; xw[jj][h][1] = xr[1]; }
#pragma unroll
                for (int jj = 0; jj < 4; ++jj) { const int ti = F.wave * 4 + jp + jj; const float rstd = rstdl[ti];
                    v4u o[2];
#pragma unroll
                    for (int h = 0; h < 2; ++h) { unsigned w4[4];
#pragma unroll
                        for (int q = 0; q < 4; ++q) { const v4u t = xw[jj][h][q >> 1]; const unsigned t0 = (q & 1) ? t.z : t.x, t1 = (q & 1) ? t.w : t.y;
                            const f32x4 hh = (f32x4){pg8::bf_lo(t0), pg8::bf_hi(t0), pg8::bf_lo(t1), pg8::bf_hi(t1)} * rstd * gv[h][q]; w4[q] = pg8::pk4_fp8(hh.x, hh.y, hh.z, hh.w); }
                        o[h].x = w4[0]; o[h].y = w4[1]; o[h].z = w4[2]; o[h].w = w4[3]; }
#pragma unroll
                    for (int k = 0; k < 4; ++k) { unsigned char* op = AS + (size_t)dest[ti * 4 + k] * DM + F.lane * 16;
                        *(v4u*)op = o[0]; *(v4u*)(op + 1024) = o[1]; }
                }
            }
        }
        __syncthreads();
    }
}
__device__ __forceinline__ void p8_final(Frame& F) {
    const bf16* X1 = (const bf16*)(F.ws + WS_X1); const unsigned char* Y = F.ws + WS_Y; const int* TSLOT = (const int*)(F.ws + WS_STOK);
    const int gw = F.vcu * NWAVES + F.wave, NGW = F.G * NWAVES;
    int sl_all = 0; { const int r0 = gw + (F.lane >> 2) * NGW; if (r0 < T) sl_all = (int)__hip_atomic_load((const unsigned*)TSLOT + r0 * 4 + (F.lane & 3), __ATOMIC_RELAXED, __HIP_MEMORY_SCOPE_AGENT); }
    const f32x4* gf = (const f32x4*)F.g_final + F.lane;
    auto slots = [&](int ri, int row, int (&slot)[4]) { int sl = sl_all, sb = (ri & 15) * 4;
        if (ri >= 16) { sl = (int)__hip_atomic_load((const unsigned*)TSLOT + row * 4 + (F.lane & 3), __ATOMIC_RELAXED, __HIP_MEMORY_SCOPE_AGENT); sb = 0; }
#pragma unroll
        for (int k = 0; k < 4; ++k) slot[k] = __shfl(sl, sb + k); };
    auto issue = [&](int row, const int (&slot)[4], v2u (&xq)[8], int (&yq)[4][8]) { const v2u* xr = (const v2u*)(X1 + (size_t)row * DM) + F.lane;
#pragma unroll
        for (int j = 0; j < 8; ++j) { xq[j] = xr[64 * j];
#pragma unroll
            for (int k = 0; k < 4; ++k) yq[k][j] = (int)((const unsigned*)(Y + (size_t)slot[k] * DM) + F.lane)[64 * j]; } };
    auto finish = [&](int row, const v2u (&xq)[8], const int (&yq)[4][8]) { f32x4 v[8]; float ss = 0.f;
#pragma unroll
        for (int j = 0; j < 8; ++j) { v[j] = (f32x4){pg8::bf_lo(xq[j].x), pg8::bf_hi(xq[j].x), pg8::bf_lo(xq[j].y), pg8::bf_hi(xq[j].y)};
#pragma unroll
            for (int k = 0; k < 4; ++k) { const int y = yq[k][j];
                v[j].x += __builtin_amdgcn_cvt_f32_fp8(y, 0) * pg8::Y8_INV; v[j].y += __builtin_amdgcn_cvt_f32_fp8(y, 1) * pg8::Y8_INV; v[j].z += __builtin_amdgcn_cvt_f32_fp8(y, 2) * pg8::Y8_INV; v[j].w += __builtin_amdgcn_cvt_f32_fp8(y, 3) * pg8::Y8_INV; }
            ss += (v[j].x * v[j].x + v[j].y * v[j].y) + (v[j].z * v[j].z + v[j].w * v[j].w); }
        const float rstd = 1.0f / sqrtf(wave_sum(ss) * (1.0f / DM) + RMS_EPS);
        f32x4* o = (f32x4*)(F.out + (size_t)row * DM) + F.lane;
#pragma unroll
        for (int j = 0; j < 8; ++j) o[64 * j] = v[j] * rstd * gf[64 * j]; };
    int ri = 0;
    for (int row = gw; row < T; row += 4 * NGW, ri += 4) {
        const int rowB = row + NGW, rowC = row + 2 * NGW, rowD = row + 3 * NGW; const bool hasB = rowB < T, hasC = rowC < T, hasD = rowD < T;
        int sa[4], sbk[4], sc[4], sd[4]; slots(ri, row, sa); if (hasB) slots(ri + 1, rowB, sbk); if (hasC) slots(ri + 2, rowC, sc); if (hasD) slots(ri + 3, rowD, sd);
        v2u xa[8], xb[8], xc[8], xd[8]; int ya[4][8], yb[4][8], yc[4][8], yd[4][8];
        issue(row, sa, xa, ya);
        if (hasB) issue(rowB, sbk, xb, yb);
        if (hasC) issue(rowC, sc, xc, yc);
        if (hasD) issue(rowD, sd, xd, yd);
        finish(row, xa, ya);
        if (hasB) finish(rowB, xb, yb);
        if (hasC) finish(rowC, xc, yc);
        if (hasD) finish(rowD, xd, yd);
    }
}

struct Args { const float* in[16]; float* out; unsigned char* ws; int ph_lo, ph_hi; };
__global__ void __launch_bounds__(NWAVES * 64, 2) mk_fwd(Args args) {
    extern __shared__ __attribute__((aligned(16))) unsigned char lds[];
    Frame F;
    F.lds = (LAS unsigned char*)lds;
    F.MISC = (volatile LAS unsigned*)(F.lds + MISC_OFF);
    F.tid = threadIdx.x; F.lane = F.tid & 63; F.wave = __builtin_amdgcn_readfirstlane(F.tid >> 6);
    F.G = gridDim.x; { const int bx = blockIdx.x; F.vcu = (F.G % 8 == 0) ? (bx % 8) * (F.G / 8) + bx / 8 : bx; }
    unsigned char* ws = args.ws; F.ws = ws; F.out = args.out;
    F.ctl = (gu32*)(ws + WS_CTL);
    F.x = args.in[0]; F.g_mix = args.in[1]; F.w_in = args.in[2]; F.b_forget = args.in[3]; F.b_gate = args.in[4]; F.w_psb = args.in[5]; F.w_pfx = args.in[6]; F.w_out = args.in[7];
    F.g_ffn = args.in[8]; F.w_router = args.in[9]; F.b_router = args.in[10]; F.w1 = args.in[11]; F.b1 = args.in[12]; F.w2 = args.in[13]; F.b2 = args.in[14]; F.g_final = args.in[15];
    for (int u = F.tid; u < (LDS_BYTES - LDSCTL_OFF) / 4; u += NWAVES * 64) ((LAS unsigned*)(F.lds + LDSCTL_OFF))[u] = 0u;
    __syncthreads();
    XcdBarrier bar; bar.bar = (unsigned*)(F.ctl + CW_BAR); bar.x = 0; bar.st = nullptr;
    if (N_LAUNCHES != PER_PHASE) bar = xcd_barrier_post((unsigned*)(F.ctl + CW_BAR), F.MISC + 8);
#define GRID_BAR(seam) do { if (N_LAUNCHES == PER_PHASE) { if (F.tid == 0) __hip_atomic_store(F.ctl + CW_TMO, 0xBADBA0u | (unsigned)(seam), RLX_AGENT); } else { xcd_barrier(bar); } } while (0)
    const int lo = args.ph_lo, hi = args.ph_hi;
#define IN(k) (lo <= (k) && (k) < hi)
#define BOTH(k) (IN(k) && IN((k) + 1))
    bf16* HN = (bf16*)(ws + WS_HN); bf16* QKV = (bf16*)(ws + WS_QKV); bf16* GATES = (bf16*)(ws + WS_GATES);
    bf16* OSB = (bf16*)(ws + WS_OSB); bf16* OFX = (bf16*)(ws + WS_OFX); bf16* MIXED = (bf16*)(ws + WS_MIXED);
    float* PART = (float*)(ws + WS_PART); float* X1 = (float*)(ws + WS_X1);
    unsigned char* AS = ws + WS_AS; unsigned char* HB = ws + WS_H; unsigned char* YB = ws + WS_Y;

    if (IN(0)) { p0_prologue(F); if (BOTH(0)) GRID_BAR(0); }

    if (IN(1)) {
        { pg8::TileOrder S; S.init(HN, ws + WS_WIN, T, 6 * DH, DM, F.G, (int)blockIdx.x);
          pg8::EpiP1 E{QKV, QKV_STRIDE / 2, (unsigned*)(F.ctl + CW_KM)};
          pg8::gemm_phase<pg8::EpiP1, pg8::TileOrder, true, true>(F.lds + RING_OFF, DM, S, E); }
        { pg8::TileOrder S; S.init(ws + WS_HN8, ws + WS_WIN8, T, 2 * DM, DM, F.G, (int)blockIdx.x, 1);
          pg8::EpiGates E{GATES, F.b_gate};
          pg8::gemm_phase<pg8::EpiGates, pg8::TileOrder, true, true, 1>(F.lds + RING_OFF, DM, S, E); }
        if (BOTH(1)) GRID_BAR(1);
    }

    if (IN(2)) {
        const float* LOGFall = (const float*)(ws + WS_LOGF);
        const int hq = (int)blockIdx.x & 7;
        att::ALAS_char_ptr alds = (att::ALAS_char_ptr)(F.lds + RING_OFF);
        LAS int* qslot = (LAS int*)(F.lds + RING_OFF + att::OFF_FLAG + 64);
        float* PARTF = (float*)(ws + WS_PART);
        const bool conv_first = (((int)blockIdx.x >> 3) & 7) < CONV_FIRST_OF8;
        if (conv_first) p2_convert(F, (unsigned*)(F.ctl + CW_QC), qslot);
#define P2_PULL(cw, limit) do { if (F.wave == 0) { int c_ = (limit); if (F.lane < 8) c_ = (int)__hip_atomic_load((const unsigned*)(F.ctl + (cw) + 64 * F.lane), __ATOMIC_RELAXED, __HIP_MEMORY_SCOPE_AGENT); \
            int bh_ = -1, bc_ = (limit); _Pragma("unroll") for (int j_ = 0; j_ < 8; ++j_) { const int cj_ = __shfl(c_, j_); if (cj_ < bc_) { bc_ = cj_; bh_ = j_; } } \
            { const int own_ = __shfl(c_, hq); if (own_ < (limit)) bh_ = hq; } \
            if (F.lane == 0) { int it_ = (limit); if (bh_ >= 0) it_ = (int)__hip_atomic_fetch_add((unsigned*)(F.ctl + (cw) + 64 * bh_), 1u, __ATOMIC_RELAXED, __HIP_MEMORY_SCOPE_AGENT); qslot[0] = bh_; qslot[1] = it_; } } \
        __syncthreads(); } while (0)
        for (;;) {
            P2_PULL(CW_QF, 48);
            const int h = qslot[0], it = qslot[1]; __syncthreads();
            if (h < 0) break;
            if (it >= 48) continue;
            int qb, mode;
            if (it < 16) { qb = 31 - it; mode = 1; }
            else { const int k = it - 16; if (k < 24) { const int g = k / 3, j = k - 3 * g; qb = j == 0 ? 15 - g : 31 - 2 * g - (j - 1); } else qb = 31 - k; mode = qb >= 16 ? 2 : 0; }
            const int NT = 4 * (qb + 1), t0 = mode == 1 ? NT / 2 : 0, t1 = mode == 2 ? NT / 2 : NT;
            const int slot = h * 16 + (qb & 15);
            att::fox_unit(QKV + 3 * (QKV_STRIDE / 2) + h * HD, QKV + 4 * (QKV_STRIDE / 2) + h * HD, QKV + 5 * (QKV_STRIDE / 2) + h * HD, OFX + h * HD, LOGFall + (size_t)h * T, qb, t0, t1, mode,
                          PARTF + (size_t)slot * (att::QB * att::D + 2 * att::QB), (unsigned*)(F.ctl + CW_FLAG + 64 * slot), (unsigned*)(F.ctl + CW_TMO), (const unsigned*)(F.ctl + CW_KM + 4 * h), alds);
        }
        for (;;) {
            P2_PULL(CW_QS, 32);
            const int h = qslot[0], it = qslot[1]; __syncthreads();
            if (h < 0) break;
            if (it >= 32) continue;
            att::sb_unit(QKV + 0 * (QKV_STRIDE / 2) + h * HD, QKV + 1 * (QKV_STRIDE / 2) + h * HD, QKV + 2 * (QKV_STRIDE / 2) + h * HD, OSB + h * HD, 31 - it, alds);
        }
#undef P2_PULL
        if (!conv_first) p2_convert(F, (unsigned*)(F.ctl + CW_QC), qslot);
        if (BOTH(2)) GRID_BAR(2);
    }

    if (IN(3)) {
        pg8::MixOrder S; S.t.init(OSB, ws + WS_WPA, T, DM, DH, F.G, (int)blockIdx.x); S.A1 = (const char*)OFX; S.B1 = (const char*)(ws + WS_WPB);
        pg8::EpiMix E{GATES, PART, MIXED};
        pg8::gemm_phase<pg8::EpiMix, pg8::MixOrder, false, true>(F.lds + RING_OFF, DH, S, E);
        if (BOTH(3)) GRID_BAR(3);
    }

    if (IN(4)) {
        pg8::TileOrder S; S.init(MIXED, ws + WS_WOUT, T, DM, DM, F.G, (int)blockIdx.x);
        pg8::EpiResid E{F.x, (pg8::bf16_t*)X1};
        pg8::gemm_phase<pg8::EpiResid, pg8::TileOrder, false, true>(F.lds + RING_OFF, DM, S, E);
        if (BOTH(4)) GRID_BAR(4);
    }

    if (IN(5)) { p5_router(F); if (BOTH(5)) GRID_BAR(5); }

    if (IN(6) || IN(7)) {
        LAS int* cntl = (LAS int*)(F.lds + TAB_OFF); LAS int* pref = cntl + 32;
        if (F.tid < 32) { int n = (int)__hip_atomic_load(F.ctl + CW_CNT + 64 * F.tid, RLX_AGENT); cntl[F.tid] = n > CAP ? CAP : n; }
        __syncthreads();
        if (F.tid == 0) { int p = 0; for (int e = 0; e < NE; ++e) { pref[e] = p; p += (cntl[e] + 255) >> 8; } pref[NE] = p; }
        __syncthreads();
        if (IN(6)) {
            pg8::MoeOrder S{(const char*)AS, (const char*)(ws + WS_W1), (const PG8_LAS int*)pref, (size_t)CAP * DM, (size_t)2 * DFF * DM, (size_t)256 * DM, (2 * DFF) / 256, CAP / 256, F.G, F.vcu};
            pg8::EpiSwiglu E{F.b1, HB};
            pg8::gemm_phase<pg8::EpiSwiglu, pg8::MoeOrder, true, true, 1>(F.lds + RING_OFF, DM, S, E);
            if (BOTH(6)) GRID_BAR(6);
        }
        if (IN(7)) {
            pg8::MoeOrder S{(const char*)HB, (const char*)(ws + WS_W2), (const PG8_LAS int*)pref, (size_t)CAP * DFF, (size_t)DM * DFF, (size_t)256 * DFF, DM / 256, CAP / 256, F.G, F.vcu};
            pg8::EpiMoeOut E{F.b2, (const float*)(ws + WS_SW), YB};
            pg8::gemm_phase<pg8::EpiMoeOut, pg8::MoeOrder, true, true, 1>(F.lds + RING_OFF, DFF, S, E);
            if (BOTH(7)) GRID_BAR(7);
        }
    }

    if (IN(8)) p8_final(F);
#undef IN
#undef BOTH
}

extern "C" void kernel_launch(void* const* d_in, const int* in_sizes, int n_in, void* d_out, int out_size, void* d_ws, size_t ws_size, hipStream_t stream) {
    static int grid = 0;
    if (grid == 0) {
        if (n_in != 16 || in_sizes[0] != T * DM || out_size != T * DM || ws_size < WS_END) { fprintf(stderr, "kernel_launch: built for 16 inputs, x/out of %d floats, >= %zu bytes of workspace; got n_in %d, in0 %d, out %d, ws %zu; nothing launched\n", T * DM, (size_t)WS_END, n_in, n_in > 0 ? in_sizes[0] : -1, out_size, ws_size); grid = -1; return; }
        int dev = 0, cus = 0, per_cu = 0;
        if (hipGetDevice(&dev) != hipSuccess || hipDeviceGetAttribute(&cus, hipDeviceAttributeMultiprocessorCount, dev) != hipSuccess) { fprintf(stderr, "kernel_launch: hipGetDevice / hipDeviceGetAttribute failed\n"); grid = -1; return; }
        if (hipFuncSetAttribute((const void*)mk_fwd, hipFuncAttributeMaxDynamicSharedMemorySize, LDS_BYTES) != hipSuccess) { fprintf(stderr, "kernel_launch: hipFuncSetAttribute failed\n"); grid = -1; return; }
        if (hipOccupancyMaxActiveBlocksPerMultiprocessor(&per_cu, (const void*)mk_fwd, NWAVES * 64, LDS_BYTES) != hipSuccess || per_cu < 1)
            fprintf(stderr, "kernel_launch: note: the occupancy query reports %d workgroups per CU\n", per_cu);
        (void)hipGetLastError();
        grid = cus;
    }
    if (grid < 0) return;
    if (hipMemsetAsync((char*)d_ws + WS_CTL, 0, CTL_ZERO_BYTES, stream) != hipSuccess) { fprintf(stderr, "kernel_launch: hipMemsetAsync failed\n"); return; }
    Args a{};
    for (int i = 0; i < 16; ++i) a.in[i] = (const float*)d_in[i];
    a.out = (float*)d_out; a.ws = (unsigned char*)d_ws;
    if (N_LAUNCHES == 1) { a.ph_lo = 0; a.ph_hi = PER_PHASE; hipLaunchKernelGGL(mk_fwd, dim3(grid), dim3(NWAVES * 64), LDS_BYTES, stream, a); }
    else for (int li = 0; li < PER_PHASE; ++li) { a.ph_lo = li; a.ph_hi = li + 1; hipLaunchKernelGGL(mk_fwd, dim3(grid), dim3(NWAVES * 64), LDS_BYTES, stream, a); }
    const hipError_t le = hipPeekAtLastError();
    if (le != hipSuccess) fprintf(stderr, "kernel_launch: launch failed: %s (grid %d)\n", hipGetErrorName(le), grid);
}
```
